# Optimizing an MI355X kernel written in HIP

```python
import jax, jax.numpy as jnp
from jax import lax
import numpy as np

D_MODEL = 2048
BATCH = 32
SEQ = 256
DEPTH = 1
DEC_BATCH = 2
DEC_SEQ = 4096
PAST_LEN = 512

GRID_W = 64
MIX_WIDTH = D_MODEL
LRU_WIDTH = MIX_WIDTH // 2
LRU_HEADS = 8
LRU_HEAD_DIM = LRU_WIDTH // LRU_HEADS
LRU_C = 8.0
CONV_WIDTH = 4
CONV_LEFT = 2
RWKV_WIDTH = MIX_WIDTH - LRU_WIDTH
HEAD_SIZE = 64
RWKV_HEADS = RWKV_WIDTH // HEAD_SIZE
DECAY_LORA = 64
AAA_LORA = 64
GATE_LORA = 160
RWKV_IN_WIDTH = 3 * RWKV_WIDTH + DECAY_LORA + AAA_LORA + GATE_LORA
IN_WIDTH = 2 * LRU_WIDTH + RWKV_IN_WIDTH
FFN_HIDDEN = -(-8 * D_MODEL // (3 * 256)) * 256
RMS_EPS = 1e-6
GN_EPS = 64e-5

kernel_name = 'hybrid_rglru_rwkv7_prefix_diffusion_step'


def rms_norm(x, g):
    x32 = x.astype(jnp.float32)
    y = x32 * lax.rsqrt(jnp.mean(x32 * x32, axis=-1, keepdims=True) + RMS_EPS)
    return (y * g.astype(jnp.float32)).astype(x.dtype)


def shift_context(p):
    half = p.shape[-1] // 2
    prev = jnp.pad(p[..., :half], ((0, 0), (1, 0), (0, 0)))[:, :-1]
    nxt = jnp.pad(p[..., half:], ((0, 0), (0, 1), (0, 0)))[:, 1:]
    return jnp.concatenate([prev, nxt], axis=-1)


def shift_grid(p):
    B, T, C = p.shape
    rows = T // GRID_W
    q = C // 4
    g = p.reshape(B, rows, GRID_W, C)
    left = jnp.pad(g[..., :q], ((0, 0), (0, 0), (1, 0), (0, 0)))[:, :, :-1]
    right = jnp.pad(g[..., q:2 * q], ((0, 0), (0, 0), (0, 1), (0, 0)))[:, :, 1:]
    up = jnp.pad(g[..., 2 * q:3 * q], ((0, 0), (1, 0), (0, 0), (0, 0)))[:, :-1]
    down = jnp.pad(g[..., 3 * q:], ((0, 0), (0, 1), (0, 0), (0, 0)))[:, 1:]
    return jnp.concatenate([left, right, up, down], axis=-1).reshape(B, T, C)


def conv_centred(x, w, b):
    T = x.shape[1]
    xp = jnp.pad(x, ((0, 0), (CONV_LEFT, CONV_WIDTH - 1 - CONV_LEFT), (0, 0)))
    y = xp[:, 0:T] * w[0]
    for k in range(1, CONV_WIDTH):
        y = y + xp[:, k:k + T] * w[k]
    return y + b


def _linear_combine(e1, e2):
    a1, b1 = e1
    a2, b2 = e2
    return a1 * a2, a2 * b1 + b2


def rglru(x, wr, br, wi, bi, lam, h0, reverse):
    B, T, W = x.shape
    xf = x.astype(jnp.float32)
    xh = xf.reshape(B, T, LRU_HEADS, LRU_HEAD_DIM)
    r = jax.nn.sigmoid(jnp.einsum('bthi,hij->bthj', xh, wr.astype(jnp.float32)) + br).reshape(B, T, W)
    i = jax.nn.sigmoid(jnp.einsum('bthi,hij->bthj', xh, wi.astype(jnp.float32)) + bi).reshape(B, T, W)
    log_a = -LRU_C * r * jax.nn.softplus(-lam.astype(jnp.float32))
    a = jnp.exp(log_a)
    b = jnp.sqrt(-jnp.expm1(2.0 * log_a)) * (i * xf)
    if reverse:
        a, b = jnp.flip(a, 1), jnp.flip(b, 1)
    a_cum, b_cum = lax.associative_scan(_linear_combine, (a, b), axis=1)
    hs = a_cum * h0.astype(jnp.float32)[:, None, :] + b_cum
    h_fin = hs[:, -1]
    if reverse:
        hs = jnp.flip(hs, 1)
    return hs, h_fin


def wkv7_scan(r, decay, kk, a, k, v, S0, reverse):
    xs = tuple(jnp.moveaxis(t, 1, 0) for t in (r, decay, kk, a, k, v))

    def step(S, inp):
        r_t, w_t, kk_t, a_t, k_t, v_t = inp
        sa = jnp.einsum('bhvk,bhk->bhv', S, -kk_t)
        S = (S * w_t[:, :, None, :] + sa[..., None] * (kk_t * a_t)[:, :, None, :]
             + v_t[..., None] * k_t[:, :, None, :])
        return S, jnp.einsum('bhvk,bhk->bhv', S, r_t)

    S_fin, ys = lax.scan(step, S0.astype(jnp.float32), xs, reverse=reverse)
    return jnp.moveaxis(ys, 0, 1), S_fin


def rwkv7(pr, shift_fn, S0, L):
    dt = pr.dtype
    B, T, _ = pr.shape
    pr = pr + L['rwkv_mu'] * (shift_fn(pr) - pr)
    s1 = RWKV_WIDTH
    r, k, v, wd, ad, gd = jnp.split(pr, [s1, 2 * s1, 3 * s1, 3 * s1 + DECAY_LORA, 3 * s1 + DECAY_LORA + AAA_LORA], axis=-1)

    def heads(t):
        return t.astype(jnp.float32).reshape(B, T, RWKV_HEADS, HEAD_SIZE)

    kk = heads(k * L['rwkv_k_k'])
    kk = kk * lax.rsqrt(jnp.maximum(jnp.sum(kk * kk, axis=-1, keepdims=True), 1e-24))
    g = jax.nn.sigmoid(gd) @ L['rwkv_g_up']
    wl = jnp.tanh(wd)
    rh, vh = heads(r), heads(v)
    ys, finals = [], []
    for d, rev in ((0, False), (1, True)):
        w_log = -jax.nn.softplus(-(L['rwkv_w0'][d] + wl @ L['rwkv_w_up'][d])) - 0.5
        decay = jnp.exp(-jnp.exp(heads(w_log)))
        a_flat = jax.nn.sigmoid(L['rwkv_a0'][d] + ad @ L['rwkv_a_up'][d])
        k_d = heads(k * (1.0 + (a_flat - 1.0) * L['rwkv_k_a']))
        y_d, S_d = wkv7_scan(rh, decay, kk, heads(a_flat), k_d, vh, S0[:, d], rev)
        ys.append(y_d)
        finals.append(S_d)
    bonus = jnp.sum(rh * heads(k) * L['rwkv_r_k'].astype(jnp.float32), axis=-1, keepdims=True) * vh
    y = ys[0] + ys[1] + bonus
    mean = jnp.mean(y, axis=-1, keepdims=True)
    var = jnp.mean(jnp.square(y - mean), axis=-1, keepdims=True)
    y = ((y - mean) * lax.rsqrt(var + GN_EPS)).reshape(B, T, RWKV_WIDTH)
    y = y * L['rwkv_ln_w'] + L['rwkv_ln_b']
    out = (y * g.astype(jnp.float32)).astype(dt)
    return out, jnp.stack([finals[0], finals[1]], axis=1)


def mixer(h, shift_fn, lru_h0, wkv_S0, L):
    dt = h.dtype
    proj = h @ L['w_in']
    xl, gl, pr = jnp.split(proj, [LRU_WIDTH, 2 * LRU_WIDTH], axis=-1)
    xc = conv_centred(xl, L['lru_conv_w'], L['lru_conv_b'])
    hs_f, hf = rglru(xc, L['lru_wr'][0], L['lru_br'][0], L['lru_wi'][0], L['lru_bi'][0], L['lru_lambda'][0], lru_h0[:, 0], False)
    hs_b, hb = rglru(xc, L['lru_wr'][1], L['lru_br'][1], L['lru_wi'][1], L['lru_bi'][1], L['lru_lambda'][1], lru_h0[:, 1], True)
    lru_out = ((hs_f + hs_b) * jax.nn.gelu(gl.astype(jnp.float32))).astype(dt)
    rwkv_out, wkv_fin = rwkv7(pr, shift_fn, wkv_S0, L)
    out = jnp.concatenate([lru_out, rwkv_out], axis=-1) @ L['w_out']
    return out, jnp.stack([hf, hb], axis=1), wkv_fin


def block(x, mod, shift_fn, lru_h0, wkv_S0, L):
    shift_m, scale_m, gate_m, shift_f, scale_f, gate_f = jnp.split(mod, 6, axis=-1)
    h = rms_norm(x, L['norm_mix_pre']) * (1.0 + scale_m) + shift_m
    out, lru_fin, wkv_fin = mixer(h, shift_fn, lru_h0, wkv_S0, L)
    x = x + gate_m * rms_norm(out, L['norm_mix_post'])
    h = rms_norm(x, L['norm_ffn_pre']) * (1.0 + scale_f) + shift_f
    gate, up = jnp.split(h @ L['ffn_w_gu'], 2, axis=-1)
    f = (jax.nn.silu(gate) * up) @ L['ffn_w_down']
    x = x + gate_f * rms_norm(f, L['norm_ffn_post'])
    return x, lru_fin, wkv_fin


def setup_inputs(seed: int = 0) -> dict:
    key = jax.random.key(seed)
    ks = jax.random.split(key, 40)
    f32 = jnp.float32
    D = D_MODEL

    def nrm(k, shape, scale):
        return jax.random.normal(k, shape, f32) * scale

    u = jax.random.uniform(ks[13], (DEPTH, 2, LRU_WIDTH), f32, minval=0.9, maxval=0.999)
    s = u ** (1.0 / LRU_C)
    lru_lambda = jnp.log(s) - jnp.log1p(-s)
    return {
        'x_prompt': nrm(ks[0], (BATCH, SEQ, D), 1.0),
        'x_sample': nrm(ks[1], (DEC_BATCH, DEC_SEQ, D), 1.0),
        'state_lru': nrm(ks[2], (DEC_BATCH, DEPTH, 2, LRU_WIDTH), 1.0),
        'state_wkv': nrm(ks[3], (DEC_BATCH, DEPTH, 2, RWKV_HEADS, HEAD_SIZE, HEAD_SIZE), 0.5),
        'c': nrm(ks[4], (DEC_BATCH, D), 1.0),
        'c_ctx': nrm(ks[5], (D,), 1.0),
        'norm_mix_pre': 1.0 + nrm(ks[6], (DEPTH, D), 0.1),
        'norm_mix_post': 1.0 + nrm(ks[7], (DEPTH, D), 0.1),
        'norm_ffn_pre': 1.0 + nrm(ks[8], (DEPTH, D), 0.1),
        'norm_ffn_post': 1.0 + nrm(ks[9], (DEPTH, D), 0.1),
        'w_mod': nrm(ks[10], (DEPTH, D, 6 * D), 0.5 * D ** -0.5),
        'b_mod': nrm(ks[11], (DEPTH, 6 * D), 0.02),
        'w_in': nrm(ks[12], (DEPTH, D, IN_WIDTH), D ** -0.5),
        'lru_conv_w': nrm(ks[14], (DEPTH, CONV_WIDTH, LRU_WIDTH), CONV_WIDTH ** -0.5),
        'lru_conv_b': nrm(ks[15], (DEPTH, LRU_WIDTH), 0.02),
        'lru_wr': nrm(ks[16], (DEPTH, 2, LRU_HEADS, LRU_HEAD_DIM, LRU_HEAD_DIM), LRU_HEAD_DIM ** -0.5),
        'lru_br': nrm(ks[17], (DEPTH, 2, LRU_HEADS, LRU_HEAD_DIM), 0.1),
        'lru_wi': nrm(ks[18], (DEPTH, 2, LRU_HEADS, LRU_HEAD_DIM, LRU_HEAD_DIM), LRU_HEAD_DIM ** -0.5),
        'lru_bi': nrm(ks[19], (DEPTH, 2, LRU_HEADS, LRU_HEAD_DIM), 0.1),
        'lru_lambda': lru_lambda,
        'rwkv_mu': jax.random.uniform(ks[20], (DEPTH, RWKV_IN_WIDTH), f32),
        'rwkv_w0': jax.random.uniform(ks[21], (DEPTH, 2, RWKV_WIDTH), f32, minval=-6.0, maxval=-1.0),
        'rwkv_w_up': nrm(ks[22], (DEPTH, 2, DECAY_LORA, RWKV_WIDTH), DECAY_LORA ** -0.5),
        'rwkv_a0': nrm(ks[23], (DEPTH, 2, RWKV_WIDTH), 0.5),
        'rwkv_a_up': nrm(ks[24], (DEPTH, 2, AAA_LORA, RWKV_WIDTH), AAA_LORA ** -0.5),
        'rwkv_g_up': nrm(ks[25], (DEPTH, GATE_LORA, RWKV_WIDTH), GATE_LORA ** -0.5),
        'rwkv_k_k': 0.85 + nrm(ks[26], (DEPTH, RWKV_WIDTH), 0.1),
        'rwkv_k_a': 1.0 + nrm(ks[27], (DEPTH, RWKV_WIDTH), 0.1),
        'rwkv_r_k': nrm(ks[28], (DEPTH, RWKV_HEADS, HEAD_SIZE), 0.1),
        'rwkv_ln_w': 1.0 + nrm(ks[29], (DEPTH, RWKV_WIDTH), 0.1),
        'rwkv_ln_b': nrm(ks[30], (DEPTH, RWKV_WIDTH), 0.02),
        'w_out': nrm(ks[31], (DEPTH, MIX_WIDTH, D), MIX_WIDTH ** -0.5),
        'ffn_w_gu': nrm(ks[32], (DEPTH, D, 2 * FFN_HIDDEN), D ** -0.5),
        'ffn_w_down': nrm(ks[33], (DEPTH, FFN_HIDDEN, D), FFN_HIDDEN ** -0.5),
    }


def reference(x_prompt, x_sample, state_lru, state_wkv, c, c_ctx,
              norm_mix_pre, norm_mix_post, norm_ffn_pre, norm_ffn_post, w_mod, b_mod, w_in,
              lru_conv_w, lru_conv_b, lru_wr, lru_br, lru_wi, lru_bi, lru_lambda,
              rwkv_mu, rwkv_w0, rwkv_w_up, rwkv_a0, rwkv_a_up, rwkv_g_up, rwkv_k_k, rwkv_k_a, rwkv_r_k,
              rwkv_ln_w, rwkv_ln_b, w_out, ffn_w_gu, ffn_w_down):
    y_p = x_prompt
    y_s = x_sample
    Bp = x_prompt.shape[0]
    new_lru, new_wkv = [], []
    for l in range(DEPTH):
        L = {
            'norm_mix_pre': norm_mix_pre[l], 'norm_mix_post': norm_mix_post[l],
            'norm_ffn_pre': norm_ffn_pre[l], 'norm_ffn_post': norm_ffn_post[l],
            'w_in': w_in[l], 'w_out': w_out[l],
            'lru_conv_w': lru_conv_w[l], 'lru_conv_b': lru_conv_b[l],
            'lru_wr': lru_wr[l], 'lru_br': lru_br[l], 'lru_wi': lru_wi[l], 'lru_bi': lru_bi[l],
            'lru_lambda': lru_lambda[l],
            'rwkv_mu': rwkv_mu[l], 'rwkv_w0': rwkv_w0[l], 'rwkv_w_up': rwkv_w_up[l],
            'rwkv_a0': rwkv_a0[l], 'rwkv_a_up': rwkv_a_up[l], 'rwkv_g_up': rwkv_g_up[l],
            'rwkv_k_k': rwkv_k_k[l], 'rwkv_k_a': rwkv_k_a[l], 'rwkv_r_k': rwkv_r_k[l],
            'rwkv_ln_w': rwkv_ln_w[l], 'rwkv_ln_b': rwkv_ln_b[l],
            'ffn_w_gu': ffn_w_gu[l], 'ffn_w_down': ffn_w_down[l],
        }
        mod_ctx = (jax.nn.silu(c_ctx) @ w_mod[l] + b_mod[l])[None, None, :]
        mod_lat = (jax.nn.silu(c) @ w_mod[l] + b_mod[l])[:, None, :]
        lru_zero = jnp.zeros((Bp, 2, LRU_WIDTH), jnp.float32)
        wkv_zero = jnp.zeros((Bp, 2, RWKV_HEADS, HEAD_SIZE, HEAD_SIZE), jnp.float32)
        y_p, lru_ctx, wkv_ctx = block(y_p, mod_ctx, shift_context, lru_zero, wkv_zero, L)
        new_lru.append(lru_ctx.astype(x_prompt.dtype))
        new_wkv.append(wkv_ctx.astype(x_prompt.dtype))
        y_s, _, _ = block(y_s, mod_lat, shift_grid, state_lru[:, l], state_wkv[:, l], L)
    new_state_lru = jnp.stack(new_lru, axis=1)
    new_state_wkv = jnp.stack(new_wkv, axis=1)
    return (y_p, y_s, new_state_lru, new_state_wkv)
```

```cpp
#include <hip/hip_runtime.h>
#include <hip/hip_cooperative_groups.h>
#include <cstdio>
namespace cg = cooperative_groups;

#ifndef MK_ONE_LAUNCH
#define MK_ONE_LAUNCH 0
#endif
#ifndef MK_CG_FIRST
#define MK_CG_FIRST 1
#endif

#define LAS __attribute__((address_space(3)))
typedef unsigned short bf16_t;
typedef short bf16x8 __attribute__((ext_vector_type(8)));
typedef float f32x4 __attribute__((ext_vector_type(4)));
typedef unsigned u32x4 __attribute__((ext_vector_type(4)));
typedef unsigned u32x2 __attribute__((ext_vector_type(2)));

constexpr int D = 2048, NTOK = 16384, NPTOK = 8192, PSEQ = 256, SSEQ = 4096;
constexpr int LRUW = 1024, RW = 1024, NH = 16, RIN = 3360, INW = 5408, INWP = 5632, FFH = 5632;
constexpr int LAK = 384;
constexpr int NPHASE = 16;

constexpr size_t MiB = 1024 * 1024;
constexpr size_t WS_CTL = 0;
constexpr size_t WS_MOD = 64 * 1024;
constexpr size_t WS_NL8 = 256 * 1024;
constexpr size_t WS_BTLRU = 1 * MiB;
constexpr size_t WS_BTLORA = 3 * MiB;
constexpr size_t WS_WTOUT = 7 * MiB;
constexpr size_t WS_WTGU = 15 * MiB;
constexpr size_t WS_WTDN = 59 * MiB;
constexpr size_t WS_H = 81 * MiB;
constexpr size_t WS_PROJ = 145 * MiB;
constexpr size_t WS_S = 321 * MiB;
constexpr size_t WS_WTIN = WS_S;
constexpr size_t WS_XC = WS_S;
constexpr size_t WS_G = WS_S;
constexpr size_t WS_LA = WS_S + 32 * MiB;
constexpr size_t WS_YB = WS_S + 32 * MiB;
constexpr size_t WS_PQ = WS_S + 64 * MiB;
constexpr size_t WS_END = WS_S + 96 * MiB;

__device__ __forceinline__ float bf2f(unsigned b) { return __uint_as_float(b << 16); }
__device__ __forceinline__ float bflo(unsigned w) { return __uint_as_float(w << 16); }
__device__ __forceinline__ float bfhi(unsigned w) { return __uint_as_float(w & 0xffff0000u); }
__device__ __forceinline__ unsigned f2bf(float f) { unsigned u = __float_as_uint(f); return (u + 0x7fffu + ((u >> 16) & 1u)) >> 16; }
__device__ __forceinline__ unsigned pk2(float lo, float hi) { return f2bf(lo) | (f2bf(hi) << 16); }
__device__ __forceinline__ float sigmoidf_(float x) { return __builtin_amdgcn_rcpf(1.f + __expf(-x)); }
__device__ __forceinline__ float gelu_tanh(float x) { const float u = 0.7978845608028654f * (x + 0.044715f * x * x * x); return 0.5f * x * (1.f + tanhf(u)); }
template <int CTRL> __device__ __forceinline__ float dpp_f(float x) { return __builtin_bit_cast(float, __builtin_amdgcn_update_dpp(0, __builtin_bit_cast(int, x), CTRL, 0xf, 0xf, true)); }
__device__ __forceinline__ float red8(float x) { x += dpp_f<0xB1>(x); x += dpp_f<0x4E>(x); x += dpp_f<0x141>(x); return x; }
__device__ __forceinline__ float wave_sum(float x) { x = red8(x); x += dpp_f<0x140>(x); x += __shfl_xor(x, 16); x += __shfl_xor(x, 32); return x; }
__device__ __forceinline__ int modidx(int row) { return row < NPTOK ? 0 : 1 + ((row - NPTOK) >> 12); }

#define XB_TMO      128
#define XB_XCNT(j)  (256  + 64 * (j))
#define XB_XSUB(j)  (1280 + 64 * (j))
#define XB_XGEN(j)  (2304 + 64 * (j))
#define XB_TOP      3328
#define XB_TOPGEN   3392
#define XCD_BAR_WORDS 3456
#define XB_SPIN_CAP (1u << 22)
__device__ __forceinline__ unsigned xb_ld(unsigned* p)              { return __hip_atomic_load(p, __ATOMIC_RELAXED, __HIP_MEMORY_SCOPE_AGENT); }
__device__ __forceinline__ unsigned xb_add(unsigned* p, unsigned v) { return __hip_atomic_fetch_add(p, v, __ATOMIC_RELAXED, __HIP_MEMORY_SCOPE_AGENT); }
__device__ __forceinline__ unsigned xb_xcc_id() { return (unsigned)__builtin_amdgcn_s_getreg((3 << 11) | 20) & 0xFu; }
#define XB_SPIN(cond, bar) do { unsigned _sp = 0; while (cond) { __builtin_amdgcn_s_sleep(1); \
    if ((++_sp & 255u) == 0u) { if (xb_ld(&(bar)[XB_TMO])) break; if (_sp > XB_SPIN_CAP) { atomicAdd(&(bar)[XB_TMO], 1u); break; } } } } while (0)
struct XcdBarrier { unsigned* bar; unsigned x; volatile LAS unsigned* st; };
__device__ __forceinline__ XcdBarrier xcd_barrier_post(unsigned* bar, volatile LAS unsigned* st) {
    XcdBarrier b; b.bar = bar; b.x = xb_xcc_id(); b.st = st;
    if (threadIdx.x == 0) (void)xb_add(&bar[XB_XCNT(b.x)], 1u);
    return b;
}
__device__ __forceinline__ void xcd_barrier_complete(unsigned* bar, unsigned x, unsigned& nloc, unsigned& nx) {
    const unsigned G = gridDim.x * gridDim.y * gridDim.z;
    unsigned sum, cnt, mine, sp = 0u;
    for (;;) {
        sum = 0u; cnt = 0u; mine = 0u;
#pragma unroll
        for (unsigned j = 0; j < 16; ++j) { const unsigned c = xb_ld(&bar[XB_XCNT(j)]); sum += c; cnt += (c > 0u) ? 1u : 0u; mine = (j == x) ? c : mine; }
        if (sum == G) break;
        __builtin_amdgcn_s_sleep(1);
        if ((++sp & 255u) == 0u) { if (xb_ld(&bar[XB_TMO])) break; if (sp > XB_SPIN_CAP) { atomicAdd(&bar[XB_TMO], 1u); break; } }
    }
    nloc = mine > 0u ? mine : 1u; nx = cnt > 0u ? cnt : 1u;
}
__device__ __forceinline__ void xcd_barrier(const XcdBarrier& b) {
    asm volatile("s_waitcnt vmcnt(0)" ::: "memory");
    __syncthreads();
    if (threadIdx.x == 0) {
        unsigned* bar = b.bar;
        __builtin_amdgcn_s_waitcnt(0);
        unsigned nloc = b.st[0], nx = b.st[1];
        if (nloc == 0u) { xcd_barrier_complete(bar, b.x, nloc, nx); b.st[0] = nloc; b.st[1] = nx; }
        const unsigned old = xb_add(&bar[XB_XSUB(b.x)], 1u);
        const unsigned gen = old / nloc;
        if (old + 1u == (gen + 1u) * nloc) {
            __builtin_amdgcn_fence(__ATOMIC_RELEASE, "agent");
            asm volatile("s_waitcnt vmcnt(0)" ::: "memory");
            const unsigned og = xb_add(&bar[XB_TOP], 1u);
            const unsigned tg = og / nx;
            if (og + 1u == (tg + 1u) * nx) xb_add(&bar[XB_TOPGEN], 1u);
            else XB_SPIN(xb_ld(&bar[XB_TOPGEN]) == tg, bar);
            __builtin_amdgcn_fence(__ATOMIC_ACQUIRE, "agent");
            xb_add(&bar[XB_XGEN(b.x)], 1u);
            asm volatile("s_waitcnt vmcnt(0)" ::: "memory");
        } else {
            XB_SPIN(xb_ld(&bar[XB_XGEN(b.x)]) == gen, bar);
            __builtin_amdgcn_fence(__ATOMIC_ACQUIRE, "agent");
            asm volatile("s_waitcnt vmcnt(0)" ::: "memory");
        }
    }
    __syncthreads();
}

struct Args { const float* in[34]; float* out; unsigned char* ws; int ph_lo, ph_hi; };
struct Frame {
    LAS unsigned char* lds;
    int tid, lane, wave, G;
    const float* const* in;
    float* out; unsigned char* ws;
};
#define IN_XP 0
#define IN_XS 1
#define IN_SLRU 2
#define IN_SWKV 3
#define IN_C 4
#define IN_CCTX 5
#define IN_NMPRE 6
#define IN_NMPOST 7
#define IN_NFPRE 8
#define IN_NFPOST 9
#define IN_WMOD 10
#define IN_BMOD 11
#define IN_WIN 12
#define IN_CONVW 13
#define IN_CONVB 14
#define IN_WR 15
#define IN_BR 16
#define IN_WI 17
#define IN_BI 18
#define IN_LAM 19
#define IN_MU 20
#define IN_W0 21
#define IN_WUP 22
#define IN_A0 23
#define IN_AUP 24
#define IN_GUP 25
#define IN_KK 26
#define IN_KA 27
#define IN_RK 28
#define IN_LNW 29
#define IN_LNB 30
#define IN_WOUT 31
#define IN_WGU 32
#define IN_WDN 33

namespace pg8 {
constexpr int BM = 256, BK = 64, HALF = 128, HTB = HALF * BK * 2, STAGE_BYTES = 8 * HTB, NXCD = 8, WGM = 8;
__host__ __device__ __forceinline__ int lds_byte(int r, int c) { const int st = (r >> 4) * 2 + (c >> 5), rr = r & 15, cc = c & 31, ob = rr * 64 + cc * 2; return st * 1024 + (ob ^ (((ob >> 9) & 1) << 5)); }
__host__ __device__ __forceinline__ void stage_rc(int b, int& R, int& C) { const int st = b / 1024, sb = b % 1024, swz = sb ^ (((sb >> 9) & 1) << 5); R = (st >> 1) * 16 + swz / 64; C = (st & 1) * 32 + (swz % 64) / 2; }
__host__ __device__ __forceinline__ int perm32(int rho) { const int n = rho >> 4, i = rho & 15; return 8 * (i >> 2) + 4 * n + (i & 3); }
struct Unit { int pm, pn; };
struct Gemm { const bf16_t* A; const bf16_t* Bt; int lda, ldb, K; int lruoff; };
struct StaticOrder {
    int nM, nN, nwg, G, c;
    __device__ void init(int M, int N, int G_, int c_) { nM = M / BM; nN = N / BM; nwg = nM * nN; G = G_; c = c_; }
    __device__ bool next(int i, Unit& u) const {
        const long L = (long)i * G + c; if (L >= nwg) return false;
        int wgid = (int)L; { const int q = nwg / NXCD, r = nwg % NXCD, xcd = wgid % NXCD, off = wgid / NXCD; wgid = (xcd < r ? xcd * (q + 1) : r * (q + 1) + (xcd - r) * q) + off; }
        const int nig = WGM * nN, gid = wgid / nig, fm = gid * WGM, gsz = (nM - fm) < WGM ? (nM - fm) : WGM;
        u.pm = fm + ((wgid % nig) % gsz); u.pn = (wgid % nig) / gsz; return true;
    }
};
__device__ __forceinline__ size_t a_unit_off(const Gemm& g, const Unit& u) {
    size_t o = (size_t)u.pm * BM * g.lda * 2;
    if (g.lruoff) { const int hd = u.pn >> 1; o += (size_t)(hd < 7 ? 128 * hd : 768) * 2; }
    return o;
}

template <class Epi>
__device__ __forceinline__ void gemm_phase(LAS unsigned char* lds, const Gemm g, const StaticOrder& S, const Epi& E) {
    const int tid = threadIdx.x, wid = __builtin_amdgcn_readfirstlane(tid >> 6), lane = tid & 63, wr = wid >> 2, wc = wid & 3, fr = lane & 15, fq = lane >> 4;
    const int nt = g.K / BK;
    unsigned voffA[2], voffB[2];
#pragma unroll
    for (int i = 0; i < 2; ++i) { int R, C; stage_rc(tid * 16 + i * 8192, R, C); const int Rb = (R & ~31) + perm32(R & 31);
        voffA[i] = (unsigned)(R * g.lda + C) * 2u; voffB[i] = (unsigned)(Rb * g.ldb + C) * 2u; }
    const size_t kstep = (size_t)(BK * 2);
    const size_t hstepA = (size_t)HALF * g.lda * 2, hstepB = (size_t)HALF * g.ldb * 2;
    const size_t tstepB = 2 * hstepB;
    const unsigned ldsw = (unsigned)wid * 1024u;
    const int aoff = lds_byte(wr * 64 + fr, fq * 8), boff = lds_byte(wc * 32 + fr, fq * 8);
#define PG8_SA(b, h) (((b) * 2 + (h)) * HTB)
#define PG8_SB(b, h) ((4 + (b) * 2 + (h)) * HTB)
#define PG8_STAGE(bufoff, gbase, voff) do { _Pragma("unroll") for (int _i = 0; _i < 2; ++_i) \
        __builtin_amdgcn_global_load_lds((const unsigned*)((const char*)(gbase) + (voff)[_i]), (LAS unsigned*)(lds + (bufoff) + ldsw + _i * 8192), 16, 0, 0); } while (0)
#define PG8_LDA(dst, b, h) do { _Pragma("unroll") for (int m = 0; m < 4; ++m) _Pragma("unroll") for (int k = 0; k < 2; ++k) dst[m][k] = *(const LAS bf16x8*)(lds + PG8_SA(b, h) + aoff + m * 2048 + k * 1024); } while (0)
#define PG8_LDB(dst, b, h) do { _Pragma("unroll") for (int n = 0; n < 2; ++n) _Pragma("unroll") for (int k = 0; k < 2; ++k) dst[n][k] = *(const LAS bf16x8*)(lds + PG8_SB(b, h) + boff + n * 2048 + k * 1024); } while (0)
#define PG8_MMA(ai, bj, At, Bt) do { __builtin_amdgcn_s_setprio(1); _Pragma("unroll") for (int m = 0; m < 4; ++m) _Pragma("unroll") for (int n = 0; n < 2; ++n) _Pragma("unroll") for (int k = 0; k < 2; ++k) \
        acc[ai][bj][m][n] = __builtin_amdgcn_mfma_f32_16x16x32_bf16(Bt[n][k], At[m][k], acc[ai][bj][m][n], 0, 0, 0); __builtin_amdgcn_s_setprio(0); } while (0)
#define PG8_WAIT_V(n) asm volatile("s_waitcnt vmcnt(" #n ")" ::: "memory")
#define PG8_WAIT_L(n) asm volatile("s_waitcnt lgkmcnt(" #n ")" ::: "memory")
#define PG8_BAR __builtin_amdgcn_s_barrier()
#define PG8_SCHED __builtin_amdgcn_sched_barrier(0)
    Unit cur, nxt; int ui = 0;
    if (!S.next(0, cur)) return;
    f32x4 acc[2][2][4][2];
#pragma unroll
    for (int a = 0; a < 2; ++a)
#pragma unroll
        for (int b = 0; b < 2; ++b)
#pragma unroll
            for (int m = 0; m < 4; ++m)
#pragma unroll
                for (int n = 0; n < 2; ++n) acc[a][b][m][n] = (f32x4){0.f, 0.f, 0.f, 0.f};
    bf16x8 At[4][2], B0[2][2], B1[2][2];
    const char* cA = (const char*)g.A + a_unit_off(g, cur); const char* cB = (const char*)g.Bt + (size_t)cur.pn * tstepB;
    PG8_STAGE(PG8_SB(0, 0), cB, voffB); PG8_STAGE(PG8_SA(0, 0), cA, voffA); PG8_STAGE(PG8_SB(0, 1), cB + hstepB, voffB); PG8_STAGE(PG8_SA(0, 1), cA + hstepA, voffA);
    if (wr == 1) PG8_BAR;
    PG8_WAIT_V(4); PG8_BAR;
    PG8_STAGE(PG8_SB(1, 0), cB + kstep, voffB); PG8_STAGE(PG8_SA(1, 0), cA + kstep, voffA); PG8_STAGE(PG8_SB(1, 1), cB + hstepB + kstep, voffB);
    PG8_WAIT_V(6); PG8_BAR;
    for (;;) {
        const bool has_next = S.next(ui + 1, nxt);
        const char* nA = has_next ? (const char*)g.A + a_unit_off(g, nxt) : cA; const char* nB = has_next ? (const char*)g.Bt + (size_t)nxt.pn * tstepB : cB;
#pragma unroll 1
        for (int t = 0; t < nt; t += 2) {
            const bool last = (t == nt - 2);
            const char* a1 = cA + (size_t)(t + 1) * kstep;
            const char* a2 = last ? nA : cA + (size_t)(t + 2) * kstep; const char* b2 = last ? nB : cB + (size_t)(t + 2) * kstep;
            const char* a3 = a2 + kstep; const char* b3 = b2 + kstep;
            PG8_LDB(B0, 0, 0); PG8_SCHED; PG8_LDA(At, 0, 0); PG8_STAGE(PG8_SA(1, 1), a1 + hstepA, voffA);
            PG8_WAIT_L(8); PG8_BAR; PG8_WAIT_L(0); PG8_MMA(0, 0, At, B0); PG8_BAR; PG8_SCHED;
            PG8_LDB(B1, 0, 1); PG8_STAGE(PG8_SB(0, 0), b2, voffB);
            PG8_BAR; PG8_WAIT_L(0); PG8_MMA(0, 1, At, B1); PG8_BAR;
            PG8_LDA(At, 0, 1); PG8_STAGE(PG8_SA(0, 0), a2, voffA);
            PG8_BAR; PG8_WAIT_L(0); PG8_MMA(1, 0, At, B0); PG8_BAR; PG8_SCHED;
            PG8_STAGE(PG8_SB(0, 1), b2 + hstepB, voffB);
            PG8_WAIT_V(6); PG8_BAR; PG8_MMA(1, 1, At, B1); PG8_BAR;
            PG8_LDB(B0, 1, 0); PG8_SCHED; PG8_LDA(At, 1, 0); PG8_STAGE(PG8_SA(0, 1), a2 + hstepA, voffA);
            PG8_WAIT_L(8); PG8_BAR; PG8_WAIT_L(0); PG8_MMA(0, 0, At, B0); PG8_BAR; PG8_SCHED;
            PG8_LDB(B1, 1, 1); PG8_STAGE(PG8_SB(1, 0), b3, voffB);
            PG8_BAR; PG8_WAIT_L(0); PG8_MMA(0, 1, At, B1); PG8_BAR;
            PG8_LDA(At, 1, 1); PG8_STAGE(PG8_SA(1, 0), a3, voffA);
            PG8_BAR; PG8_WAIT_L(0); PG8_MMA(1, 0, At, B0); PG8_BAR; PG8_SCHED;
            PG8_STAGE(PG8_SB(1, 1), b3 + hstepB, voffB);
            PG8_WAIT_V(6); PG8_BAR; PG8_MMA(1, 1, At, B1); PG8_BAR;
        }
        E(acc, cur, wr, wc, fr, fq);
        if (!has_next) break;
#pragma unroll
        for (int a = 0; a < 2; ++a)
#pragma unroll
            for (int b = 0; b < 2; ++b)
#pragma unroll
                for (int m = 0; m < 4; ++m)
#pragma unroll
                    for (int n = 0; n < 2; ++n) acc[a][b][m][n] = (f32x4){0.f, 0.f, 0.f, 0.f};
        cur = nxt; cA = nA; cB = nB; ++ui;
    }
    PG8_WAIT_V(0);
    if (wr == 0) PG8_BAR;
    PG8_BAR;
#undef PG8_SA
#undef PG8_SB
#undef PG8_STAGE
#undef PG8_LDA
#undef PG8_LDB
#undef PG8_MMA
#undef PG8_WAIT_V
#undef PG8_WAIT_L
#undef PG8_BAR
#undef PG8_SCHED
}

struct EpiBf16 {
    bf16_t* O; int ldc;
    __device__ __forceinline__ void operator()(const f32x4 (&acc)[2][2][4][2], const Unit& u, int wr, int wc, int fr, int fq) const {
        const int row0 = u.pm * BM + wr * 64 + fr, col0 = u.pn * BM + wc * 32 + 8 * fq;
#pragma unroll
        for (int ai = 0; ai < 2; ++ai)
#pragma unroll
            for (int m = 0; m < 4; ++m) { bf16_t* rowp = O + (size_t)(row0 + ai * HALF + m * 16) * ldc + col0;
#pragma unroll
                for (int bj = 0; bj < 2; ++bj) { const f32x4 v0 = acc[ai][bj][m][0], v1 = acc[ai][bj][m][1];
                    *(u32x4*)(rowp + bj * HALF) = (u32x4){pk2(v0[0], v0[1]), pk2(v0[2], v0[3]), pk2(v1[0], v1[1]), pk2(v1[2], v1[3])}; } }
    }
};
struct EpiGu {
    bf16_t* O;
    __device__ __forceinline__ void operator()(const f32x4 (&acc)[2][2][4][2], const Unit& u, int wr, int wc, int fr, int fq) const {
        const int row0 = u.pm * BM + wr * 64 + fr, col0 = u.pn * HALF + wc * 32 + 8 * fq;
#pragma unroll
        for (int ai = 0; ai < 2; ++ai)
#pragma unroll
            for (int m = 0; m < 4; ++m) { bf16_t* rowp = O + (size_t)(row0 + ai * HALF + m * 16) * FFH + col0;
                float o[8];
#pragma unroll
                for (int n = 0; n < 2; ++n)
#pragma unroll
                    for (int i = 0; i < 4; ++i) { const float gt = acc[ai][0][m][n][i], up = acc[ai][1][m][n][i]; o[n * 4 + i] = gt * sigmoidf_(gt) * up; }
                *(u32x4*)rowp = (u32x4){pk2(o[0], o[1]), pk2(o[2], o[3]), pk2(o[4], o[5]), pk2(o[6], o[7])}; }
    }
};
struct EpiLru {
    unsigned* LAB; const bf16_t* XC; const float* br; const float* bi; const float* nl8;
    __device__ __forceinline__ void operator()(const f32x4 (&acc)[2][2][4][2], const Unit& u, int wr, int wc, int fr, int fq) const {
        const int hd = u.pn >> 1, dir = u.pn & 1;
        const int row0 = u.pm * BM + wr * 64 + fr, ch0 = wc * 32 + 8 * fq, chan0 = hd * 128 + ch0;
        const float* brp = br + (dir * 8 + hd) * 128 + ch0; const float* bip = bi + (dir * 8 + hd) * 128 + ch0; const float* nlp = nl8 + dir * 1024 + chan0;
#pragma unroll
        for (int ai = 0; ai < 2; ++ai)
#pragma unroll
            for (int m = 0; m < 4; ++m) { const int row = row0 + ai * HALF + m * 16;
                const u32x4 xw = *(const u32x4*)(XC + (size_t)row * LRUW + chan0);
                unsigned* dst = LAB + ((size_t)row * 2 + dir) * LRUW + chan0;
#pragma unroll
                for (int n = 0; n < 2; ++n) { const f32x4 brv = *(const f32x4*)(brp + 4 * n), biv = *(const f32x4*)(bip + 4 * n), nlv = *(const f32x4*)(nlp + 4 * n);
                    unsigned o[4];
#pragma unroll
                    for (int i = 0; i < 4; ++i) { const int e = n * 4 + i;
                        const float xc = (e & 1) ? bfhi(xw[e >> 1]) : bflo(xw[e >> 1]);
                        const float rg = sigmoidf_(acc[ai][0][m][n][i] + brv[i]), ig = sigmoidf_(acc[ai][1][m][n][i] + biv[i]);
                        const float la = rg * nlv[i], x2 = 2.f * la;
                        const float om = (x2 > -0.1f) ? -x2 * (1.f + x2 * (0.5f + x2 * (0.16666667f + x2 * 0.041666668f))) : 1.f - __expf(x2);
                        const float bb = __builtin_amdgcn_sqrtf(om) * ig * xc;
                        o[i] = f2bf(la) | (f2bf(bb) << 16); }
                    *(u32x4*)(dst + 4 * n) = (u32x4){o[0], o[1], o[2], o[3]};
                    __builtin_amdgcn_sched_barrier(0); } }
    }
};
struct EpiLora {
    bf16_t* E; bf16_t* AA; bf16_t* Gt; const float* w0; const float* a0;
    __device__ __forceinline__ void operator()(const f32x4 (&acc)[2][2][4][2], const Unit& u, int wr, int wc, int fr, int fq) const {
        const int type = u.pn >> 2, d = type & 1;
        const int row0 = u.pm * BM + wr * 64 + fr;
        const float* bsrc = type < 2 ? w0 + d * RW : a0 + d * RW;
        bf16_t* obase = type < 2 ? E + d * RW : (type < 4 ? AA + d * RW : Gt);
        const int opitch = type < 4 ? 2 * RW : RW;
        const float sc = type < 2 ? 0.60653066f : 1.f;
#pragma unroll
        for (int bj = 0; bj < 2; ++bj) { const int ch0 = (u.pn & 3) * 256 + bj * HALF + wc * 32 + 8 * fq;
#pragma unroll
            for (int ai = 0; ai < 2; ++ai)
#pragma unroll
                for (int m = 0; m < 4; ++m) { const int row = row0 + ai * HALF + m * 16;
                    float o[8];
#pragma unroll
                    for (int n = 0; n < 2; ++n) { f32x4 bias = (f32x4){0.f, 0.f, 0.f, 0.f}; if (type < 4) bias = *(const f32x4*)(bsrc + ch0 + 4 * n);
#pragma unroll
                        for (int i = 0; i < 4; ++i) { const float z = acc[ai][bj][m][n][i] + bias[i]; o[n * 4 + i] = type < 4 ? sc * sigmoidf_(z) : z; } }
                    *(u32x4*)(obase + (size_t)row * opitch + ch0) = (u32x4){pk2(o[0], o[1]), pk2(o[2], o[3]), pk2(o[4], o[5]), pk2(o[6], o[7])};
                    __builtin_amdgcn_sched_barrier(0); } }
    }
};
}

__device__ __forceinline__ void xpose_tile(Frame& F, const float* src, int ldsrc, int ncols_valid, int k0, int n0, bf16_t* dst, int lddst, int drow0) {
    LAS bf16_t* t = (LAS bf16_t*)F.lds;
    const int tid = F.tid;
    { const int r = tid >> 4, c4 = (tid & 15) * 4;
#pragma unroll
      for (int rr = 0; rr < 2; ++rr) { const int k = r + rr * 32; float4 v = make_float4(0.f, 0.f, 0.f, 0.f);
          if (n0 + c4 < ncols_valid) v = *(const float4*)(src + (size_t)(k0 + k) * ldsrc + n0 + c4);
          t[(c4 + 0) * 72 + k] = (bf16_t)f2bf(v.x); t[(c4 + 1) * 72 + k] = (bf16_t)f2bf(v.y); t[(c4 + 2) * 72 + k] = (bf16_t)f2bf(v.z); t[(c4 + 3) * 72 + k] = (bf16_t)f2bf(v.w); } }
    __syncthreads();
    { const int n = tid >> 3, kc = (tid & 7) * 8;
      const u32x4 v = *(const LAS u32x4*)(t + n * 72 + kc);
      *(u32x4*)(dst + (size_t)(drow0 + n) * lddst + k0 + kc) = v; }
    __syncthreads();
}

__device__ __forceinline__ void p0_prologue(Frame& F) {
    const int tid = F.tid, G = F.G, bid = blockIdx.x;
    unsigned char* ws = F.ws;
    {
        LAS float* sv = (LAS float*)F.lds;
        LAS float* red = (LAS float*)(F.lds + 24576);
        const float* c = F.in[IN_C]; const float* cctx = F.in[IN_CCTX];
        for (int i = tid; i < 3 * D; i += 512) { const int r = i / D, k = i % D; const float cv = r == 0 ? cctx[k] : c[(r - 1) * D + k]; sv[i] = cv * sigmoidf_(cv); }
        __syncthreads();
        const float* wm = F.in[IN_WMOD]; const float* bm = F.in[IN_BMOD]; float* MOD = (float*)(ws + WS_MOD);
        for (int cb = bid; cb < 256; cb += G) {
            const int n0 = cb * 48;
            if (tid < 504) { const int cg4 = (tid % 12) * 4, kl = tid / 12;
                float a0[4] = {0, 0, 0, 0}, a1[4] = {0, 0, 0, 0}, a2[4] = {0, 0, 0, 0};
                for (int k = kl; k < D; k += 42) { const float4 w = *(const float4*)(wm + (size_t)k * 12288 + n0 + cg4);
                    const float s0 = sv[k], s1 = sv[D + k], s2 = sv[2 * D + k];
                    a0[0] += s0 * w.x; a0[1] += s0 * w.y; a0[2] += s0 * w.z; a0[3] += s0 * w.w;
                    a1[0] += s1 * w.x; a1[1] += s1 * w.y; a1[2] += s1 * w.z; a1[3] += s1 * w.w;
                    a2[0] += s2 * w.x; a2[1] += s2 * w.y; a2[2] += s2 * w.z; a2[3] += s2 * w.w; }
#pragma unroll
                for (int i = 0; i < 4; ++i) { red[(kl * 3 + 0) * 48 + cg4 + i] = a0[i]; red[(kl * 3 + 1) * 48 + cg4 + i] = a1[i]; red[(kl * 3 + 2) * 48 + cg4 + i] = a2[i]; } }
            __syncthreads();
            if (tid < 144) { const int r = tid / 48, j = tid % 48; float s = 0.f; for (int kl = 0; kl < 42; ++kl) s += red[(kl * 3 + r) * 48 + j]; MOD[r * 12288 + n0 + j] = s + bm[n0 + j]; }
            __syncthreads();
        }
    }
    {
        const int T_IN = 32 * 88, T_OUT = 32 * 32, T_GU = 32 * 176, T_DN = 88 * 32, T_ALL = T_IN + T_OUT + T_GU + T_DN;
        for (int ti = bid; ti < T_ALL; ti += G) {
            if (ti < T_IN) { const int kt = ti / 88, nt = ti % 88; xpose_tile(F, F.in[IN_WIN], INW, INW, kt * 64, nt * 64, (bf16_t*)(ws + WS_WTIN), D, nt * 64); }
            else if (ti < T_IN + T_OUT) { const int t2 = ti - T_IN, kt = t2 / 32, nt = t2 % 32; xpose_tile(F, F.in[IN_WOUT], D, D, kt * 64, nt * 64, (bf16_t*)(ws + WS_WTOUT), D, nt * 64); }
            else if (ti < T_IN + T_OUT + T_GU) { const int t2 = ti - T_IN - T_OUT, kt = t2 / 176, nt = t2 % 176, n0 = nt * 64;
                const int drow0 = n0 < FFH ? (n0 / 128) * 256 + (n0 % 128) : ((n0 - FFH) / 128) * 256 + 128 + ((n0 - FFH) % 128);
                xpose_tile(F, F.in[IN_WGU], 2 * FFH, 2 * FFH, kt * 64, n0, (bf16_t*)(ws + WS_WTGU), D, drow0); }
            else { const int t2 = ti - T_IN - T_OUT - T_GU, kt = t2 / 32, nt = t2 % 32; xpose_tile(F, F.in[IN_WDN], D, D, kt * 64, nt * 64, (bf16_t*)(ws + WS_WTDN), FFH, nt * 64); }
        }
    }
    {
        const size_t gt = (size_t)bid * 512 + tid, gs = (size_t)G * 512;
        bf16_t* btl = (bf16_t*)(ws + WS_BTLRU);
        const float* wr = F.in[IN_WR]; const float* wi = F.in[IN_WI];
        for (size_t idx = gt; idx < (size_t)4096 * 256; idx += gs) { const int row = (int)(idx >> 8), col = (int)(idx & 255);
            const int hd = row >> 9, q = (row >> 7) & 3, j = row & 127, koff = hd < 7 ? 128 * hd : 768, kk = col - (128 * hd - koff);
            float v = 0.f;
            if (kk >= 0 && kk < 128) { const int d = q >> 1; const float* W = (q & 1) ? wi : wr; v = W[((size_t)(d * 8 + hd) * 128 + kk) * 128 + j]; }
            btl[idx] = (bf16_t)f2bf(v); }
        bf16_t* bto = (bf16_t*)(ws + WS_BTLORA);
        const float* wup = F.in[IN_WUP]; const float* aup = F.in[IN_AUP]; const float* gup = F.in[IN_GUP];
        for (size_t idx = gt; idx < (size_t)5120 * LAK; idx += gs) { const int n = (int)(idx / LAK), k = (int)(idx % LAK);
            float v = 0.f;
            if (n < 2048) { if (k < 64) v = wup[((size_t)(n >> 10) * 64 + k) * RW + (n & 1023)]; }
            else if (n < 4096) { if (k >= 64 && k < 128) v = aup[((size_t)((n - 2048) >> 10) * 64 + (k - 64)) * RW + (n & 1023)]; }
            else { if (k >= 128 && k < 288) v = gup[(size_t)(k - 128) * RW + (n - 4096)]; }
            bto[idx] = (bf16_t)f2bf(v); }
        float* nl8 = (float*)(ws + WS_NL8); const float* lam = F.in[IN_LAM];
        for (size_t idx = gt; idx < 2048; idx += gs) { const float l = lam[idx]; nl8[idx] = -8.f * log1pf(__expf(-l)); }
    }
}

__device__ __forceinline__ void p1_normmod(Frame& F) {
    const float* MOD = (const float*)(F.ws + WS_MOD); const float* g1 = F.in[IN_NMPRE]; bf16_t* H = (bf16_t*)(F.ws + WS_H);
    for (int row = blockIdx.x * 8 + F.wave; row < NTOK; row += F.G * 8) {
        const float* xr = row < NPTOK ? F.in[IN_XP] + (size_t)row * D : F.in[IN_XS] + (size_t)(row - NPTOK) * D;
        float4 v[8]; float ss = 0.f;
#pragma unroll
        for (int i = 0; i < 8; ++i) { v[i] = *(const float4*)(xr + (i * 64 + F.lane) * 4); ss += v[i].x * v[i].x + v[i].y * v[i].y + v[i].z * v[i].z + v[i].w * v[i].w; }
        ss = wave_sum(ss);
        const float rstd = rsqrtf(ss * (1.f / D) + 1e-6f);
        const float* md = MOD + modidx(row) * 12288;
#pragma unroll
        for (int i = 0; i < 8; ++i) { const int col = (i * 64 + F.lane) * 4;
            const float4 g = *(const float4*)(g1 + col), sc = *(const float4*)(md + D + col), sh = *(const float4*)(md + col);
            const float h0 = v[i].x * rstd * g.x * (1.f + sc.x) + sh.x, h1 = v[i].y * rstd * g.y * (1.f + sc.y) + sh.y;
            const float h2 = v[i].z * rstd * g.z * (1.f + sc.z) + sh.z, h3 = v[i].w * rstd * g.w * (1.f + sc.w) + sh.w;
            *(u32x2*)(H + (size_t)row * D + col) = (u32x2){pk2(h0, h1), pk2(h2, h3)}; }
    }
}

struct NbrOff { int o0, o1, o2, o3; };
__device__ __forceinline__ NbrOff nbr_offsets(int g) {
    NbrOff n;
    if (g < NPTOK) { const int t = g & (PSEQ - 1); n.o0 = t >= 1 ? -1 : 0; n.o1 = t < PSEQ - 1 ? 1 : 0; n.o2 = 0; n.o3 = 0; }
    else { const int t = (g - NPTOK) & (SSEQ - 1), row = t >> 6, col = t & 63; n.o0 = col >= 1 ? -1 : 0; n.o1 = col < 63 ? 1 : 0; n.o2 = row >= 1 ? -64 : 0; n.o3 = row < 63 ? 64 : 0; }
    return n;
}
__device__ __forceinline__ int nbr_kind(bool sample, int j) { return sample ? (j < 840 ? 0 : (j < 1680 ? 1 : (j < 2520 ? 2 : 3))) : (j < 1680 ? 0 : 1); }
__device__ __forceinline__ int nbr_pick(const NbrOff& n, int kind) { return kind == 0 ? n.o0 : (kind == 1 ? n.o1 : (kind == 2 ? n.o2 : n.o3)); }
__device__ __forceinline__ float mixed_val(const bf16_t* PR, int g, int j, int off, float mu) {
    const float p = bf2f(PR[(size_t)g * INWP + j]);
    const float q = off ? bf2f(PR[(size_t)(g + off) * INWP + j]) : 0.f;
    return p + mu * (q - p);
}

__device__ __forceinline__ void p3_elem(Frame& F) {
    const bf16_t* PROJ = (const bf16_t*)(F.ws + WS_PROJ); const bf16_t* PR = PROJ + 2048;
    bf16_t* XC = (bf16_t*)(F.ws + WS_XC); bf16_t* LA = (bf16_t*)(F.ws + WS_LA);
    const float* cw = F.in[IN_CONVW]; const float* cb = F.in[IN_CONVB]; const float* mu = F.in[IN_MU];
    const int lane = F.lane;
    for (int g = blockIdx.x * 8 + F.wave; g < NTOK; g += F.G * 8) {
        const bool sample = g >= NPTOK; const int T = sample ? SSEQ : PSEQ, t = sample ? ((g - NPTOK) & (SSEQ - 1)) : (g & (PSEQ - 1));
#pragma unroll
        for (int half = 0; half < 2; ++half) { const int c0 = half * 512 + lane * 8;
            float o[8];
#pragma unroll
            for (int i = 0; i < 8; ++i) o[i] = cb[c0 + i];
#pragma unroll
            for (int k = 0; k < 4; ++k) { const int tt = t + k - 2;
                if (tt >= 0 && tt < T) { const u32x4 w = *(const u32x4*)(PROJ + (size_t)(g + k - 2) * INWP + c0);
                    const float4 w0 = *(const float4*)(cw + k * LRUW + c0), w1 = *(const float4*)(cw + k * LRUW + c0 + 4);
                    o[0] += bflo(w[0]) * w0.x; o[1] += bfhi(w[0]) * w0.y; o[2] += bflo(w[1]) * w0.z; o[3] += bfhi(w[1]) * w0.w;
                    o[4] += bflo(w[2]) * w1.x; o[5] += bfhi(w[2]) * w1.y; o[6] += bflo(w[3]) * w1.z; o[7] += bfhi(w[3]) * w1.w; } }
            *(u32x4*)(XC + (size_t)g * LRUW + c0) = (u32x4){pk2(o[0], o[1]), pk2(o[2], o[3]), pk2(o[4], o[5]), pk2(o[6], o[7])}; }
        const NbrOff no = nbr_offsets(g);
#pragma unroll
        for (int i = 0; i < 6; ++i) { const int jj = lane + 64 * i;
            if (jj < LAK) { float v = 0.f;
                if (jj < 288) { const int j = 3072 + jj; const float m = mixed_val(PR, g, j, nbr_pick(no, nbr_kind(sample, j)), mu[j]);
                    v = jj < 64 ? tanhf(m) : (jj < 128 ? m : sigmoidf_(m)); }
                LA[(size_t)g * LAK + jj] = (bf16_t)f2bf(v); } }
    }
}

__device__ __forceinline__ void p5_lru_scan(Frame& F) {
    const unsigned* LAB = (const unsigned*)F.out;
    const bf16_t* PROJ = (const bf16_t*)(F.ws + WS_PROJ); bf16_t* MIX = (bf16_t*)(F.ws + WS_H);
    LAS float* cinF = (LAS float*)F.lds;
    LAS float* cinB = (LAS float*)(F.lds + 32768);
    LAS float* aggA = (LAS float*)(F.lds + 65536);
    LAS float* aggB = (LAS float*)(F.lds + 65536 + 2048);
    LAS float* segc = (LAS float*)(F.lds + 65536 + 4096);
    const int tid = F.tid, c = tid >> 6, ch = tid & 63;
    float* nsl = F.out + (size_t)2 * NPTOK * D;
    for (int u = blockIdx.x; u < 32 + 512; u += F.G) {
        const bool sample = u < 32; const int uu = sample ? u : u - 32;
        const int b = uu >> 4, cgp = uu & 15, chan = cgp * 64 + ch;
        const int nseg = sample ? 16 : 1, g0 = sample ? NPTOK + b * SSEQ : b * PSEQ;
        for (int dir = 0; dir < 2; ++dir) {
            LAS float* cin = dir ? cinB : cinF;
            if (c == 0) segc[ch] = sample ? F.in[IN_SLRU][(b * 2 + dir) * LRUW + chan] : 0.f;
            __syncthreads();
            for (int si = 0; si < nseg; ++si) { const int s = dir ? nseg - 1 - si : si;
                const unsigned* p = LAB + ((size_t)(g0 + s * 256 + c * 32) * 2 + dir) * LRUW + chan;
                float A = 1.f, B = 0.f;
#pragma unroll 8
                for (int i = 0; i < 32; ++i) { const int ii = dir ? 31 - i : i; const unsigned w = p[(size_t)ii * 2 * LRUW];
                    const float a = __expf(bflo(w)), bb = bfhi(w); B = a * B + bb; A *= a; }
                aggA[c * 64 + ch] = A; aggB[c * 64 + ch] = B;
                __syncthreads();
                if (c == 0) { float carry = segc[ch];
                    for (int k = 0; k < 8; ++k) { const int cc = dir ? 7 - k : k; cin[(s * 8 + cc) * 64 + ch] = carry; carry = aggA[cc * 64 + ch] * carry + aggB[cc * 64 + ch]; }
                    segc[ch] = carry; }
                __syncthreads();
            }
            if (!sample && c == 0) nsl[(size_t)(b * 2 + dir) * LRUW + chan] = segc[ch];
            __syncthreads();
        }
        for (int s = 0; s < nseg; ++s) {
            const int gb = g0 + s * 256 + c * 32;
            const unsigned* pf = LAB + ((size_t)gb * 2 + 0) * LRUW + chan;
            const unsigned* pb = LAB + ((size_t)gb * 2 + 1) * LRUW + chan;
            float hf[32]; float h = cinF[(s * 8 + c) * 64 + ch];
#pragma unroll
            for (int i = 0; i < 32; ++i) { const unsigned w = pf[(size_t)i * 2 * LRUW]; h = __expf(bflo(w)) * h + bfhi(w); hf[i] = h; }
            h = cinB[(s * 8 + c) * 64 + ch];
#pragma unroll
            for (int i = 31; i >= 0; --i) { const unsigned w = pb[(size_t)i * 2 * LRUW]; h = __expf(bflo(w)) * h + bfhi(w);
                const float gl = bf2f(PROJ[(size_t)(gb + i) * INWP + LRUW + chan]);
                MIX[(size_t)(gb + i) * D + chan] = (bf16_t)f2bf((hf[i] + h) * gelu_tanh(gl)); }
        }
        __syncthreads();
    }
}

struct WkvJob { int g0; int gstep; bool sample; int h; int dir; const float* S0; float* Sout; bf16_t* Y; int ypitch; };
constexpr int WNS = 4;
template <int KIND, bool HAS_S0>
__device__ __forceinline__ void wkv_unit(Frame& F, const WkvJob& J) {
    const int lane = F.lane, vi = lane >> 3, ki = lane & 7;
    LAS float* L = (LAS float*)(F.lds + F.wave * 6144);
    const bf16_t* PR = (const bf16_t*)(F.ws + WS_PROJ) + 2048;
    const bf16_t* Eb = (const bf16_t*)F.out; const bf16_t* Ab = Eb + (size_t)NTOK * 2 * RW;
    const int chan = J.h * 64 + lane, dir = J.dir;
    const float mu_r = F.in[IN_MU][chan], mu_k = F.in[IN_MU][1024 + chan], mu_v = F.in[IN_MU][2048 + chan];
    const int kd_r = nbr_kind(J.sample, chan), kd_k = nbr_kind(J.sample, 1024 + chan), kd_v = nbr_kind(J.sample, 2048 + chan);
    const float k_k = F.in[IN_KK][chan], k_a = F.in[IN_KA][chan];
    float S[8][8];
    if (HAS_S0) {
#pragma unroll
        for (int i = 0; i < 8; ++i) { const float4 a = *(const float4*)(J.S0 + (vi * 8 + i) * 64 + ki * 8), b = *(const float4*)(J.S0 + (vi * 8 + i) * 64 + ki * 8 + 4);
            S[i][0] = a.x; S[i][1] = a.y; S[i][2] = a.z; S[i][3] = a.w; S[i][4] = b.x; S[i][5] = b.y; S[i][6] = b.z; S[i][7] = b.w; }
    } else {
#pragma unroll
        for (int i = 0; i < 8; ++i)
#pragma unroll
            for (int j = 0; j < 8; ++j) S[i][j] = (KIND == 1 && vi == ki && i == j) ? 1.f : 0.f;
    }
    unsigned short ro[WNS], rn[WNS], ko[WNS], kn[WNS], vo[WNS], vn[WNS], ee[WNS], aa[WNS];
#define WKV_FETCH(mc) do { _Pragma("unroll") for (int s = 0; s < WNS; ++s) { const int g = J.g0 + ((mc) * WNS + s) * J.gstep; const NbrOff no = nbr_offsets(g); \
        const int ofr = nbr_pick(no, kd_r), ofk = nbr_pick(no, kd_k), ofv = nbr_pick(no, kd_v); \
        const bf16_t* pg = PR + (size_t)g * INWP; \
        ro[s] = pg[chan]; rn[s] = pg[(ptrdiff_t)ofr * INWP + chan]; ko[s] = pg[1024 + chan]; kn[s] = pg[(ptrdiff_t)ofk * INWP + 1024 + chan]; \
        if (KIND != 1) { vo[s] = pg[2048 + chan]; vn[s] = pg[(ptrdiff_t)ofv * INWP + 2048 + chan]; } \
        ee[s] = Eb[((size_t)g * 2 + dir) * RW + chan]; aa[s] = Ab[((size_t)g * 2 + dir) * RW + chan]; } } while (0)
#define WKV_CONVERT(mc) do { _Pragma("unroll") for (int s = 0; s < WNS; ++s) { const NbrOff no = nbr_offsets(J.g0 + ((mc) * WNS + s) * J.gstep); \
        const int ofr = nbr_pick(no, kd_r), ofk = nbr_pick(no, kd_k), ofv = nbr_pick(no, kd_v); \
        const float r0 = bf2f(ro[s]), r1 = ofr ? bf2f(rn[s]) : 0.f, k0 = bf2f(ko[s]), k1 = ofk ? bf2f(kn[s]) : 0.f; \
        const float r = r0 + mu_r * (r1 - r0), k = k0 + mu_k * (k1 - k0); \
        float kk = k * k_k; const float ssq = wave_sum(kk * kk); kk *= rsqrtf(fmaxf(ssq, 1e-24f)); \
        const float a = bf2f(aa[s]), w = __expf(-bf2f(ee[s])); \
        L[(0 * WNS + s) * 64 + lane] = w; L[(1 * WNS + s) * 64 + lane] = kk; L[(2 * WNS + s) * 64 + lane] = kk * a; \
        L[(3 * WNS + s) * 64 + lane] = k * (1.f + (a - 1.f) * k_a); L[(4 * WNS + s) * 64 + lane] = r; \
        if (KIND != 1) { const float v0 = bf2f(vo[s]), v1 = ofv ? bf2f(vn[s]) : 0.f; L[(5 * WNS + s) * 64 + lane] = v0 + mu_v * (v1 - v0); } } } while (0)
    WKV_FETCH(0);
    WKV_CONVERT(0);
    for (int mc = 0; mc < 256 / WNS; ++mc) {
        if (mc + 1 < 256 / WNS) WKV_FETCH(mc + 1);
#pragma unroll 2
        for (int s = 0; s < WNS; ++s) {
            float w[8], kk[8], kka[8], kd[8], r[8], v[8];
#define WKV_LD8(dst, arr, off) do { const f32x4 _a = *(const LAS f32x4*)(L + ((arr) * WNS + s) * 64 + (off)), _b = *(const LAS f32x4*)(L + ((arr) * WNS + s) * 64 + (off) + 4); \
            dst[0] = _a[0]; dst[1] = _a[1]; dst[2] = _a[2]; dst[3] = _a[3]; dst[4] = _b[0]; dst[5] = _b[1]; dst[6] = _b[2]; dst[7] = _b[3]; } while (0)
            WKV_LD8(w, 0, ki * 8); WKV_LD8(kk, 1, ki * 8); WKV_LD8(kka, 2, ki * 8);
            if (KIND != 1) { WKV_LD8(kd, 3, ki * 8); WKV_LD8(v, 5, vi * 8); }
            if (KIND == 0) WKV_LD8(r, 4, ki * 8);
            float sa[8];
#pragma unroll
            for (int i = 0; i < 8; ++i) { float t = 0.f;
#pragma unroll
                for (int j = 0; j < 8; ++j) t = fmaf(S[i][j], kk[j], t);
                sa[i] = -red8(t); }
#pragma unroll
            for (int i = 0; i < 8; ++i)
#pragma unroll
                for (int j = 0; j < 8; ++j) { float t = sa[i] * kka[j]; if (KIND != 1) t = fmaf(v[i], kd[j], t); S[i][j] = fmaf(S[i][j], w[j], t); }
            if (KIND == 0) {
                float y[8];
#pragma unroll
                for (int i = 0; i < 8; ++i) { float t = 0.f;
#pragma unroll
                    for (int j = 0; j < 8; ++j) t = fmaf(S[i][j], r[j], t);
                    y[i] = red8(t); }
                if (ki == 0) { const int g = J.g0 + (mc * WNS + s) * J.gstep;
                    *(u32x4*)(J.Y + (size_t)g * J.ypitch + J.h * 64 + vi * 8) = (u32x4){pk2(y[0], y[1]), pk2(y[2], y[3]), pk2(y[4], y[5]), pk2(y[6], y[7])}; }
            }
        }
        if (mc + 1 < 256 / WNS) WKV_CONVERT(mc + 1);
    }
    if (J.Sout) {
#pragma unroll
        for (int i = 0; i < 8; ++i) { float* d = J.Sout + (vi * 8 + i) * 64 + ki * 8;
            *(float4*)d = make_float4(S[i][0], S[i][1], S[i][2], S[i][3]); *(float4*)(d + 4) = make_float4(S[i][4], S[i][5], S[i][6], S[i][7]); }
    }
#undef WKV_FETCH
#undef WKV_CONVERT
#undef WKV_LD8
}

__device__ __forceinline__ void p7_wkv_pass1(Frame& F) {
    float* PQ = (float*)(F.ws + WS_PQ); float* nsw = F.out + (size_t)2 * NPTOK * D + 32 * 2 * LRUW;
    bf16_t* MIX = (bf16_t*)(F.ws + WS_H); bf16_t* YB = (bf16_t*)(F.ws + WS_YB);
    for (int u = blockIdx.x * 8 + F.wave; u < 3072; u += F.G * 8) {
        WkvJob J;
        if (u < 1024) { const int h = u & 15, dir = (u >> 4) & 1, b = u >> 5;
            J.sample = false; J.h = h; J.dir = dir; J.g0 = b * PSEQ + (dir ? PSEQ - 1 : 0); J.gstep = dir ? -1 : 1; J.S0 = nullptr;
            J.Sout = nsw + (size_t)((b * 2 + dir) * 16 + h) * 4096; J.Y = dir ? YB : MIX + 1024; J.ypitch = dir ? RW : D;
            wkv_unit<0, false>(F, J);
        } else { const int u2 = u - 1024, h = u2 & 15, pq = (u2 >> 4) & 1, dir = (u2 >> 5) & 1, chunk = (u2 >> 6) & 15, b = u2 >> 10;
            const int tt0 = chunk * 256, t0 = dir ? SSEQ - 1 - tt0 : tt0;
            J.sample = true; J.h = h; J.dir = dir; J.g0 = NPTOK + b * SSEQ + t0; J.gstep = dir ? -1 : 1; J.S0 = nullptr; J.Y = nullptr; J.ypitch = 0;
            const int chain = (b * 2 + dir) * 16 + h;
            J.Sout = PQ + ((size_t)(chain * 16 + chunk) * 2 + pq) * 4096;
            if (pq == 0) wkv_unit<1, false>(F, J); else wkv_unit<2, false>(F, J);
        }
    }
}
__device__ __forceinline__ void p8_wkv_combine(Frame& F) {
    float* PQ = (float*)(F.ws + WS_PQ);
    LAS float* Sl = (LAS float*)F.lds; LAS float* Pl = (LAS float*)(F.lds + 16384);
    const int tid = F.tid, v = tid >> 3, kq = tid & 7;
    for (int chain = blockIdx.x; chain < 64; chain += F.G) {
        const float* s0 = F.in[IN_SWKV] + (size_t)chain * 4096;
        __syncthreads();
        { const float4 a = *(const float4*)(s0 + tid * 8), b = *(const float4*)(s0 + tid * 8 + 4);
          *(LAS f32x4*)(Sl + tid * 8) = (f32x4){a.x, a.y, a.z, a.w}; *(LAS f32x4*)(Sl + tid * 8 + 4) = (f32x4){b.x, b.y, b.z, b.w}; }
        for (int c = 0; c < 15; ++c) {
            const float* Pc = PQ + ((size_t)(chain * 16 + c) * 2 + 0) * 4096; float* Qc = PQ + ((size_t)(chain * 16 + c) * 2 + 1) * 4096;
            { const float4 a = *(const float4*)(Pc + tid * 8), b = *(const float4*)(Pc + tid * 8 + 4);
              *(LAS f32x4*)(Pl + tid * 8) = (f32x4){a.x, a.y, a.z, a.w}; *(LAS f32x4*)(Pl + tid * 8 + 4) = (f32x4){b.x, b.y, b.z, b.w}; }
            float acc[8];
            { const float4 a = *(const float4*)(Qc + v * 64 + kq * 8), b = *(const float4*)(Qc + v * 64 + kq * 8 + 4);
              acc[0] = a.x; acc[1] = a.y; acc[2] = a.z; acc[3] = a.w; acc[4] = b.x; acc[5] = b.y; acc[6] = b.z; acc[7] = b.w; }
            __syncthreads();
            for (int k = 0; k < 64; ++k) { const float s = Sl[v * 64 + k]; const f32x4 p0 = *(const LAS f32x4*)(Pl + k * 64 + kq * 8), p1 = *(const LAS f32x4*)(Pl + k * 64 + kq * 8 + 4);
                acc[0] += s * p0[0]; acc[1] += s * p0[1]; acc[2] += s * p0[2]; acc[3] += s * p0[3]; acc[4] += s * p1[0]; acc[5] += s * p1[1]; acc[6] += s * p1[2]; acc[7] += s * p1[3]; }
            __syncthreads();
            *(LAS f32x4*)(Sl + v * 64 + kq * 8) = (f32x4){acc[0], acc[1], acc[2], acc[3]}; *(LAS f32x4*)(Sl + v * 64 + kq * 8 + 4) = (f32x4){acc[4], acc[5], acc[6], acc[7]};
            *(float4*)(Qc + v * 64 + kq * 8) = make_float4(acc[0], acc[1], acc[2], acc[3]); *(float4*)(Qc + v * 64 + kq * 8 + 4) = make_float4(acc[4], acc[5], acc[6], acc[7]);
            __syncthreads();
        }
    }
}
__device__ __forceinline__ void p9_wkv_pass3(Frame& F) {
    float* PQ = (float*)(F.ws + WS_PQ); bf16_t* MIX = (bf16_t*)(F.ws + WS_H); bf16_t* YB = (bf16_t*)(F.ws + WS_YB);
    if (F.wave >= 4) return;
    for (int u = blockIdx.x * 4 + F.wave; u < 1024; u += F.G * 4) {
        const int h = u & 15, dir = (u >> 4) & 1, chunk = (u >> 5) & 15, b = u >> 9;
        const int tt0 = chunk * 256, t0 = dir ? SSEQ - 1 - tt0 : tt0, chain = (b * 2 + dir) * 16 + h;
        WkvJob J; J.sample = true; J.h = h; J.dir = dir; J.g0 = NPTOK + b * SSEQ + t0; J.gstep = dir ? -1 : 1;
        J.S0 = chunk == 0 ? F.in[IN_SWKV] + (size_t)chain * 4096 : PQ + ((size_t)(chain * 16 + chunk - 1) * 2 + 1) * 4096;
        J.Sout = nullptr; J.Y = dir ? YB : MIX + 1024; J.ypitch = dir ? RW : D;
        wkv_unit<0, true>(F, J);
    }
}

__device__ __forceinline__ void p10_wkv_finish(Frame& F) {
    const bf16_t* PR = (const bf16_t*)(F.ws + WS_PROJ) + 2048; bf16_t* MIX = (bf16_t*)(F.ws + WS_H);
    const bf16_t* YB = (const bf16_t*)(F.ws + WS_YB); const bf16_t* Gt = (const bf16_t*)(F.ws + WS_G);
    const float* mu = F.in[IN_MU]; const float* rk = F.in[IN_RK]; const float* lnw = F.in[IN_LNW]; const float* lnb = F.in[IN_LNB];
    const int lane = F.lane;
    for (int g = blockIdx.x * 8 + F.wave; g < NTOK; g += F.G * 8) {
        const bool sample = g >= NPTOK; const NbrOff no = nbr_offsets(g);
#pragma unroll 4
        for (int h = 0; h < NH; ++h) { const int chan = h * 64 + lane;
            const float r = mixed_val(PR, g, chan, nbr_pick(no, nbr_kind(sample, chan)), mu[chan]);
            const float k = mixed_val(PR, g, 1024 + chan, nbr_pick(no, nbr_kind(sample, 1024 + chan)), mu[1024 + chan]);
            const float v = mixed_val(PR, g, 2048 + chan, nbr_pick(no, nbr_kind(sample, 2048 + chan)), mu[2048 + chan]);
            const float yf = bf2f(MIX[(size_t)g * D + 1024 + chan]), yb = bf2f(YB[(size_t)g * RW + chan]);
            const float bon = wave_sum(r * k * rk[chan]);
            const float y = yf + yb + bon * v;
            const float mean = wave_sum(y) * (1.f / 64.f); const float dlt = y - mean;
            const float var = wave_sum(dlt * dlt) * (1.f / 64.f);
            const float yn = dlt * rsqrtf(var + 64e-5f) * lnw[chan] + lnb[chan];
            MIX[(size_t)g * D + 1024 + chan] = (bf16_t)f2bf(yn * bf2f(Gt[(size_t)g * RW + chan])); }
    }
}

__device__ __forceinline__ void p12_rows(Frame& F) {
    const float* MOD = (const float*)(F.ws + WS_MOD); const bf16_t* OUTB = (const bf16_t*)(F.ws + WS_PROJ); bf16_t* H2 = (bf16_t*)(F.ws + WS_H);
    const float* gpost = F.in[IN_NMPOST]; const float* gpre = F.in[IN_NFPRE];
    for (int row = blockIdx.x * 8 + F.wave; row < NTOK; row += F.G * 8) {
        const float* xr = row < NPTOK ? F.in[IN_XP] + (size_t)row * D : F.in[IN_XS] + (size_t)(row - NPTOK) * D;
        const float* md = MOD + modidx(row) * 12288;
        float o[32]; float ss = 0.f;
#pragma unroll
        for (int i = 0; i < 4; ++i) { const u32x4 w = *(const u32x4*)(OUTB + (size_t)row * D + (i * 64 + F.lane) * 8);
#pragma unroll
            for (int j = 0; j < 4; ++j) { o[i * 8 + 2 * j] = bflo(w[j]); o[i * 8 + 2 * j + 1] = bfhi(w[j]); }
#pragma unroll
            for (int j = 0; j < 8; ++j) ss += o[i * 8 + j] * o[i * 8 + j]; }
        ss = wave_sum(ss);
        const float rstd = rsqrtf(ss * (1.f / D) + 1e-6f);
        float ss2 = 0.f;
#pragma unroll
        for (int i = 0; i < 4; ++i) { const int col = (i * 64 + F.lane) * 8;
#pragma unroll
            for (int q = 0; q < 2; ++q) { const int c4 = col + q * 4;
                const float4 x = *(const float4*)(xr + c4), gp = *(const float4*)(gpost + c4), gm = *(const float4*)(md + 2 * D + c4);
                float4 r;
                r.x = x.x + gm.x * (o[i * 8 + q * 4 + 0] * rstd * gp.x); r.y = x.y + gm.y * (o[i * 8 + q * 4 + 1] * rstd * gp.y);
                r.z = x.z + gm.z * (o[i * 8 + q * 4 + 2] * rstd * gp.z); r.w = x.w + gm.w * (o[i * 8 + q * 4 + 3] * rstd * gp.w);
                *(float4*)(F.out + (size_t)row * D + c4) = r;
                o[i * 8 + q * 4 + 0] = r.x; o[i * 8 + q * 4 + 1] = r.y; o[i * 8 + q * 4 + 2] = r.z; o[i * 8 + q * 4 + 3] = r.w;
                ss2 += r.x * r.x + r.y * r.y + r.z * r.z + r.w * r.w; } }
        ss2 = wave_sum(ss2);
        const float rstd2 = rsqrtf(ss2 * (1.f / D) + 1e-6f);
#pragma unroll
        for (int i = 0; i < 4; ++i) { const int col = (i * 64 + F.lane) * 8; float hh[8];
#pragma unroll
            for (int q = 0; q < 2; ++q) { const int c4 = col + q * 4;
                const float4 g = *(const float4*)(gpre + c4), sc = *(const float4*)(md + 4 * D + c4), sh = *(const float4*)(md + 3 * D + c4);
                hh[q * 4 + 0] = o[i * 8 + q * 4 + 0] * rstd2 * g.x * (1.f + sc.x) + sh.x; hh[q * 4 + 1] = o[i * 8 + q * 4 + 1] * rstd2 * g.y * (1.f + sc.y) + sh.y;
                hh[q * 4 + 2] = o[i * 8 + q * 4 + 2] * rstd2 * g.z * (1.f + sc.z) + sh.z; hh[q * 4 + 3] = o[i * 8 + q * 4 + 3] * rstd2 * g.w * (1.f + sc.w) + sh.w; }
            *(u32x4*)(H2 + (size_t)row * D + col) = (u32x4){pk2(hh[0], hh[1]), pk2(hh[2], hh[3]), pk2(hh[4], hh[5]), pk2(hh[6], hh[7])}; }
    }
}
__device__ __forceinline__ void p15_rows(Frame& F) {
    const float* MOD = (const float*)(F.ws + WS_MOD); const bf16_t* Fb = (const bf16_t*)(F.ws + WS_H); const float* gpost = F.in[IN_NFPOST];
    for (int row = blockIdx.x * 8 + F.wave; row < NTOK; row += F.G * 8) {
        const float* md = MOD + modidx(row) * 12288;
        float o[32]; float ss = 0.f;
#pragma unroll
        for (int i = 0; i < 4; ++i) { const u32x4 w = *(const u32x4*)(Fb + (size_t)row * D + (i * 64 + F.lane) * 8);
#pragma unroll
            for (int j = 0; j < 4; ++j) { o[i * 8 + 2 * j] = bflo(w[j]); o[i * 8 + 2 * j + 1] = bfhi(w[j]); }
#pragma unroll
            for (int j = 0; j < 8; ++j) ss += o[i * 8 + j] * o[i * 8 + j]; }
        ss = wave_sum(ss);
        const float rstd = rsqrtf(ss * (1.f / D) + 1e-6f);
#pragma unroll
        for (int i = 0; i < 4; ++i) { const int col = (i * 64 + F.lane) * 8;
#pragma unroll
            for (int q = 0; q < 2; ++q) { const int c4 = col + q * 4; float* yp = F.out + (size_t)row * D + c4;
                const float4 x = *(const float4*)yp, gp = *(const float4*)(gpost + c4), gf = *(const float4*)(md + 5 * D + c4);
                float4 r;
                r.x = x.x + gf.x * (o[i * 8 + q * 4 + 0] * rstd * gp.x); r.y = x.y + gf.y * (o[i * 8 + q * 4 + 1] * rstd * gp.y);
                r.z = x.z + gf.z * (o[i * 8 + q * 4 + 2] * rstd * gp.z); r.w = x.w + gf.w * (o[i * 8 + q * 4 + 3] * rstd * gp.w);
                *(float4*)yp = r; } }
    }
}

constexpr int LDS_MISC = 131072, LDS_BYTES = 131072 + 256;
__global__ void __launch_bounds__(512, 2) fwd_kernel(Args args) {
    extern __shared__ __attribute__((aligned(16))) unsigned char lds_raw[];
    Frame F;
    F.lds = (LAS unsigned char*)lds_raw;
    F.tid = threadIdx.x; F.lane = F.tid & 63; F.wave = __builtin_amdgcn_readfirstlane(F.tid >> 6); F.G = gridDim.x;
    F.in = args.in; F.out = args.out; F.ws = args.ws;
    volatile LAS unsigned* MISC = (volatile LAS unsigned*)(F.lds + LDS_MISC);
    const int lo = args.ph_lo, hi = args.ph_hi;
    const bool fused = (hi - lo) > 1;
    if (F.tid < 64) MISC[F.tid] = 0u;
    __syncthreads();
    XcdBarrier bar; bar.bar = (unsigned*)(F.ws + WS_CTL); bar.x = 0; bar.st = MISC;
    if (fused) bar = xcd_barrier_post((unsigned*)(F.ws + WS_CTL), MISC);
#ifndef PH_MASK
#define PH_MASK 0xFFFF
#endif
#define IN(k) (((PH_MASK >> (k)) & 1) && lo <= (k) && (k) < hi)
#define SEAM(k) do { if (IN(k) && IN((k) + 1)) { if (MK_CG_FIRST && (k) == 0) { cg::this_grid().sync(); } else xcd_barrier(bar); } } while (0)
    unsigned char* ws = F.ws;
    if (IN(0)) p0_prologue(F);
    SEAM(0);
    if (IN(1)) p1_normmod(F);
    SEAM(1);
    if (IN(2)) { pg8::Gemm g{(const bf16_t*)(ws + WS_H), (const bf16_t*)(ws + WS_WTIN), D, D, D, 0}; pg8::StaticOrder S; S.init(NTOK, INWP, F.G, blockIdx.x);
        pg8::EpiBf16 E{(bf16_t*)(ws + WS_PROJ), INWP}; pg8::gemm_phase(F.lds, g, S, E); }
    SEAM(2);
    if (IN(3)) p3_elem(F);
    SEAM(3);
    if (IN(4)) { pg8::Gemm g{(const bf16_t*)(ws + WS_XC), (const bf16_t*)(ws + WS_BTLRU), LRUW, 256, 256, 1}; pg8::StaticOrder S; S.init(NTOK, 4096, F.G, blockIdx.x);
        pg8::EpiLru E{(unsigned*)F.out, (const bf16_t*)(ws + WS_XC), F.in[IN_BR], F.in[IN_BI], (const float*)(ws + WS_NL8)}; pg8::gemm_phase(F.lds, g, S, E); }
    SEAM(4);
    if (IN(5)) p5_lru_scan(F);
    SEAM(5);
    if (IN(6)) { pg8::Gemm g{(const bf16_t*)(ws + WS_LA), (const bf16_t*)(ws + WS_BTLORA), LAK, LAK, LAK, 0}; pg8::StaticOrder S; S.init(NTOK, 5120, F.G, blockIdx.x);
        pg8::EpiLora E{(bf16_t*)F.out, (bf16_t*)F.out + (size_t)NTOK * 2 * RW, (bf16_t*)(ws + WS_G), F.in[IN_W0], F.in[IN_A0]}; pg8::gemm_phase(F.lds, g, S, E); }
    SEAM(6);
    if (IN(7)) p7_wkv_pass1(F);
    SEAM(7);
    if (IN(8)) p8_wkv_combine(F);
    SEAM(8);
    if (IN(9)) p9_wkv_pass3(F);
    SEAM(9);
    if (IN(10)) p10_wkv_finish(F);
    SEAM(10);
    if (IN(11)) { pg8::Gemm g{(const bf16_t*)(ws + WS_H), (const bf16_t*)(ws + WS_WTOUT), D, D, D, 0}; pg8::StaticOrder S; S.init(NTOK, D, F.G, blockIdx.x);
        pg8::EpiBf16 E{(bf16_t*)(ws + WS_PROJ), D}; pg8::gemm_phase(F.lds, g, S, E); }
    SEAM(11);
    if (IN(12)) p12_rows(F);
    SEAM(12);
    if (IN(13)) { pg8::Gemm g{(const bf16_t*)(ws + WS_H), (const bf16_t*)(ws + WS_WTGU), D, D, D, 0}; pg8::StaticOrder S; S.init(NTOK, 2 * FFH, F.G, blockIdx.x);
        pg8::EpiGu E{(bf16_t*)(ws + WS_PROJ)}; pg8::gemm_phase(F.lds, g, S, E); }
    SEAM(13);
    if (IN(14)) { pg8::Gemm g{(const bf16_t*)(ws + WS_PROJ), (const bf16_t*)(ws + WS_WTDN), FFH, FFH, FFH, 0}; pg8::StaticOrder S; S.init(NTOK, D, F.G, blockIdx.x);
        pg8::EpiBf16 E{(bf16_t*)(ws + WS_H), D}; pg8::gemm_phase(F.lds, g, S, E); }
    SEAM(14);
    if (IN(15)) p15_rows(F);
#undef IN
#undef SEAM
}

extern "C" void kernel_launch(void* const* d_in, const int* in_sizes, int n_in, void* d_out, int out_size, void* d_ws, size_t ws_size, hipStream_t stream) {
    static int grid = 0;
    if (grid == 0) {
        if (n_in != 34 || ws_size < WS_END) { fprintf(stderr, "kernel_launch: need 34 inputs and >= %zu bytes of workspace; got %d, %zu\n", (size_t)WS_END, n_in, ws_size); grid = -1; return; }
        int dev = 0, cus = 0, per_cu = 0;
        if (hipGetDevice(&dev) != hipSuccess || hipDeviceGetAttribute(&cus, hipDeviceAttributeMultiprocessorCount, dev) != hipSuccess) { grid = -1; return; }
        if (hipFuncSetAttribute((const void*)fwd_kernel, hipFuncAttributeMaxDynamicSharedMemorySize, LDS_BYTES) != hipSuccess) { fprintf(stderr, "kernel_launch: hipFuncSetAttribute failed\n"); grid = -1; return; }
        if (hipOccupancyMaxActiveBlocksPerMultiprocessor(&per_cu, (const void*)fwd_kernel, 512, LDS_BYTES) != hipSuccess || per_cu < 1) { fprintf(stderr, "kernel_launch: occupancy query says %d\n", per_cu); per_cu = 1; }
        (void)hipGetLastError();
        grid = cus;
    }
    if (grid < 0) return;
    (void)hipMemsetAsync((char*)d_ws + WS_CTL, 0, 64 * 1024, stream);
    Args a{};
    for (int i = 0; i < 34; ++i) a.in[i] = (const float*)d_in[i];
    a.out = (float*)d_out; a.ws = (unsigned char*)d_ws;
#if MK_ONE_LAUNCH
    a.ph_lo = 0; a.ph_hi = NPHASE;
    void* kargs[] = {&a};
    hipError_t e = hipLaunchCooperativeKernel((const void*)fwd_kernel, dim3(grid), dim3(512), kargs, LDS_BYTES, stream);
    if (e != hipSuccess) fprintf(stderr, "cooperative launch failed: %s (grid %d)\n", hipGetErrorString(e), grid);
#else
    for (int p = 0; p < NPHASE; ++p) { a.ph_lo = p; a.ph_hi = p + 1; hipLaunchKernelGGL(fwd_kernel, dim3(grid), dim3(512), LDS_BYTES, stream, a); }
#endif
}
```

```cpp
#include <hip/hip_runtime.h>
#include <hip/hip_cooperative_groups.h>
#include <cstdio>
namespace cg = cooperative_groups;

#ifndef MK_ONE_LAUNCH
#define MK_ONE_LAUNCH 1
#endif
#ifndef MK_CG_FIRST
#define MK_CG_FIRST 1
#endif

#define LAS __attribute__((address_space(3)))
typedef unsigned short bf16_t;
typedef short bf16x8 __attribute__((ext_vector_type(8)));
typedef float f32x4 __attribute__((ext_vector_type(4)));
typedef unsigned u32x4 __attribute__((ext_vector_type(4)));
typedef unsigned u32x2 __attribute__((ext_vector_type(2)));

constexpr int D = 2048, NTOK = 16384, NPTOK = 8192, PSEQ = 256, SSEQ = 4096;
constexpr int LRUW = 1024, RW = 1024, NH = 16, RIN = 3360, INW = 5408, INWP = 5632, FFH = 5632;
constexpr int LAK = 384;
constexpr int NPHASE = 16;

constexpr size_t MiB = 1024 * 1024;
constexpr size_t WS_CTL = 0;
constexpr size_t WS_MOD = 64 * 1024;
constexpr size_t WS_NL8 = 256 * 1024;
constexpr size_t WS_BTLRU = 1 * MiB;
constexpr size_t WS_BTLORA = 3 * MiB;
constexpr size_t WS_WTOUT = 7 * MiB;
constexpr size_t WS_WTGU = 15 * MiB;
constexpr size_t WS_WTDN = 59 * MiB;
constexpr size_t WS_H = 81 * MiB;
constexpr size_t WS_PROJ = 145 * MiB;
constexpr size_t WS_S = 321 * MiB;
constexpr size_t WS_WTIN = WS_S;
constexpr size_t WS_XC = WS_S;
constexpr size_t WS_G = WS_S;
constexpr size_t WS_LA = WS_S + 32 * MiB;
constexpr size_t WS_YB = WS_S + 32 * MiB;
constexpr size_t WS_PQ = WS_S + 64 * MiB;
constexpr size_t WS_END = WS_S + 96 * MiB;

__device__ __forceinline__ float bf2f(unsigned b) { return __uint_as_float(b << 16); }
__device__ __forceinline__ float bflo(unsigned w) { return __uint_as_float(w << 16); }
__device__ __forceinline__ float bfhi(unsigned w) { return __uint_as_float(w & 0xffff0000u); }
__device__ __forceinline__ unsigned f2bf(float f) { unsigned u = __float_as_uint(f); return (u + 0x7fffu + ((u >> 16) & 1u)) >> 16; }
__device__ __forceinline__ unsigned pk2(float lo, float hi) { return f2bf(lo) | (f2bf(hi) << 16); }
__device__ __forceinline__ float sigmoidf_(float x) { return __builtin_amdgcn_rcpf(1.f + __expf(-x)); }
__device__ __forceinline__ float gelu_tanh(float x) { const float u = 0.7978845608028654f * (x + 0.044715f * x * x * x); return 0.5f * x * (1.f + tanhf(u)); }
template <int CTRL> __device__ __forceinline__ float dpp_f(float x) { return __builtin_bit_cast(float, __builtin_amdgcn_update_dpp(0, __builtin_bit_cast(int, x), CTRL, 0xf, 0xf, true)); }
__device__ __forceinline__ float red8(float x) { x += dpp_f<0xB1>(x); x += dpp_f<0x4E>(x); x += dpp_f<0x141>(x); return x; }
__device__ __forceinline__ float wave_sum(float x) { x = red8(x); x += dpp_f<0x140>(x); x += __shfl_xor(x, 16); x += __shfl_xor(x, 32); return x; }
__device__ __forceinline__ int modidx(int row) { return row < NPTOK ? 0 : 1 + ((row - NPTOK) >> 12); }

#define XB_TMO      128
#define XB_XCNT(j)  (256  + 64 * (j))
#define XB_XSUB(j)  (1280 + 64 * (j))
#define XB_XGEN(j)  (2304 + 64 * (j))
#define XB_TOP      3328
#define XB_TOPGEN   3392
#define XCD_BAR_WORDS 3456
#define XB_SPIN_CAP (1u << 22)
__device__ __forceinline__ unsigned xb_ld(unsigned* p)              { return __hip_atomic_load(p, __ATOMIC_RELAXED, __HIP_MEMORY_SCOPE_AGENT); }
__device__ __forceinline__ unsigned xb_add(unsigned* p, unsigned v) { return __hip_atomic_fetch_add(p, v, __ATOMIC_RELAXED, __HIP_MEMORY_SCOPE_AGENT); }
__device__ __forceinline__ unsigned xb_xcc_id() { return (unsigned)__builtin_amdgcn_s_getreg((3 << 11) | 20) & 0xFu; }
#define XB_SPIN(cond, bar) do { unsigned _sp = 0; while (cond) { __builtin_amdgcn_s_sleep(1); \
    if ((++_sp & 255u) == 0u) { if (xb_ld(&(bar)[XB_TMO])) break; if (_sp > XB_SPIN_CAP) { atomicAdd(&(bar)[XB_TMO], 1u); break; } } } } while (0)
struct XcdBarrier { unsigned* bar; unsigned x; volatile LAS unsigned* st; };
__device__ __forceinline__ XcdBarrier xcd_barrier_post(unsigned* bar, volatile LAS unsigned* st) {
    XcdBarrier b; b.bar = bar; b.x = xb_xcc_id(); b.st = st;
    if (threadIdx.x == 0) (void)xb_add(&bar[XB_XCNT(b.x)], 1u);
    return b;
}
__device__ __forceinline__ void xcd_barrier_complete(unsigned* bar, unsigned x, unsigned& nloc, unsigned& nx) {
    const unsigned G = gridDim.x * gridDim.y * gridDim.z;
    unsigned sum, cnt, mine, sp = 0u;
    for (;;) {
        sum = 0u; cnt = 0u; mine = 0u;
#pragma unroll
        for (unsigned j = 0; j < 16; ++j) { const unsigned c = xb_ld(&bar[XB_XCNT(j)]); sum += c; cnt += (c > 0u) ? 1u : 0u; mine = (j == x) ? c : mine; }
        if (sum == G) break;
        __builtin_amdgcn_s_sleep(1);
        if ((++sp & 255u) == 0u) { if (xb_ld(&bar[XB_TMO])) break; if (sp > XB_SPIN_CAP) { atomicAdd(&bar[XB_TMO], 1u); break; } }
    }
    nloc = mine > 0u ? mine : 1u; nx = cnt > 0u ? cnt : 1u;
}
__device__ __forceinline__ void xcd_barrier(const XcdBarrier& b) {
    asm volatile("s_waitcnt vmcnt(0)" ::: "memory");
    __syncthreads();
    if (threadIdx.x == 0) {
        unsigned* bar = b.bar;
        __builtin_amdgcn_s_waitcnt(0);
        unsigned nloc = b.st[0], nx = b.st[1];
        if (nloc == 0u) { xcd_barrier_complete(bar, b.x, nloc, nx); b.st[0] = nloc; b.st[1] = nx; }
        const unsigned old = xb_add(&bar[XB_XSUB(b.x)], 1u);
        const unsigned gen = old / nloc;
        if (old + 1u == (gen + 1u) * nloc) {
            __builtin_amdgcn_fence(__ATOMIC_RELEASE, "agent");
            asm volatile("s_waitcnt vmcnt(0)" ::: "memory");
            const unsigned og = xb_add(&bar[XB_TOP], 1u);
            const unsigned tg = og / nx;
            if (og + 1u == (tg + 1u) * nx) xb_add(&bar[XB_TOPGEN], 1u);
            else XB_SPIN(xb_ld(&bar[XB_TOPGEN]) == tg, bar);
            __builtin_amdgcn_fence(__ATOMIC_ACQUIRE, "agent");
            xb_add(&bar[XB_XGEN(b.x)], 1u);
            asm volatile("s_waitcnt vmcnt(0)" ::: "memory");
        } else {
            XB_SPIN(xb_ld(&bar[XB_XGEN(b.x)]) == gen, bar);
            __builtin_amdgcn_fence(__ATOMIC_ACQUIRE, "agent");
            asm volatile("s_waitcnt vmcnt(0)" ::: "memory");
        }
    }
    __syncthreads();
}

struct Args { const float* in[34]; float* out; unsigned char* ws; int ph_lo, ph_hi; };
struct Frame {
    LAS unsigned char* lds;
    int tid, lane, wave, G;
    const float* const* in;
    float* out; unsigned char* ws;
};
#define IN_XP 0
#define IN_XS 1
#define IN_SLRU 2
#define IN_SWKV 3
#define IN_C 4
#define IN_CCTX 5
#define IN_NMPRE 6
#define IN_NMPOST 7
#define IN_NFPRE 8
#define IN_NFPOST 9
#define IN_WMOD 10
#define IN_BMOD 11
#define IN_WIN 12
#define IN_CONVW 13
#define IN_CONVB 14
#define IN_WR 15
#define IN_BR 16
#define IN_WI 17
#define IN_BI 18
#define IN_LAM 19
#define IN_MU 20
#define IN_W0 21
#define IN_WUP 22
#define IN_A0 23
#define IN_AUP 24
#define IN_GUP 25
#define IN_KK 26
#define IN_KA 27
#define IN_RK 28
#define IN_LNW 29
#define IN_LNB 30
#define IN_WOUT 31
#define IN_WGU 32
#define IN_WDN 33

namespace pg8 {
constexpr int BM = 256, BK = 64, HALF = 128, HTB = HALF * BK * 2, STAGE_BYTES = 8 * HTB, NXCD = 8, WGM = 8;
__host__ __device__ __forceinline__ int lds_byte(int r, int c) { const int st = (r >> 4) * 2 + (c >> 5), rr = r & 15, cc = c & 31, ob = rr * 64 + cc * 2; return st * 1024 + (ob ^ (((ob >> 9) & 1) << 5)); }
__host__ __device__ __forceinline__ void stage_rc(int b, int& R, int& C) { const int st = b / 1024, sb = b % 1024, swz = sb ^ (((sb >> 9) & 1) << 5); R = (st >> 1) * 16 + swz / 64; C = (st & 1) * 32 + (swz % 64) / 2; }
__host__ __device__ __forceinline__ int perm32(int rho) { const int n = rho >> 4, i = rho & 15; return 8 * (i >> 2) + 4 * n + (i & 3); }
struct Unit { int pm, pn; };
struct Gemm { const bf16_t* A; const bf16_t* Bt; int lda, ldb, K; int lruoff; };
struct StaticOrder {
    int nM, nN, nwg, G, c;
    __device__ void init(int M, int N, int G_, int c_) { nM = M / BM; nN = N / BM; nwg = nM * nN; G = G_; c = c_; }
    __device__ bool next(int i, Unit& u) const {
        const long L = (long)i * G + c; if (L >= nwg) return false;
        int wgid = (int)L; { const int q = nwg / NXCD, r = nwg % NXCD, xcd = wgid % NXCD, off = wgid / NXCD; wgid = (xcd < r ? xcd * (q + 1) : r * (q + 1) + (xcd - r) * q) + off; }
        const int nig = WGM * nN, gid = wgid / nig, fm = gid * WGM, gsz = (nM - fm) < WGM ? (nM - fm) : WGM;
        u.pm = fm + ((wgid % nig) % gsz); u.pn = (wgid % nig) / gsz; return true;
    }
};
__device__ __forceinline__ size_t a_unit_off(const Gemm& g, const Unit& u) {
    size_t o = (size_t)u.pm * BM * g.lda * 2;
    if (g.lruoff) { const int hd = u.pn >> 1; o += (size_t)(hd < 7 ? 128 * hd : 768) * 2; }
    return o;
}

template <class Epi>
__device__ __forceinline__ void gemm_phase(LAS unsigned char* lds, const Gemm g, const StaticOrder& S, const Epi& E) {
    const int tid = threadIdx.x, wid = __builtin_amdgcn_readfirstlane(tid >> 6), lane = tid & 63, wr = wid >> 2, wc = wid & 3, fr = lane & 15, fq = lane >> 4;
    const int nt = g.K / BK;
    unsigned voffA[2], voffB[2];
#pragma unroll
    for (int i = 0; i < 2; ++i) { int R, C; stage_rc(tid * 16 + i * 8192, R, C); const int Rb = (R & ~31) + perm32(R & 31);
        voffA[i] = (unsigned)(R * g.lda + C) * 2u; voffB[i] = (unsigned)(Rb * g.ldb + C) * 2u; }
    const size_t kstep = (size_t)(BK * 2);
    const size_t hstepA = (size_t)HALF * g.lda * 2, hstepB = (size_t)HALF * g.ldb * 2;
    const size_t tstepB = 2 * hstepB;
    const unsigned ldsw = (unsigned)wid * 1024u;
    const int aoff = lds_byte(wr * 64 + fr, fq * 8), boff = lds_byte(wc * 32 + fr, fq * 8);
#define PG8_SA(b, h) (((b) * 2 + (h)) * HTB)
#define PG8_SB(b, h) ((4 + (b) * 2 + (h)) * HTB)
#define PG8_STAGE(bufoff, gbase, voff) do { _Pragma("unroll") for (int _i = 0; _i < 2; ++_i) \
        __builtin_amdgcn_global_load_lds((const unsigned*)((const char*)(gbase) + (voff)[_i]), (LAS unsigned*)(lds + (bufoff) + ldsw + _i * 8192), 16, 0, 0); } while (0)
#define PG8_LDA(dst, b, h) do { _Pragma("unroll") for (int m = 0; m < 4; ++m) _Pragma("unroll") for (int k = 0; k < 2; ++k) dst[m][k] = *(const LAS bf16x8*)(lds + PG8_SA(b, h) + aoff + m * 2048 + k * 1024); } while (0)
#define PG8_LDB(dst, b, h) do { _Pragma("unroll") for (int n = 0; n < 2; ++n) _Pragma("unroll") for (int k = 0; k < 2; ++k) dst[n][k] = *(const LAS bf16x8*)(lds + PG8_SB(b, h) + boff + n * 2048 + k * 1024); } while (0)
#define PG8_MMA(ai, bj, At, Bt) do { __builtin_amdgcn_s_setprio(1); _Pragma("unroll") for (int m = 0; m < 4; ++m) _Pragma("unroll") for (int n = 0; n < 2; ++n) _Pragma("unroll") for (int k = 0; k < 2; ++k) \
        acc[ai][bj][m][n] = __builtin_amdgcn_mfma_f32_16x16x32_bf16(Bt[n][k], At[m][k], acc[ai][bj][m][n], 0, 0, 0); __builtin_amdgcn_s_setprio(0); } while (0)
#define PG8_WAIT_V(n) asm volatile("s_waitcnt vmcnt(" #n ")" ::: "memory")
#define PG8_WAIT_L(n) asm volatile("s_waitcnt lgkmcnt(" #n ")" ::: "memory")
#define PG8_BAR __builtin_amdgcn_s_barrier()
#define PG8_SCHED __builtin_amdgcn_sched_barrier(0)
    Unit cur, nxt; int ui = 0;
    if (!S.next(0, cur)) return;
    f32x4 acc[2][2][4][2];
#pragma unroll
    for (int a = 0; a < 2; ++a)
#pragma unroll
        for (int b = 0; b < 2; ++b)
#pragma unroll
            for (int m = 0; m < 4; ++m)
#pragma unroll
                for (int n = 0; n < 2; ++n) acc[a][b][m][n] = (f32x4){0.f, 0.f, 0.f, 0.f};
    bf16x8 At[4][2], B0[2][2], B1[2][2];
    const char* cA = (const char*)g.A + a_unit_off(g, cur); const char* cB = (const char*)g.Bt + (size_t)cur.pn * tstepB;
    PG8_STAGE(PG8_SB(0, 0), cB, voffB); PG8_STAGE(PG8_SA(0, 0), cA, voffA); PG8_STAGE(PG8_SB(0, 1), cB + hstepB, voffB); PG8_STAGE(PG8_SA(0, 1), cA + hstepA, voffA);
    if (wr == 1) PG8_BAR;
    PG8_WAIT_V(4); PG8_BAR;
    PG8_STAGE(PG8_SB(1, 0), cB + kstep, voffB); PG8_STAGE(PG8_SA(1, 0), cA + kstep, voffA); PG8_STAGE(PG8_SB(1, 1), cB + hstepB + kstep, voffB);
    PG8_WAIT_V(6); PG8_BAR;
    for (;;) {
        const bool has_next = S.next(ui + 1, nxt);
        const char* nA = has_next ? (const char*)g.A + a_unit_off(g, nxt) : cA; const char* nB = has_next ? (const char*)g.Bt + (size_t)nxt.pn * tstepB : cB;
#pragma unroll 1
        for (int t = 0; t < nt; t += 2) {
            const bool last = (t == nt - 2);
            const char* a1 = cA + (size_t)(t + 1) * kstep;
            const char* a2 = last ? nA : cA + (size_t)(t + 2) * kstep; const char* b2 = last ? nB : cB + (size_t)(t + 2) * kstep;
            const char* a3 = a2 + kstep; const char* b3 = b2 + kstep;
            PG8_LDB(B0, 0, 0); PG8_SCHED; PG8_LDA(At, 0, 0); PG8_STAGE(PG8_SA(1, 1), a1 + hstepA, voffA);
            PG8_WAIT_L(8); PG8_BAR; PG8_WAIT_L(0); PG8_MMA(0, 0, At, B0); PG8_BAR; PG8_SCHED;
            PG8_LDB(B1, 0, 1); PG8_STAGE(PG8_SB(0, 0), b2, voffB);
            PG8_BAR; PG8_WAIT_L(0); PG8_MMA(0, 1, At, B1); PG8_BAR;
            PG8_LDA(At, 0, 1); PG8_STAGE(PG8_SA(0, 0), a2, voffA);
            PG8_BAR; PG8_WAIT_L(0); PG8_MMA(1, 0, At, B0); PG8_BAR; PG8_SCHED;
            PG8_STAGE(PG8_SB(0, 1), b2 + hstepB, voffB);
            PG8_WAIT_V(6); PG8_BAR; PG8_MMA(1, 1, At, B1); PG8_BAR;
            PG8_LDB(B0, 1, 0); PG8_SCHED; PG8_LDA(At, 1, 0); PG8_STAGE(PG8_SA(0, 1), a2 + hstepA, voffA);
            PG8_WAIT_L(8); PG8_BAR; PG8_WAIT_L(0); PG8_MMA(0, 0, At, B0); PG8_BAR; PG8_SCHED;
            PG8_LDB(B1, 1, 1); PG8_STAGE(PG8_SB(1, 0), b3, voffB);
            PG8_BAR; PG8_WAIT_L(0); PG8_MMA(0, 1, At, B1); PG8_BAR;
            PG8_LDA(At, 1, 1); PG8_STAGE(PG8_SA(1, 0), a3, voffA);
            PG8_BAR; PG8_WAIT_L(0); PG8_MMA(1, 0, At, B0); PG8_BAR; PG8_SCHED;
            PG8_STAGE(PG8_SB(1, 1), b3 + hstepB, voffB);
            PG8_WAIT_V(6); PG8_BAR; PG8_MMA(1, 1, At, B1); PG8_BAR;
        }
        E(acc, cur, wr, wc, fr, fq);
        if (!has_next) break;
#pragma unroll
        for (int a = 0; a < 2; ++a)
#pragma unroll
            for (int b = 0; b < 2; ++b)
#pragma unroll
                for (int m = 0; m < 4; ++m)
#pragma unroll
                    for (int n = 0; n < 2; ++n) acc[a][b][m][n] = (f32x4){0.f, 0.f, 0.f, 0.f};
        cur = nxt; cA = nA; cB = nB; ++ui;
    }
    PG8_WAIT_V(0);
    if (wr == 0) PG8_BAR;
    PG8_BAR;
#undef PG8_SA
#undef PG8_SB
#undef PG8_STAGE
#undef PG8_LDA
#undef PG8_LDB
#undef PG8_MMA
#undef PG8_WAIT_V
#undef PG8_WAIT_L
#undef PG8_BAR
#undef PG8_SCHED
}

struct EpiBf16 {
    bf16_t* O; int ldc;
    __device__ __forceinline__ void operator()(const f32x4 (&acc)[2][2][4][2], const Unit& u, int wr, int wc, int fr, int fq) const {
        const int row0 = u.pm * BM + wr * 64 + fr, col0 = u.pn * BM + wc * 32 + 8 * fq;
#pragma unroll
        for (int ai = 0; ai < 2; ++ai)
#pragma unroll
            for (int m = 0; m < 4; ++m) { bf16_t* rowp = O + (size_t)(row0 + ai * HALF + m * 16) * ldc + col0;
#pragma unroll
                for (int bj = 0; bj < 2; ++bj) { const f32x4 v0 = acc[ai][bj][m][0], v1 = acc[ai][bj][m][1];
                    *(u32x4*)(rowp + bj * HALF) = (u32x4){pk2(v0[0], v0[1]), pk2(v0[2], v0[3]), pk2(v1[0], v1[1]), pk2(v1[2], v1[3])}; } }
    }
};
struct EpiGu {
    bf16_t* O;
    __device__ __forceinline__ void operator()(const f32x4 (&acc)[2][2][4][2], const Unit& u, int wr, int wc, int fr, int fq) const {
        const int row0 = u.pm * BM + wr * 64 + fr, col0 = u.pn * HALF + wc * 32 + 8 * fq;
#pragma unroll
        for (int ai = 0; ai < 2; ++ai)
#pragma unroll
            for (int m = 0; m < 4; ++m) { bf16_t* rowp = O + (size_t)(row0 + ai * HALF + m * 16) * FFH + col0;
                float o[8];
#pragma unroll
                for (int n = 0; n < 2; ++n)
#pragma unroll
                    for (int i = 0; i < 4; ++i) { const float gt = acc[ai][0][m][n][i], up = acc[ai][1][m][n][i]; o[n * 4 + i] = gt * sigmoidf_(gt) * up; }
                *(u32x4*)rowp = (u32x4){pk2(o[0], o[1]), pk2(o[2], o[3]), pk2(o[4], o[5]), pk2(o[6], o[7])}; }
    }
};
struct EpiLru {
    unsigned* LAB; const bf16_t* XC; const float* br; const float* bi; const float* nl8;
    __device__ __forceinline__ void operator()(const f32x4 (&acc)[2][2][4][2], const Unit& u, int wr, int wc, int fr, int fq) const {
        const int hd = u.pn >> 1, dir = u.pn & 1;
        const int row0 = u.pm * BM + wr * 64 + fr, ch0 = wc * 32 + 8 * fq, chan0 = hd * 128 + ch0;
        const float* brp = br + (dir * 8 + hd) * 128 + ch0; const float* bip = bi + (dir * 8 + hd) * 128 + ch0; const float* nlp = nl8 + dir * 1024 + chan0;
#pragma unroll
        for (int ai = 0; ai < 2; ++ai)
#pragma unroll
            for (int m = 0; m < 4; ++m) { const int row = row0 + ai * HALF + m * 16;
                const u32x4 xw = *(const u32x4*)(XC + (size_t)row * LRUW + chan0);
                unsigned* dst = LAB + ((size_t)row * 2 + dir) * LRUW + chan0;
#pragma unroll
                for (int n = 0; n < 2; ++n) { const f32x4 brv = *(const f32x4*)(brp + 4 * n), biv = *(const f32x4*)(bip + 4 * n), nlv = *(const f32x4*)(nlp + 4 * n);
                    unsigned o[4];
#pragma unroll
                    for (int i = 0; i < 4; ++i) { const int e = n * 4 + i;
                        const float xc = (e & 1) ? bfhi(xw[e >> 1]) : bflo(xw[e >> 1]);
                        const float rg = sigmoidf_(acc[ai][0][m][n][i] + brv[i]), ig = sigmoidf_(acc[ai][1][m][n][i] + biv[i]);
                        const float la = rg * nlv[i], x2 = 2.f * la;
                        const float om = (x2 > -0.1f) ? -x2 * (1.f + x2 * (0.5f + x2 * (0.16666667f + x2 * 0.041666668f))) : 1.f - __expf(x2);
                        const float bb = __builtin_amdgcn_sqrtf(om) * ig * xc;
                        o[i] = f2bf(la) | (f2bf(bb) << 16); }
                    *(u32x4*)(dst + 4 * n) = (u32x4){o[0], o[1], o[2], o[3]};
                    __builtin_amdgcn_sched_barrier(0); } }
    }
};
struct EpiLora {
    bf16_t* E; bf16_t* AA; bf16_t* Gt; const float* w0; const float* a0;
    __device__ __forceinline__ void operator()(const f32x4 (&acc)[2][2][4][2], const Unit& u, int wr, int wc, int fr, int fq) const {
        const int type = u.pn >> 2, d = type & 1;
        const int row0 = u.pm * BM + wr * 64 + fr;
        const float* bsrc = type < 2 ? w0 + d * RW : a0 + d * RW;
        bf16_t* obase = type < 2 ? E + d * RW : (type < 4 ? AA + d * RW : Gt);
        const int opitch = type < 4 ? 2 * RW : RW;
        const float sc = type < 2 ? 0.60653066f : 1.f;
#pragma unroll
        for (int bj = 0; bj < 2; ++bj) { const int ch0 = (u.pn & 3) * 256 + bj * HALF + wc * 32 + 8 * fq;
#pragma unroll
            for (int ai = 0; ai < 2; ++ai)
#pragma unroll
                for (int m = 0; m < 4; ++m) { const int row = row0 + ai * HALF + m * 16;
                    float o[8];
#pragma unroll
                    for (int n = 0; n < 2; ++n) { f32x4 bias = (f32x4){0.f, 0.f, 0.f, 0.f}; if (type < 4) bias = *(const f32x4*)(bsrc + ch0 + 4 * n);
#pragma unroll
                        for (int i = 0; i < 4; ++i) { const float z = acc[ai][bj][m][n][i] + bias[i]; o[n * 4 + i] = type < 4 ? sc * sigmoidf_(z) : z; } }
                    *(u32x4*)(obase + (size_t)row * opitch + ch0) = (u32x4){pk2(o[0], o[1]), pk2(o[2], o[3]), pk2(o[4], o[5]), pk2(o[6], o[7])};
                    __builtin_amdgcn_sched_barrier(0); } }
    }
};
}

__device__ __forceinline__ void xpose_tile(Frame& F, const float* src, int ldsrc, int ncols_valid, int k0, int n0, bf16_t* dst, int lddst, int drow0) {
    LAS bf16_t* t = (LAS bf16_t*)F.lds;
    const int tid = F.tid;
    { const int r = tid >> 4, c4 = (tid & 15) * 4;
#pragma unroll
      for (int rr = 0; rr < 2; ++rr) { const int k = r + rr * 32; float4 v = make_float4(0.f, 0.f, 0.f, 0.f);
          if (n0 + c4 < ncols_valid) v = *(const float4*)(src + (size_t)(k0 + k) * ldsrc + n0 + c4);
          t[(c4 + 0) * 72 + k] = (bf16_t)f2bf(v.x); t[(c4 + 1) * 72 + k] = (bf16_t)f2bf(v.y); t[(c4 + 2) * 72 + k] = (bf16_t)f2bf(v.z); t[(c4 + 3) * 72 + k] = (bf16_t)f2bf(v.w); } }
    __syncthreads();
    { const int n = tid >> 3, kc = (tid & 7) * 8;
      const u32x4 v = *(const LAS u32x4*)(t + n * 72 + kc);
      *(u32x4*)(dst + (size_t)(drow0 + n) * lddst + k0 + kc) = v; }
    __syncthreads();
}

__device__ __forceinline__ void p0_prologue(Frame& F) {
    const int tid = F.tid, G = F.G, bid = blockIdx.x;
    unsigned char* ws = F.ws;
    {
        LAS float* sv = (LAS float*)F.lds;
        LAS float* red = (LAS float*)(F.lds + 24576);
        const float* c = F.in[IN_C]; const float* cctx = F.in[IN_CCTX];
        for (int i = tid; i < 3 * D; i += 512) { const int r = i / D, k = i % D; const float cv = r == 0 ? cctx[k] : c[(r - 1) * D + k]; sv[i] = cv * sigmoidf_(cv); }
        __syncthreads();
        const float* wm = F.in[IN_WMOD]; const float* bm = F.in[IN_BMOD]; float* MOD = (float*)(ws + WS_MOD);
        for (int cb = bid; cb < 256; cb += G) {
            const int n0 = cb * 48;
            if (tid < 504) { const int cg4 = (tid % 12) * 4, kl = tid / 12;
                float a0[4] = {0, 0, 0, 0}, a1[4] = {0, 0, 0, 0}, a2[4] = {0, 0, 0, 0};
                for (int k = kl; k < D; k += 42) { const float4 w = *(const float4*)(wm + (size_t)k * 12288 + n0 + cg4);
                    const float s0 = sv[k], s1 = sv[D + k], s2 = sv[2 * D + k];
                    a0[0] += s0 * w.x; a0[1] += s0 * w.y; a0[2] += s0 * w.z; a0[3] += s0 * w.w;
                    a1[0] += s1 * w.x; a1[1] += s1 * w.y; a1[2] += s1 * w.z; a1[3] += s1 * w.w;
                    a2[0] += s2 * w.x; a2[1] += s2 * w.y; a2[2] += s2 * w.z; a2[3] += s2 * w.w; }
#pragma unroll
                for (int i = 0; i < 4; ++i) { red[(kl * 3 + 0) * 48 + cg4 + i] = a0[i]; red[(kl * 3 + 1) * 48 + cg4 + i] = a1[i]; red[(kl * 3 + 2) * 48 + cg4 + i] = a2[i]; } }
            __syncthreads();
            if (tid < 144) { const int r = tid / 48, j = tid % 48; float s = 0.f; for (int kl = 0; kl < 42; ++kl) s += red[(kl * 3 + r) * 48 + j]; MOD[r * 12288 + n0 + j] = s + bm[n0 + j]; }
            __syncthreads();
        }
    }
    {
        const int T_IN = 32 * 88, T_OUT = 32 * 32, T_GU = 32 * 176, T_DN = 88 * 32, T_ALL = T_IN + T_OUT + T_GU + T_DN;
        for (int ti = bid; ti < T_ALL; ti += G) {
            if (ti < T_IN) { const int kt = ti / 88, nt = ti % 88; xpose_tile(F, F.in[IN_WIN], INW, INW, kt * 64, nt * 64, (bf16_t*)(ws + WS_WTIN), D, nt * 64); }
            else if (ti < T_IN + T_OUT) { const int t2 = ti - T_IN, kt = t2 / 32, nt = t2 % 32; xpose_tile(F, F.in[IN_WOUT], D, D, kt * 64, nt * 64, (bf16_t*)(ws + WS_WTOUT), D, nt * 64); }
            else if (ti < T_IN + T_OUT + T_GU) { const int t2 = ti - T_IN - T_OUT, kt = t2 / 176, nt = t2 % 176, n0 = nt * 64;
                const int drow0 = n0 < FFH ? (n0 / 128) * 256 + (n0 % 128) : ((n0 - FFH) / 128) * 256 + 128 + ((n0 - FFH) % 128);
                xpose_tile(F, F.in[IN_WGU], 2 * FFH, 2 * FFH, kt * 64, n0, (bf16_t*)(ws + WS_WTGU), D, drow0); }
            else { const int t2 = ti - T_IN - T_OUT - T_GU, kt = t2 / 32, nt = t2 % 32; xpose_tile(F, F.in[IN_WDN], D, D, kt * 64, nt * 64, (bf16_t*)(ws + WS_WTDN), FFH, nt * 64); }
        }
    }
    {
        const size_t gt = (size_t)bid * 512 + tid, gs = (size_t)G * 512;
        bf16_t* btl = (bf16_t*)(ws + WS_BTLRU);
        const float* wr = F.in[IN_WR]; const float* wi = F.in[IN_WI];
        for (size_t idx = gt; idx < (size_t)4096 * 256; idx += gs) { const int row = (int)(idx >> 8), col = (int)(idx & 255);
            const int hd = row >> 9, q = (row >> 7) & 3, j = row & 127, koff = hd < 7 ? 128 * hd : 768, kk = col - (128 * hd - koff);
            float v = 0.f;
            if (kk >= 0 && kk < 128) { const int d = q >> 1; const float* W = (q & 1) ? wi : wr; v = W[((size_t)(d * 8 + hd) * 128 + kk) * 128 + j]; }
            btl[idx] = (bf16_t)f2bf(v); }
        bf16_t* bto = (bf16_t*)(ws + WS_BTLORA);
        const float* wup = F.in[IN_WUP]; const float* aup = F.in[IN_AUP]; const float* gup = F.in[IN_GUP];
        for (size_t idx = gt; idx < (size_t)5120 * LAK; idx += gs) { const int n = (int)(idx / LAK), k = (int)(idx % LAK);
            float v = 0.f;
            if (n < 2048) { if (k < 64) v = wup[((size_t)(n >> 10) * 64 + k) * RW + (n & 1023)]; }
            else if (n < 4096) { if (k >= 64 && k < 128) v = aup[((size_t)((n - 2048) >> 10) * 64 + (k - 64)) * RW + (n & 1023)]; }
            else { if (k >= 128 && k < 288) v = gup[(size_t)(k - 128) * RW + (n - 4096)]; }
            bto[idx] = (bf16_t)f2bf(v); }
        float* nl8 = (float*)(ws + WS_NL8); const float* lam = F.in[IN_LAM];
        for (size_t idx = gt; idx < 2048; idx += gs) { const float l = lam[idx]; nl8[idx] = -8.f * log1pf(__expf(-l)); }
    }
}

__device__ __forceinline__ void p1_normmod(Frame& F) {
    const float* MOD = (const float*)(F.ws + WS_MOD); const float* g1 = F.in[IN_NMPRE]; bf16_t* H = (bf16_t*)(F.ws + WS_H);
    for (int row = blockIdx.x * 8 + F.wave; row < NTOK; row += F.G * 8) {
        const float* xr = row < NPTOK ? F.in[IN_XP] + (size_t)row * D : F.in[IN_XS] + (size_t)(row - NPTOK) * D;
        float4 v[8]; float ss = 0.f;
#pragma unroll
        for (int i = 0; i < 8; ++i) { v[i] = *(const float4*)(xr + (i * 64 + F.lane) * 4); ss += v[i].x * v[i].x + v[i].y * v[i].y + v[i].z * v[i].z + v[i].w * v[i].w; }
        ss = wave_sum(ss);
        const float rstd = rsqrtf(ss * (1.f / D) + 1e-6f);
        const float* md = MOD + modidx(row) * 12288;
#pragma unroll
        for (int i = 0; i < 8; ++i) { const int col = (i * 64 + F.lane) * 4;
            const float4 g = *(const float4*)(g1 + col), sc = *(const float4*)(md + D + col), sh = *(const float4*)(md + col);
            const float h0 = v[i].x * rstd * g.x * (1.f + sc.x) + sh.x, h1 = v[i].y * rstd * g.y * (1.f + sc.y) + sh.y;
            const float h2 = v[i].z * rstd * g.z * (1.f + sc.z) + sh.z, h3 = v[i].w * rstd * g.w * (1.f + sc.w) + sh.w;
            *(u32x2*)(H + (size_t)row * D + col) = (u32x2){pk2(h0, h1), pk2(h2, h3)}; }
    }
}

struct NbrOff { int o0, o1, o2, o3; };
__device__ __forceinline__ NbrOff nbr_offsets(int g) {
    NbrOff n;
    if (g < NPTOK) { const int t = g & (PSEQ - 1); n.o0 = t >= 1 ? -1 : 0; n.o1 = t < PSEQ - 1 ? 1 : 0; n.o2 = 0; n.o3 = 0; }
    else { const int t = (g - NPTOK) & (SSEQ - 1), row = t >> 6, col = t & 63; n.o0 = col >= 1 ? -1 : 0; n.o1 = col < 63 ? 1 : 0; n.o2 = row >= 1 ? -64 : 0; n.o3 = row < 63 ? 64 : 0; }
    return n;
}
__device__ __forceinline__ int nbr_kind(bool sample, int j) { return sample ? (j < 840 ? 0 : (j < 1680 ? 1 : (j < 2520 ? 2 : 3))) : (j < 1680 ? 0 : 1); }
__device__ __forceinline__ int nbr_pick(const NbrOff& n, int kind) { return kind == 0 ? n.o0 : (kind == 1 ? n.o1 : (kind == 2 ? n.o2 : n.o3)); }
__device__ __forceinline__ float mixed_val(const bf16_t* PR, int g, int j, int off, float mu) {
    const float p = bf2f(PR[(size_t)g * INWP + j]);
    const float q = off ? bf2f(PR[(size_t)(g + off) * INWP + j]) : 0.f;
    return p + mu * (q - p);
}

__device__ __forceinline__ void p3_elem(Frame& F) {
    const bf16_t* PROJ = (const bf16_t*)(F.ws + WS_PROJ); const bf16_t* PR = PROJ + 2048;
    bf16_t* XC = (bf16_t*)(F.ws + WS_XC); bf16_t* LA = (bf16_t*)(F.ws + WS_LA);
    const float* cw = F.in[IN_CONVW]; const float* cb = F.in[IN_CONVB]; const float* mu = F.in[IN_MU];
    const int lane = F.lane;
    for (int g = blockIdx.x * 8 + F.wave; g < NTOK; g += F.G * 8) {
        const bool sample = g >= NPTOK; const int T = sample ? SSEQ : PSEQ, t = sample ? ((g - NPTOK) & (SSEQ - 1)) : (g & (PSEQ - 1));
#pragma unroll
        for (int half = 0; half < 2; ++half) { const int c0 = half * 512 + lane * 8;
            float o[8];
#pragma unroll
            for (int i = 0; i < 8; ++i) o[i] = cb[c0 + i];
#pragma unroll
            for (int k = 0; k < 4; ++k) { const int tt = t + k - 2;
                if (tt >= 0 && tt < T) { const u32x4 w = *(const u32x4*)(PROJ + (size_t)(g + k - 2) * INWP + c0);
                    const float4 w0 = *(const float4*)(cw + k * LRUW + c0), w1 = *(const float4*)(cw + k * LRUW + c0 + 4);
                    o[0] += bflo(w[0]) * w0.x; o[1] += bfhi(w[0]) * w0.y; o[2] += bflo(w[1]) * w0.z; o[3] += bfhi(w[1]) * w0.w;
                    o[4] += bflo(w[2]) * w1.x; o[5] += bfhi(w[2]) * w1.y; o[6] += bflo(w[3]) * w1.z; o[7] += bfhi(w[3]) * w1.w; } }
            *(u32x4*)(XC + (size_t)g * LRUW + c0) = (u32x4){pk2(o[0], o[1]), pk2(o[2], o[3]), pk2(o[4], o[5]), pk2(o[6], o[7])}; }
        const NbrOff no = nbr_offsets(g);
#pragma unroll
        for (int i = 0; i < 6; ++i) { const int jj = lane + 64 * i;
            if (jj < LAK) { float v = 0.f;
                if (jj < 288) { const int j = 3072 + jj; const float m = mixed_val(PR, g, j, nbr_pick(no, nbr_kind(sample, j)), mu[j]);
                    v = jj < 64 ? tanhf(m) : (jj < 128 ? m : sigmoidf_(m)); }
                LA[(size_t)g * LAK + jj] = (bf16_t)f2bf(v); } }
    }
}

__device__ __forceinline__ void p5_lru_scan(Frame& F) {
    const unsigned* LAB = (const unsigned*)F.out;
    const bf16_t* PROJ = (const bf16_t*)(F.ws + WS_PROJ); bf16_t* MIX = (bf16_t*)(F.ws + WS_H);
    LAS float* cinF = (LAS float*)F.lds;
    LAS float* cinB = (LAS float*)(F.lds + 32768);
    LAS float* aggA = (LAS float*)(F.lds + 65536);
    LAS float* aggB = (LAS float*)(F.lds + 65536 + 2048);
    LAS float* segc = (LAS float*)(F.lds + 65536 + 4096);
    const int tid = F.tid, c = tid >> 6, ch = tid & 63;
    float* nsl = F.out + (size_t)2 * NPTOK * D;
    for (int u = blockIdx.x; u < 32 + 512; u += F.G) {
        const bool sample = u < 32; const int uu = sample ? u : u - 32;
        const int b = uu >> 4, cgp = uu & 15, chan = cgp * 64 + ch;
        const int nseg = sample ? 16 : 1, g0 = sample ? NPTOK + b * SSEQ : b * PSEQ;
        for (int dir = 0; dir < 2; ++dir) {
            LAS float* cin = dir ? cinB : cinF;
            if (c == 0) segc[ch] = sample ? F.in[IN_SLRU][(b * 2 + dir) * LRUW + chan] : 0.f;
            __syncthreads();
            for (int si = 0; si < nseg; ++si) { const int s = dir ? nseg - 1 - si : si;
                const unsigned* p = LAB + ((size_t)(g0 + s * 256 + c * 32) * 2 + dir) * LRUW + chan;
                float A = 1.f, B = 0.f;
#pragma unroll 8
                for (int i = 0; i < 32; ++i) { const int ii = dir ? 31 - i : i; const unsigned w = p[(size_t)ii * 2 * LRUW];
                    const float a = __expf(bflo(w)), bb = bfhi(w); B = a * B + bb; A *= a; }
                aggA[c * 64 + ch] = A; aggB[c * 64 + ch] = B;
                __syncthreads();
                if (c == 0) { float carry = segc[ch];
                    for (int k = 0; k < 8; ++k) { const int cc = dir ? 7 - k : k; cin[(s * 8 + cc) * 64 + ch] = carry; carry = aggA[cc * 64 + ch] * carry + aggB[cc * 64 + ch]; }
                    segc[ch] = carry; }
                __syncthreads();
            }
            if (!sample && c == 0) nsl[(size_t)(b * 2 + dir) * LRUW + chan] = segc[ch];
            __syncthreads();
        }
        for (int s = 0; s < nseg; ++s) {
            const int gb = g0 + s * 256 + c * 32;
            const unsigned* pf = LAB + ((size_t)gb * 2 + 0) * LRUW + chan;
            const unsigned* pb = LAB + ((size_t)gb * 2 + 1) * LRUW + chan;
            float hf[32]; float h = cinF[(s * 8 + c) * 64 + ch];
#pragma unroll
            for (int i = 0; i < 32; ++i) { const unsigned w = pf[(size_t)i * 2 * LRUW]; h = __expf(bflo(w)) * h + bfhi(w); hf[i] = h; }
            h = cinB[(s * 8 + c) * 64 + ch];
#pragma unroll
            for (int i = 31; i >= 0; --i) { const unsigned w = pb[(size_t)i * 2 * LRUW]; h = __expf(bflo(w)) * h + bfhi(w);
                const float gl = bf2f(PROJ[(size_t)(gb + i) * INWP + LRUW + chan]);
                MIX[(size_t)(gb + i) * D + chan] = (bf16_t)f2bf((hf[i] + h) * gelu_tanh(gl)); }
        }
        __syncthreads();
    }
}

struct WkvJob { int g0; int gstep; bool sample; int h; int dir; const float* S0; float* Sout; bf16_t* Y; int ypitch; };
constexpr int WNS = 4;
template <int KIND, bool HAS_S0>
__device__ __forceinline__ void wkv_unit(Frame& F, const WkvJob& J) {
    const int lane = F.lane, vi = lane >> 3, ki = lane & 7;
    LAS float* L = (LAS float*)(F.lds + F.wave * 6144);
    const bf16_t* PR = (const bf16_t*)(F.ws + WS_PROJ) + 2048;
    const bf16_t* Eb = (const bf16_t*)F.out; const bf16_t* Ab = Eb + (size_t)NTOK * 2 * RW;
    const int chan = J.h * 64 + lane, dir = J.dir;
    const float mu_r = F.in[IN_MU][chan], mu_k = F.in[IN_MU][1024 + chan], mu_v = F.in[IN_MU][2048 + chan];
    const int kd_r = nbr_kind(J.sample, chan), kd_k = nbr_kind(J.sample, 1024 + chan), kd_v = nbr_kind(J.sample, 2048 + chan);
    const float k_k = F.in[IN_KK][chan], k_a = F.in[IN_KA][chan];
    float S[8][8];
    if (HAS_S0) {
#pragma unroll
        for (int i = 0; i < 8; ++i) { const float4 a = *(const float4*)(J.S0 + (vi * 8 + i) * 64 + ki * 8), b = *(const float4*)(J.S0 + (vi * 8 + i) * 64 + ki * 8 + 4);
            S[i][0] = a.x; S[i][1] = a.y; S[i][2] = a.z; S[i][3] = a.w; S[i][4] = b.x; S[i][5] = b.y; S[i][6] = b.z; S[i][7] = b.w; }
    } else {
#pragma unroll
        for (int i = 0; i < 8; ++i)
#pragma unroll
            for (int j = 0; j < 8; ++j) S[i][j] = (KIND == 1 && vi == ki && i == j) ? 1.f : 0.f;
    }
    unsigned short ro[WNS], rn[WNS], ko[WNS], kn[WNS], vo[WNS], vn[WNS], ee[WNS], aa[WNS];
#define WKV_FETCH(mc) do { _Pragma("unroll") for (int s = 0; s < WNS; ++s) { const int g = J.g0 + ((mc) * WNS + s) * J.gstep; const NbrOff no = nbr_offsets(g); \
        const int ofr = nbr_pick(no, kd_r), ofk = nbr_pick(no, kd_k), ofv = nbr_pick(no, kd_v); \
        const bf16_t* pg = PR + (size_t)g * INWP; \
        ro[s] = pg[chan]; rn[s] = pg[(ptrdiff_t)ofr * INWP + chan]; ko[s] = pg[1024 + chan]; kn[s] = pg[(ptrdiff_t)ofk * INWP + 1024 + chan]; \
        if (KIND != 1) { vo[s] = pg[2048 + chan]; vn[s] = pg[(ptrdiff_t)ofv * INWP + 2048 + chan]; } \
        ee[s] = Eb[((size_t)g * 2 + dir) * RW + chan]; aa[s] = Ab[((size_t)g * 2 + dir) * RW + chan]; } } while (0)
#define WKV_CONVERT(mc) do { _Pragma("unroll") for (int s = 0; s < WNS; ++s) { const NbrOff no = nbr_offsets(J.g0 + ((mc) * WNS + s) * J.gstep); \
        const int ofr = nbr_pick(no, kd_r), ofk = nbr_pick(no, kd_k), ofv = nbr_pick(no, kd_v); \
        const float r0 = bf2f(ro[s]), r1 = ofr ? bf2f(rn[s]) : 0.f, k0 = bf2f(ko[s]), k1 = ofk ? bf2f(kn[s]) : 0.f; \
        const float r = r0 + mu_r * (r1 - r0), k = k0 + mu_k * (k1 - k0); \
        float kk = k * k_k; const float ssq = wave_sum(kk * kk); kk *= rsqrtf(fmaxf(ssq, 1e-24f)); \
        const float a = bf2f(aa[s]), w = __expf(-bf2f(ee[s])); \
        L[(0 * WNS + s) * 64 + lane] = w; L[(1 * WNS + s) * 64 + lane] = kk; L[(2 * WNS + s) * 64 + lane] = kk * a; \
        L[(3 * WNS + s) * 64 + lane] = k * (1.f + (a - 1.f) * k_a); L[(4 * WNS + s) * 64 + lane] = r; \
        if (KIND != 1) { const float v0 = bf2f(vo[s]), v1 = ofv ? bf2f(vn[s]) : 0.f; L[(5 * WNS + s) * 64 + lane] = v0 + mu_v * (v1 - v0); } } } while (0)
    WKV_FETCH(0);
    WKV_CONVERT(0);
    for (int mc = 0; mc < 256 / WNS; ++mc) {
        if (mc + 1 < 256 / WNS) WKV_FETCH(mc + 1);
#pragma unroll 2
        for (int s = 0; s < WNS; ++s) {
            float w[8], kk[8], kka[8], kd[8], r[8], v[8];
#define WKV_LD8(dst, arr, off) do { const f32x4 _a = *(const LAS f32x4*)(L + ((arr) * WNS + s) * 64 + (off)), _b = *(const LAS f32x4*)(L + ((arr) * WNS + s) * 64 + (off) + 4); \
            dst[0] = _a[0]; dst[1] = _a[1]; dst[2] = _a[2]; dst[3] = _a[3]; dst[4] = _b[0]; dst[5] = _b[1]; dst[6] = _b[2]; dst[7] = _b[3]; } while (0)
            WKV_LD8(w, 0, ki * 8); WKV_LD8(kk, 1, ki * 8); WKV_LD8(kka, 2, ki * 8);
            if (KIND != 1) { WKV_LD8(kd, 3, ki * 8); WKV_LD8(v, 5, vi * 8); }
            if (KIND == 0) WKV_LD8(r, 4, ki * 8);
            float sa[8];
#pragma unroll
            for (int i = 0; i < 8; ++i) { float t = 0.f;
#pragma unroll
                for (int j = 0; j < 8; ++j) t = fmaf(S[i][j], kk[j], t);
                sa[i] = -red8(t); }
#pragma unroll
            for (int i = 0; i < 8; ++i)
#pragma unroll
                for (int j = 0; j < 8; ++j) { float t = sa[i] * kka[j]; if (KIND != 1) t = fmaf(v[i], kd[j], t); S[i][j] = fmaf(S[i][j], w[j], t); }
            if (KIND == 0) {
                float y[8];
#pragma unroll
                for (int i = 0; i < 8; ++i) { float t = 0.f;
#pragma unroll
                    for (int j = 0; j < 8; ++j) t = fmaf(S[i][j], r[j], t);
                    y[i] = red8(t); }
                if (ki == 0) { const int g = J.g0 + (mc * WNS + s) * J.gstep;
                    *(u32x4*)(J.Y + (size_t)g * J.ypitch + J.h * 64 + vi * 8) = (u32x4){pk2(y[0], y[1]), pk2(y[2], y[3]), pk2(y[4], y[5]), pk2(y[6], y[7])}; }
            }
        }
        if (mc + 1 < 256 / WNS) WKV_CONVERT(mc + 1);
    }
    if (J.Sout) {
#pragma unroll
        for (int i = 0; i < 8; ++i) { float* d = J.Sout + (vi * 8 + i) * 64 + ki * 8;
            *(float4*)d = make_float4(S[i][0], S[i][1], S[i][2], S[i][3]); *(float4*)(d + 4) = make_float4(S[i][4], S[i][5], S[i][6], S[i][7]); }
    }
#undef WKV_FETCH
#undef WKV_CONVERT
#undef WKV_LD8
}

__device__ __forceinline__ void p7_wkv_pass1(Frame& F) {
    float* PQ = (float*)(F.ws + WS_PQ); float* nsw = F.out + (size_t)2 * NPTOK * D + 32 * 2 * LRUW;
    bf16_t* MIX = (bf16_t*)(F.ws + WS_H); bf16_t* YB = (bf16_t*)(F.ws + WS_YB);
    for (int u = blockIdx.x * 8 + F.wave; u < 3072; u += F.G * 8) {
        WkvJob J;
        if (u < 1024) { const int h = u & 15, dir = (u >> 4) & 1, b = u >> 5;
            J.sample = false; J.h = h; J.dir = dir; J.g0 = b * PSEQ + (dir ? PSEQ - 1 : 0); J.gstep = dir ? -1 : 1; J.S0 = nullptr;
            J.Sout = nsw + (size_t)((b * 2 + dir) * 16 + h) * 4096; J.Y = dir ? YB : MIX + 1024; J.ypitch = dir ? RW : D;
            wkv_unit<0, false>(F, J);
        } else { const int u2 = u - 1024, h = u2 & 15, pq = (u2 >> 4) & 1, dir = (u2 >> 5) & 1, chunk = (u2 >> 6) & 15, b = u2 >> 10;
            const int tt0 = chunk * 256, t0 = dir ? SSEQ - 1 - tt0 : tt0;
            J.sample = true; J.h = h; J.dir = dir; J.g0 = NPTOK + b * SSEQ + t0; J.gstep = dir ? -1 : 1; J.S0 = nullptr; J.Y = nullptr; J.ypitch = 0;
            const int chain = (b * 2 + dir) * 16 + h;
            J.Sout = PQ + ((size_t)(chain * 16 + chunk) * 2 + pq) * 4096;
            if (pq == 0) wkv_unit<1, false>(F, J); else wkv_unit<2, false>(F, J);
        }
    }
}
__device__ __forceinline__ void p8_wkv_combine(Frame& F) {
    float* PQ = (float*)(F.ws + WS_PQ);
    LAS float* Sl = (LAS float*)F.lds; LAS float* Pl = (LAS float*)(F.lds + 16384);
    const int tid = F.tid, v = tid >> 3, kq = tid & 7;
    for (int chain = blockIdx.x; chain < 64; chain += F.G) {
        const float* s0 = F.in[IN_SWKV] + (size_t)chain * 4096;
        __syncthreads();
        { const float4 a = *(const float4*)(s0 + tid * 8), b = *(const float4*)(s0 + tid * 8 + 4);
          *(LAS f32x4*)(Sl + tid * 8) = (f32x4){a.x, a.y, a.z, a.w}; *(LAS f32x4*)(Sl + tid * 8 + 4) = (f32x4){b.x, b.y, b.z, b.w}; }
        for (int c = 0; c < 15; ++c) {
            const float* Pc = PQ + ((size_t)(chain * 16 + c) * 2 + 0) * 4096; float* Qc = PQ + ((size_t)(chain * 16 + c) * 2 + 1) * 4096;
            { const float4 a = *(const float4*)(Pc + tid * 8), b = *(const float4*)(Pc + tid * 8 + 4);
              *(LAS f32x4*)(Pl + tid * 8) = (f32x4){a.x, a.y, a.z, a.w}; *(LAS f32x4*)(Pl + tid * 8 + 4) = (f32x4){b.x, b.y, b.z, b.w}; }
            float acc[8];
            { const float4 a = *(const float4*)(Qc + v * 64 + kq * 8), b = *(const float4*)(Qc + v * 64 + kq * 8 + 4);
              acc[0] = a.x; acc[1] = a.y; acc[2] = a.z; acc[3] = a.w; acc[4] = b.x; acc[5] = b.y; acc[6] = b.z; acc[7] = b.w; }
            __syncthreads();
            for (int k = 0; k < 64; ++k) { const float s = Sl[v * 64 + k]; const f32x4 p0 = *(const LAS f32x4*)(Pl + k * 64 + kq * 8), p1 = *(const LAS f32x4*)(Pl + k * 64 + kq * 8 + 4);
                acc[0] += s * p0[0]; acc[1] += s * p0[1]; acc[2] += s * p0[2]; acc[3] += s * p0[3]; acc[4] += s * p1[0]; acc[5] += s * p1[1]; acc[6] += s * p1[2]; acc[7] += s * p1[3]; }
            __syncthreads();
            *(LAS f32x4*)(Sl + v * 64 + kq * 8) = (f32x4){acc[0], acc[1], acc[2], acc[3]}; *(LAS f32x4*)(Sl + v * 64 + kq * 8 + 4) = (f32x4){acc[4], acc[5], acc[6], acc[7]};
            *(float4*)(Qc + v * 64 + kq * 8) = make_float4(acc[0], acc[1], acc[2], acc[3]); *(float4*)(Qc + v * 64 + kq * 8 + 4) = make_float4(acc[4], acc[5], acc[6], acc[7]);
            __syncthreads();
        }
    }
}
__device__ __forceinline__ void p9_wkv_pass3(Frame& F) {
    float* PQ = (float*)(F.ws + WS_PQ); bf16_t* MIX = (bf16_t*)(F.ws + WS_H); bf16_t* YB = (bf16_t*)(F.ws + WS_YB);
    if (F.wave >= 4) return;
    for (int u = blockIdx.x * 4 + F.wave; u < 1024; u += F.G * 4) {
        const int h = u & 15, dir = (u >> 4) & 1, chunk = (u >> 5) & 15, b = u >> 9;
        const int tt0 = chunk * 256, t0 = dir ? SSEQ - 1 - tt0 : tt0, chain = (b * 2 + dir) * 16 + h;
        WkvJob J; J.sample = true; J.h = h; J.dir = dir; J.g0 = NPTOK + b * SSEQ + t0; J.gstep = dir ? -1 : 1;
        J.S0 = chunk == 0 ? F.in[IN_SWKV] + (size_t)chain * 4096 : PQ + ((size_t)(chain * 16 + chunk - 1) * 2 + 1) * 4096;
        J.Sout = nullptr; J.Y = dir ? YB : MIX + 1024; J.ypitch = dir ? RW : D;
        wkv_unit<0, true>(F, J);
    }
}

__device__ __forceinline__ void p10_wkv_finish(Frame& F) {
    const bf16_t* PR = (const bf16_t*)(F.ws + WS_PROJ) + 2048; bf16_t* MIX = (bf16_t*)(F.ws + WS_H);
    const bf16_t* YB = (const bf16_t*)(F.ws + WS_YB); const bf16_t* Gt = (const bf16_t*)(F.ws + WS_G);
    const float* mu = F.in[IN_MU]; const float* rk = F.in[IN_RK]; const float* lnw = F.in[IN_LNW]; const float* lnb = F.in[IN_LNB];
    const int lane = F.lane;
    for (int g = blockIdx.x * 8 + F.wave; g < NTOK; g += F.G * 8) {
        const bool sample = g >= NPTOK; const NbrOff no = nbr_offsets(g);
#pragma unroll 4
        for (int h = 0; h < NH; ++h) { const int chan = h * 64 + lane;
            const float r = mixed_val(PR, g, chan, nbr_pick(no, nbr_kind(sample, chan)), mu[chan]);
            const float k = mixed_val(PR, g, 1024 + chan, nbr_pick(no, nbr_kind(sample, 1024 + chan)), mu[1024 + chan]);
            const float v = mixed_val(PR, g, 2048 + chan, nbr_pick(no, nbr_kind(sample, 2048 + chan)), mu[2048 + chan]);
            const float yf = bf2f(MIX[(size_t)g * D + 1024 + chan]), yb = bf2f(YB[(size_t)g * RW + chan]);
            const float bon = wave_sum(r * k * rk[chan]);
            const float y = yf + yb + bon * v;
            const float mean = wave_sum(y) * (1.f / 64.f); const float dlt = y - mean;
            const float var = wave_sum(dlt * dlt) * (1.f / 64.f);
            const float yn = dlt * rsqrtf(var + 64e-5f) * lnw[chan] + lnb[chan];
            MIX[(size_t)g * D + 1024 + chan] = (bf16_t)f2bf(yn * bf2f(Gt[(size_t)g * RW + chan])); }
    }
}

__device__ __forceinline__ void p12_rows(Frame& F) {
    const float* MOD = (const float*)(F.ws + WS_MOD); const bf16_t* OUTB = (const bf16_t*)(F.ws + WS_PROJ); bf16_t* H2 = (bf16_t*)(F.ws + WS_H);
    const float* gpost = F.in[IN_NMPOST]; const float* gpre = F.in[IN_NFPRE];
    for (int row = blockIdx.x * 8 + F.wave; row < NTOK; row += F.G * 8) {
        const float* xr = row < NPTOK ? F.in[IN_XP] + (size_t)row * D : F.in[IN_XS] + (size_t)(row - NPTOK) * D;
        const float* md = MOD + modidx(row) * 12288;
        float o[32]; float ss = 0.f;
#pragma unroll
        for (int i = 0; i < 4; ++i) { const u32x4 w = *(const u32x4*)(OUTB + (size_t)row * D + (i * 64 + F.lane) * 8);
#pragma unroll
            for (int j = 0; j < 4; ++j) { o[i * 8 + 2 * j] = bflo(w[j]); o[i * 8 + 2 * j + 1] = bfhi(w[j]); }
#pragma unroll
            for (int j = 0; j < 8; ++j) ss += o[i * 8 + j] * o[i * 8 + j]; }
        ss = wave_sum(ss);
        const float rstd = rsqrtf(ss * (1.f / D) + 1e-6f);
        float ss2 = 0.f;
#pragma unroll
        for (int i = 0; i < 4; ++i) { const int col = (i * 64 + F.lane) * 8;
#pragma unroll
            for (int q = 0; q < 2; ++q) { const int c4 = col + q * 4;
                const float4 x = *(const float4*)(xr + c4), gp = *(const float4*)(gpost + c4), gm = *(const float4*)(md + 2 * D + c4);
                float4 r;
                r.x = x.x + gm.x * (o[i * 8 + q * 4 + 0] * rstd * gp.x); r.y = x.y + gm.y * (o[i * 8 + q * 4 + 1] * rstd * gp.y);
                r.z = x.z + gm.z * (o[i * 8 + q * 4 + 2] * rstd * gp.z); r.w = x.w + gm.w * (o[i * 8 + q * 4 + 3] * rstd * gp.w);
                *(float4*)(F.out + (size_t)row * D + c4) = r;
                o[i * 8 + q * 4 + 0] = r.x; o[i * 8 + q * 4 + 1] = r.y; o[i * 8 + q * 4 + 2] = r.z; o[i * 8 + q * 4 + 3] = r.w;
                ss2 += r.x * r.x + r.y * r.y + r.z * r.z + r.w * r.w; } }
        ss2 = wave_sum(ss2);
        const float rstd2 = rsqrtf(ss2 * (1.f / D) + 1e-6f);
#pragma unroll
        for (int i = 0; i < 4; ++i) { const int col = (i * 64 + F.lane) * 8; float hh[8];
#pragma unroll
            for (int q = 0; q < 2; ++q) { const int c4 = col + q * 4;
                const float4 g = *(const float4*)(gpre + c4), sc = *(const float4*)(md + 4 * D + c4), sh = *(const float4*)(md + 3 * D + c4);
                hh[q * 4 + 0] = o[i * 8 + q * 4 + 0] * rstd2 * g.x * (1.f + sc.x) + sh.x; hh[q * 4 + 1] = o[i * 8 + q * 4 + 1] * rstd2 * g.y * (1.f + sc.y) + sh.y;
                hh[q * 4 + 2] = o[i * 8 + q * 4 + 2] * rstd2 * g.z * (1.f + sc.z) + sh.z; hh[q * 4 + 3] = o[i * 8 + q * 4 + 3] * rstd2 * g.w * (1.f + sc.w) + sh.w; }
            *(u32x4*)(H2 + (size_t)row * D + col) = (u32x4){pk2(hh[0], hh[1]), pk2(hh[2], hh[3]), pk2(hh[4], hh[5]), pk2(hh[6], hh[7])}; }
    }
}
__device__ __forceinline__ void p15_rows(Frame& F) {
    const float* MOD = (const float*)(F.ws + WS_MOD); const bf16_t* Fb = (const bf16_t*)(F.ws + WS_H); const float* gpost = F.in[IN_NFPOST];
    for (int row = blockIdx.x * 8 + F.wave; row < NTOK; row += F.G * 8) {
        const float* md = MOD + modidx(row) * 12288;
        float o[32]; float ss = 0.f;
#pragma unroll
        for (int i = 0; i < 4; ++i) { const u32x4 w = *(const u32x4*)(Fb + (size_t)row * D + (i * 64 + F.lane) * 8);
#pragma unroll
            for (int j = 0; j < 4; ++j) { o[i * 8 + 2 * j] = bflo(w[j]); o[i * 8 + 2 * j + 1] = bfhi(w[j]); }
#pragma unroll
            for (int j = 0; j < 8; ++j) ss += o[i * 8 + j] * o[i * 8 + j]; }
        ss = wave_sum(ss);
        const float rstd = rsqrtf(ss * (1.f / D) + 1e-6f);
#pragma unroll
        for (int i = 0; i < 4; ++i) { const int col = (i * 64 + F.lane) * 8;
#pragma unroll
            for (int q = 0; q < 2; ++q) { const int c4 = col + q * 4; float* yp = F.out + (size_t)row * D + c4;
                const float4 x = *(const float4*)yp, gp = *(const float4*)(gpost + c4), gf = *(const float4*)(md + 5 * D + c4);
                float4 r;
                r.x = x.x + gf.x * (o[i * 8 + q * 4 + 0] * rstd * gp.x); r.y = x.y + gf.y * (o[i * 8 + q * 4 + 1] * rstd * gp.y);
                r.z = x.z + gf.z * (o[i * 8 + q * 4 + 2] * rstd * gp.z); r.w = x.w + gf.w * (o[i * 8 + q * 4 + 3] * rstd * gp.w);
                *(float4*)yp = r; } }
    }
}

constexpr int LDS_MISC = 131072, LDS_BYTES = 131072 + 256;
__global__ void __launch_bounds__(512, 2) fwd_kernel(Args args) {
    extern __shared__ __attribute__((aligned(16))) unsigned char lds_raw[];
    Frame F;
    F.lds = (LAS unsigned char*)lds_raw;
    F.tid = threadIdx.x; F.lane = F.tid & 63; F.wave = __builtin_amdgcn_readfirstlane(F.tid >> 6); F.G = gridDim.x;
    F.in = args.in; F.out = args.out; F.ws = args.ws;
    volatile LAS unsigned* MISC = (volatile LAS unsigned*)(F.lds + LDS_MISC);
    const int lo = args.ph_lo, hi = args.ph_hi;
    const bool fused = (hi - lo) > 1;
    if (F.tid < 64) MISC[F.tid] = 0u;
    __syncthreads();
    XcdBarrier bar; bar.bar = (unsigned*)(F.ws + WS_CTL); bar.x = 0; bar.st = MISC;
    if (fused) bar = xcd_barrier_post((unsigned*)(F.ws + WS_CTL), MISC);
#ifndef PH_MASK
#define PH_MASK 0xFFFF
#endif
#define IN(k) (((PH_MASK >> (k)) & 1) && lo <= (k) && (k) < hi)
#define SEAM(k) do { if (IN(k) && IN((k) + 1)) { if (MK_CG_FIRST && (k) == 0) { cg::this_grid().sync(); } else xcd_barrier(bar); } } while (0)
    unsigned char* ws = F.ws;
    if (IN(0)) p0_prologue(F);
    SEAM(0);
    if (IN(1)) p1_normmod(F);
    SEAM(1);
    if (IN(2)) { pg8::Gemm g{(const bf16_t*)(ws + WS_H), (const bf16_t*)(ws + WS_WTIN), D, D, D, 0}; pg8::StaticOrder S; S.init(NTOK, INWP, F.G, blockIdx.x);
        pg8::EpiBf16 E{(bf16_t*)(ws + WS_PROJ), INWP}; pg8::gemm_phase(F.lds, g, S, E); }
    SEAM(2);
    if (IN(3)) p3_elem(F);
    SEAM(3);
    if (IN(4)) { pg8::Gemm g{(const bf16_t*)(ws + WS_XC), (const bf16_t*)(ws + WS_BTLRU), LRUW, 256, 256, 1}; pg8::StaticOrder S; S.init(NTOK, 4096, F.G, blockIdx.x);
        pg8::EpiLru E{(unsigned*)F.out, (const bf16_t*)(ws + WS_XC), F.in[IN_BR], F.in[IN_BI], (const float*)(ws + WS_NL8)}; pg8::gemm_phase(F.lds, g, S, E); }
    SEAM(4);
    if (IN(5)) p5_lru_scan(F);
    SEAM(5);
    if (IN(6)) { pg8::Gemm g{(const bf16_t*)(ws + WS_LA), (const bf16_t*)(ws + WS_BTLORA), LAK, LAK, LAK, 0}; pg8::StaticOrder S; S.init(NTOK, 5120, F.G, blockIdx.x);
        pg8::EpiLora E{(bf16_t*)F.out, (bf16_t*)F.out + (size_t)NTOK * 2 * RW, (bf16_t*)(ws + WS_G), F.in[IN_W0], F.in[IN_A0]}; pg8::gemm_phase(F.lds, g, S, E); }
    SEAM(6);
    if (IN(7)) p7_wkv_pass1(F);
    SEAM(7);
    if (IN(8)) p8_wkv_combine(F);
    SEAM(8);
    if (IN(9)) p9_wkv_pass3(F);
    SEAM(9);
    if (IN(10)) p10_wkv_finish(F);
    SEAM(10);
    if (IN(11)) { pg8::Gemm g{(const bf16_t*)(ws + WS_H), (const bf16_t*)(ws + WS_WTOUT), D, D, D, 0}; pg8::StaticOrder S; S.init(NTOK, D, F.G, blockIdx.x);
        pg8::EpiBf16 E{(bf16_t*)(ws + WS_PROJ), D}; pg8::gemm_phase(F.lds, g, S, E); }
    SEAM(11);
    if (IN(12)) p12_rows(F);
    SEAM(12);
    if (IN(13)) { pg8::Gemm g{(const bf16_t*)(ws + WS_H), (const bf16_t*)(ws + WS_WTGU), D, D, D, 0}; pg8::StaticOrder S; S.init(NTOK, 2 * FFH, F.G, blockIdx.x);
        pg8::EpiGu E{(bf16_t*)(ws + WS_PROJ)}; pg8::gemm_phase(F.lds, g, S, E); }
    SEAM(13);
    if (IN(14)) { pg8::Gemm g{(const bf16_t*)(ws + WS_PROJ), (const bf16_t*)(ws + WS_WTDN), FFH, FFH, FFH, 0}; pg8::StaticOrder S; S.init(NTOK, D, F.G, blockIdx.x);
        pg8::EpiBf16 E{(bf16_t*)(ws + WS_H), D}; pg8::gemm_phase(F.lds, g, S, E); }
    SEAM(14);
    if (IN(15)) p15_rows(F);
#undef IN
#undef SEAM
}

extern "C" void kernel_launch(void* const* d_in, const int* in_sizes, int n_in, void* d_out, int out_size, void* d_ws, size_t ws_size, hipStream_t stream) {
    static int grid = 0;
    if (grid == 0) {
        if (n_in != 34 || ws_size < WS_END) { fprintf(stderr, "kernel_launch: need 34 inputs and >= %zu bytes of workspace; got %d, %zu\n", (size_t)WS_END, n_in, ws_size); grid = -1; return; }
        int dev = 0, cus = 0, per_cu = 0;
        if (hipGetDevice(&dev) != hipSuccess || hipDeviceGetAttribute(&cus, hipDeviceAttributeMultiprocessorCount, dev) != hipSuccess) { grid = -1; return; }
        if (hipFuncSetAttribute((const void*)fwd_kernel, hipFuncAttributeMaxDynamicSharedMemorySize, LDS_BYTES) != hipSuccess) { fprintf(stderr, "kernel_launch: hipFuncSetAttribute failed\n"); grid = -1; return; }
        if (hipOccupancyMaxActiveBlocksPerMultiprocessor(&per_cu, (const void*)fwd_kernel, 512, LDS_BYTES) != hipSuccess || per_cu < 1) { fprintf(stderr, "kernel_launch: occupancy query says %d\n", per_cu); per_cu = 1; }
        (void)hipGetLastError();
        grid = cus;
    }
    if (grid < 0) return;
    (void)hipMemsetAsync((char*)d_ws + WS_CTL, 0, 64 * 1024, stream);
    Args a{};
    for (int i = 0; i < 34; ++i) a.in[i] = (const float*)d_in[i];
    a.out = (float*)d_out; a.ws = (unsigned char*)d_ws;
#if MK_ONE_LAUNCH
    a.ph_lo = 0; a.ph_hi = NPHASE;
    void* kargs[] = {&a};
    hipError_t e = hipLaunchCooperativeKernel((const void*)fwd_kernel, dim3(grid), dim3(512), kargs, LDS_BYTES, stream);
    if (e != hipSuccess) fprintf(stderr, "cooperative launch failed: %s (grid %d)\n", hipGetErrorString(e), grid);
#else
    for (int p = 0; p < NPHASE; ++p) { a.ph_lo = p; a.ph_hi = p + 1; hipLaunchKernelGGL(fwd_kernel, dim3(grid), dim3(512), LDS_BYTES, stream, a); }
#endif
}
```

```cpp
#include <hip/hip_runtime.h>
#include <hip/hip_cooperative_groups.h>
#include <cstdio>
namespace cg = cooperative_groups;

#ifndef MK_ONE_LAUNCH
#define MK_ONE_LAUNCH 1
#endif
#ifndef MK_CG_FIRST
#define MK_CG_FIRST 1
#endif

#define LAS __attribute__((address_space(3)))
typedef unsigned short bf16_t;
typedef short bf16x8 __attribute__((ext_vector_type(8)));
typedef float f32x4 __attribute__((ext_vector_type(4)));
typedef unsigned u32x4 __attribute__((ext_vector_type(4)));
typedef unsigned u32x2 __attribute__((ext_vector_type(2)));

constexpr int D = 2048, NTOK = 16384, NPTOK = 8192, PSEQ = 256, SSEQ = 4096;
constexpr int LRUW = 1024, RW = 1024, NH = 16, RIN = 3360, INW = 5408, INWP = 5632, FFH = 5632;
constexpr int LAK = 384;
constexpr int NPHASE = 16;

constexpr size_t MiB = 1024 * 1024;
constexpr size_t WS_CTL = 0;
constexpr size_t WS_MOD = 64 * 1024;
constexpr size_t WS_NL8 = 256 * 1024;
constexpr size_t WS_BTLRU = 1 * MiB;
constexpr size_t WS_BTLORA = 3 * MiB;
constexpr size_t WS_WTOUT = 7 * MiB;
constexpr size_t WS_WTGU = 15 * MiB;
constexpr size_t WS_WTDN = 59 * MiB;
constexpr size_t WS_H = 81 * MiB;
constexpr size_t WS_PROJ = 145 * MiB;
constexpr size_t WS_S = 321 * MiB;
constexpr size_t WS_WTIN = WS_S;
constexpr size_t WS_XC = WS_S;
constexpr size_t WS_G = WS_S;
constexpr size_t WS_LA = WS_S + 32 * MiB;
constexpr size_t WS_YB = WS_S + 32 * MiB;
constexpr size_t WS_PQ = WS_S + 64 * MiB;
constexpr size_t WS_END = WS_S + 96 * MiB;
constexpr size_t WS_PRB = WS_WTOUT;

__device__ __forceinline__ float bf2f(unsigned b) { return __uint_as_float(b << 16); }
__device__ __forceinline__ float bflo(unsigned w) { return __uint_as_float(w << 16); }
__device__ __forceinline__ float bfhi(unsigned w) { return __uint_as_float(w & 0xffff0000u); }
__device__ __forceinline__ unsigned pk2(float lo, float hi) { unsigned r; asm("v_cvt_pk_bf16_f32 %0, %1, %2" : "=v"(r) : "v"(lo), "v"(hi)); return r; }
__device__ __forceinline__ unsigned f2bf(float f) { return pk2(f, 0.f) & 0xffffu; }
__device__ __forceinline__ void unpack8(const u32x4 w, float (&o)[8]) { o[0] = bflo(w[0]); o[1] = bfhi(w[0]); o[2] = bflo(w[1]); o[3] = bfhi(w[1]); o[4] = bflo(w[2]); o[5] = bfhi(w[2]); o[6] = bflo(w[3]); o[7] = bfhi(w[3]); }
__device__ __forceinline__ void lds_st8(LAS float* p, const float (&v)[8]) { *(LAS f32x4*)p = (f32x4){v[0], v[1], v[2], v[3]}; *(LAS f32x4*)(p + 4) = (f32x4){v[4], v[5], v[6], v[7]}; }
__device__ __forceinline__ void ld8(const float* p, float (&v)[8]) { const float4 a = *(const float4*)p, b = *(const float4*)(p + 4); v[0] = a.x; v[1] = a.y; v[2] = a.z; v[3] = a.w; v[4] = b.x; v[5] = b.y; v[6] = b.z; v[7] = b.w; }
__device__ __forceinline__ float sigmoidf_(float x) { return __builtin_amdgcn_rcpf(1.f + __expf(-x)); }
__device__ __forceinline__ float gelu_tanh(float x) { const float u = 0.7978845608028654f * (x + 0.044715f * x * x * x); return 0.5f * x * (1.f + tanhf(u)); }
template <int CTRL> __device__ __forceinline__ float dpp_f(float x) { return __builtin_bit_cast(float, __builtin_amdgcn_update_dpp(0, __builtin_bit_cast(int, x), CTRL, 0xf, 0xf, true)); }
__device__ __forceinline__ float red8(float x) { x += dpp_f<0xB1>(x); x += dpp_f<0x4E>(x); x += dpp_f<0x141>(x); return x; }
__device__ __forceinline__ float wave_sum(float x) { x = red8(x); x += dpp_f<0x140>(x); x += __shfl_xor(x, 16); x += __shfl_xor(x, 32); return x; }

__device__ __forceinline__ float vfma(float a, float b, float c) { float d; asm("v_fma_f32 %0, %1, %2, %3" : "=v"(d) : "v"(a), "v"(b), "v"(c)); return d; }
__device__ __forceinline__ float vadd(float a, float b) { float d; asm("v_add_f32 %0, %1, %2" : "=v"(d) : "v"(a), "v"(b)); return d; }
__device__ __forceinline__ float vmul(float a, float b) { float d; asm("v_mul_f32 %0, %1, %2" : "=v"(d) : "v"(a), "v"(b)); return d; }
__device__ __forceinline__ void red8x8(float (&x)[8]) {
    asm volatile(
        "s_nop 1\n\t"
        "v_add_f32_dpp %0, %0, %0 quad_perm:[1,0,3,2] row_mask:0xf bank_mask:0xf bound_ctrl:1\n\t"
        "v_add_f32_dpp %1, %1, %1 quad_perm:[1,0,3,2] row_mask:0xf bank_mask:0xf bound_ctrl:1\n\t"
        "v_add_f32_dpp %2, %2, %2 quad_perm:[1,0,3,2] row_mask:0xf bank_mask:0xf bound_ctrl:1\n\t"
        "v_add_f32_dpp %3, %3, %3 quad_perm:[1,0,3,2] row_mask:0xf bank_mask:0xf bound_ctrl:1\n\t"
        "v_add_f32_dpp %4, %4, %4 quad_perm:[1,0,3,2] row_mask:0xf bank_mask:0xf bound_ctrl:1\n\t"
        "v_add_f32_dpp %5, %5, %5 quad_perm:[1,0,3,2] row_mask:0xf bank_mask:0xf bound_ctrl:1\n\t"
        "v_add_f32_dpp %6, %6, %6 quad_perm:[1,0,3,2] row_mask:0xf bank_mask:0xf bound_ctrl:1\n\t"
        "v_add_f32_dpp %7, %7, %7 quad_perm:[1,0,3,2] row_mask:0xf bank_mask:0xf bound_ctrl:1\n\t"
        "v_add_f32_dpp %0, %0, %0 quad_perm:[2,3,0,1] row_mask:0xf bank_mask:0xf bound_ctrl:1\n\t"
        "v_add_f32_dpp %1, %1, %1 quad_perm:[2,3,0,1] row_mask:0xf bank_mask:0xf bound_ctrl:1\n\t"
        "v_add_f32_dpp %2, %2, %2 quad_perm:[2,3,0,1] row_mask:0xf bank_mask:0xf bound_ctrl:1\n\t"
        "v_add_f32_dpp %3, %3, %3 quad_perm:[2,3,0,1] row_mask:0xf bank_mask:0xf bound_ctrl:1\n\t"
        "v_add_f32_dpp %4, %4, %4 quad_perm:[2,3,0,1] row_mask:0xf bank_mask:0xf bound_ctrl:1\n\t"
        "v_add_f32_dpp %5, %5, %5 quad_perm:[2,3,0,1] row_mask:0xf bank_mask:0xf bound_ctrl:1\n\t"
        "v_add_f32_dpp %6, %6, %6 quad_perm:[2,3,0,1] row_mask:0xf bank_mask:0xf bound_ctrl:1\n\t"
        "v_add_f32_dpp %7, %7, %7 quad_perm:[2,3,0,1] row_mask:0xf bank_mask:0xf bound_ctrl:1\n\t"
        "v_add_f32_dpp %0, %0, %0 row_half_mirror row_mask:0xf bank_mask:0xf bound_ctrl:1\n\t"
        "v_add_f32_dpp %1, %1, %1 row_half_mirror row_mask:0xf bank_mask:0xf bound_ctrl:1\n\t"
        "v_add_f32_dpp %2, %2, %2 row_half_mirror row_mask:0xf bank_mask:0xf bound_ctrl:1\n\t"
        "v_add_f32_dpp %3, %3, %3 row_half_mirror row_mask:0xf bank_mask:0xf bound_ctrl:1\n\t"
        "v_add_f32_dpp %4, %4, %4 row_half_mirror row_mask:0xf bank_mask:0xf bound_ctrl:1\n\t"
        "v_add_f32_dpp %5, %5, %5 row_half_mirror row_mask:0xf bank_mask:0xf bound_ctrl:1\n\t"
        "v_add_f32_dpp %6, %6, %6 row_half_mirror row_mask:0xf bank_mask:0xf bound_ctrl:1\n\t"
        "v_add_f32_dpp %7, %7, %7 row_half_mirror row_mask:0xf bank_mask:0xf bound_ctrl:1\n\t"
        "s_nop 1"
        : "+v"(x[0]), "+v"(x[1]), "+v"(x[2]), "+v"(x[3]), "+v"(x[4]), "+v"(x[5]), "+v"(x[6]), "+v"(x[7]));
}

#define A8(op) op " %0, %8, %16\n\t" op " %1, %9, %16\n\t" op " %2, %10, %16\n\t" op " %3, %11, %16\n\t" op " %4, %12, %16\n\t" op " %5, %13, %16\n\t" op " %6, %14, %16\n\t" op " %7, %15, %16"
__device__ __forceinline__ void col_mul8(float (&acc)[8], float s0, float s1, float s2, float s3, float s4, float s5, float s6, float s7, float k) {
    asm(A8("v_mul_f32") : "=&v"(acc[0]), "=&v"(acc[1]), "=&v"(acc[2]), "=&v"(acc[3]), "=&v"(acc[4]), "=&v"(acc[5]), "=&v"(acc[6]), "=&v"(acc[7])
        : "v"(s0), "v"(s1), "v"(s2), "v"(s3), "v"(s4), "v"(s5), "v"(s6), "v"(s7), "v"(k));
}
__device__ __forceinline__ void col_mac8(float (&acc)[8], float s0, float s1, float s2, float s3, float s4, float s5, float s6, float s7, float k) {
    asm(A8("v_fmac_f32") : "+v"(acc[0]), "+v"(acc[1]), "+v"(acc[2]), "+v"(acc[3]), "+v"(acc[4]), "+v"(acc[5]), "+v"(acc[6]), "+v"(acc[7])
        : "v"(s0), "v"(s1), "v"(s2), "v"(s3), "v"(s4), "v"(s5), "v"(s6), "v"(s7), "v"(k));
}
#undef A8
template <bool HASV>
__device__ __forceinline__ void col_upd8(float& s0, float& s1, float& s2, float& s3, float& s4, float& s5, float& s6, float& s7, const float (&sa)[8], const float (&v)[8], float w, float kka, float kd) {
    if (HASV)
        asm("v_mul_f32 %0, %0, %24\n\tv_mul_f32 %1, %1, %24\n\tv_mul_f32 %2, %2, %24\n\tv_mul_f32 %3, %3, %24\n\tv_mul_f32 %4, %4, %24\n\tv_mul_f32 %5, %5, %24\n\tv_mul_f32 %6, %6, %24\n\tv_mul_f32 %7, %7, %24\n\t"
            "v_fmac_f32 %0, %8, %25\n\tv_fmac_f32 %1, %9, %25\n\tv_fmac_f32 %2, %10, %25\n\tv_fmac_f32 %3, %11, %25\n\tv_fmac_f32 %4, %12, %25\n\tv_fmac_f32 %5, %13, %25\n\tv_fmac_f32 %6, %14, %25\n\tv_fmac_f32 %7, %15, %25\n\t"
            "v_fmac_f32 %0, %16, %26\n\tv_fmac_f32 %1, %17, %26\n\tv_fmac_f32 %2, %18, %26\n\tv_fmac_f32 %3, %19, %26\n\tv_fmac_f32 %4, %20, %26\n\tv_fmac_f32 %5, %21, %26\n\tv_fmac_f32 %6, %22, %26\n\tv_fmac_f32 %7, %23, %26"
            : "+v"(s0), "+v"(s1), "+v"(s2), "+v"(s3), "+v"(s4), "+v"(s5), "+v"(s6), "+v"(s7)
            : "v"(sa[0]), "v"(sa[1]), "v"(sa[2]), "v"(sa[3]), "v"(sa[4]), "v"(sa[5]), "v"(sa[6]), "v"(sa[7]),
              "v"(v[0]), "v"(v[1]), "v"(v[2]), "v"(v[3]), "v"(v[4]), "v"(v[5]), "v"(v[6]), "v"(v[7]), "v"(w), "v"(kka), "v"(kd));
    else
        asm("v_mul_f32 %0, %0, %16\n\tv_mul_f32 %1, %1, %16\n\tv_mul_f32 %2, %2, %16\n\tv_mul_f32 %3, %3, %16\n\tv_mul_f32 %4, %4, %16\n\tv_mul_f32 %5, %5, %16\n\tv_mul_f32 %6, %6, %16\n\tv_mul_f32 %7, %7, %16\n\t"
            "v_fmac_f32 %0, %8, %17\n\tv_fmac_f32 %1, %9, %17\n\tv_fmac_f32 %2, %10, %17\n\tv_fmac_f32 %3, %11, %17\n\tv_fmac_f32 %4, %12, %17\n\tv_fmac_f32 %5, %13, %17\n\tv_fmac_f32 %6, %14, %17\n\tv_fmac_f32 %7, %15, %17"
            : "+v"(s0), "+v"(s1), "+v"(s2), "+v"(s3), "+v"(s4), "+v"(s5), "+v"(s6), "+v"(s7)
            : "v"(sa[0]), "v"(sa[1]), "v"(sa[2]), "v"(sa[3]), "v"(sa[4]), "v"(sa[5]), "v"(sa[6]), "v"(sa[7]), "v"(w), "v"(kka));
}

typedef float f32x2 __attribute__((ext_vector_type(2)));
#define PK8(op, tail) op " %0, %8, %16" tail "\n\t" op " %1, %9, %16" tail "\n\t" op " %2, %10, %16" tail "\n\t" op " %3, %11, %16" tail "\n\t" op " %4, %12, %16" tail "\n\t" op " %5, %13, %16" tail "\n\t" op " %6, %14, %16" tail "\n\t" op " %7, %15, %16" tail
__device__ __forceinline__ void pk_mul8(f32x2 (&acc)[8], f32x2 s0, f32x2 s1, f32x2 s2, f32x2 s3, f32x2 s4, f32x2 s5, f32x2 s6, f32x2 s7, f32x2 k) {
    asm(PK8("v_pk_mul_f32", "") : "=&v"(acc[0]), "=&v"(acc[1]), "=&v"(acc[2]), "=&v"(acc[3]), "=&v"(acc[4]), "=&v"(acc[5]), "=&v"(acc[6]), "=&v"(acc[7])
        : "v"(s0), "v"(s1), "v"(s2), "v"(s3), "v"(s4), "v"(s5), "v"(s6), "v"(s7), "v"(k));
}
__device__ __forceinline__ void pk_mac8(f32x2 (&acc)[8], f32x2 s0, f32x2 s1, f32x2 s2, f32x2 s3, f32x2 s4, f32x2 s5, f32x2 s6, f32x2 s7, f32x2 k) {
    asm("v_pk_fma_f32 %0, %8, %16, %0\n\tv_pk_fma_f32 %1, %9, %16, %1\n\tv_pk_fma_f32 %2, %10, %16, %2\n\tv_pk_fma_f32 %3, %11, %16, %3\n\t"
        "v_pk_fma_f32 %4, %12, %16, %4\n\tv_pk_fma_f32 %5, %13, %16, %5\n\tv_pk_fma_f32 %6, %14, %16, %6\n\tv_pk_fma_f32 %7, %15, %16, %7"
        : "+v"(acc[0]), "+v"(acc[1]), "+v"(acc[2]), "+v"(acc[3]), "+v"(acc[4]), "+v"(acc[5]), "+v"(acc[6]), "+v"(acc[7])
        : "v"(s0), "v"(s1), "v"(s2), "v"(s3), "v"(s4), "v"(s5), "v"(s6), "v"(s7), "v"(k));
}
#undef PK8
#define BLO " op_sel:[0,0,0] op_sel_hi:[0,1,1]"
#define BHI " op_sel:[1,0,0] op_sel_hi:[1,1,1]"
template <bool HASV>
__device__ __forceinline__ void pk_upd8(f32x2& s0, f32x2& s1, f32x2& s2, f32x2& s3, f32x2& s4, f32x2& s5, f32x2& s6, f32x2& s7, const f32x2 (&sap)[4], const f32x2 (&vp)[4], f32x2 w, f32x2 kka, f32x2 kd) {
    if (HASV)
        asm("v_pk_mul_f32 %0, %0, %16\n\tv_pk_mul_f32 %1, %1, %16\n\tv_pk_mul_f32 %2, %2, %16\n\tv_pk_mul_f32 %3, %3, %16\n\tv_pk_mul_f32 %4, %4, %16\n\tv_pk_mul_f32 %5, %5, %16\n\tv_pk_mul_f32 %6, %6, %16\n\tv_pk_mul_f32 %7, %7, %16\n\t"
            "v_pk_fma_f32 %0, %8, %17, %0" BLO "\n\tv_pk_fma_f32 %1, %8, %17, %1" BHI "\n\tv_pk_fma_f32 %2, %9, %17, %2" BLO "\n\tv_pk_fma_f32 %3, %9, %17, %3" BHI "\n\t"
            "v_pk_fma_f32 %4, %10, %17, %4" BLO "\n\tv_pk_fma_f32 %5, %10, %17, %5" BHI "\n\tv_pk_fma_f32 %6, %11, %17, %6" BLO "\n\tv_pk_fma_f32 %7, %11, %17, %7" BHI "\n\t"
            "v_pk_fma_f32 %0, %12, %18, %0" BLO "\n\tv_pk_fma_f32 %1, %12, %18, %1" BHI "\n\tv_pk_fma_f32 %2, %13, %18, %2" BLO "\n\tv_pk_fma_f32 %3, %13, %18, %3" BHI "\n\t"
            "v_pk_fma_f32 %4, %14, %18, %4" BLO "\n\tv_pk_fma_f32 %5, %14, %18, %5" BHI "\n\tv_pk_fma_f32 %6, %15, %18, %6" BLO "\n\tv_pk_fma_f32 %7, %15, %18, %7" BHI
            : "+v"(s0), "+v"(s1), "+v"(s2), "+v"(s3), "+v"(s4), "+v"(s5), "+v"(s6), "+v"(s7)
            : "v"(sap[0]), "v"(sap[1]), "v"(sap[2]), "v"(sap[3]), "v"(vp[0]), "v"(vp[1]), "v"(vp[2]), "v"(vp[3]), "v"(w), "v"(kka), "v"(kd));
    else
        asm("v_pk_mul_f32 %0, %0, %12\n\tv_pk_mul_f32 %1, %1, %12\n\tv_pk_mul_f32 %2, %2, %12\n\tv_pk_mul_f32 %3, %3, %12\n\tv_pk_mul_f32 %4, %4, %12\n\tv_pk_mul_f32 %5, %5, %12\n\tv_pk_mul_f32 %6, %6, %12\n\tv_pk_mul_f32 %7, %7, %12\n\t"
            "v_pk_fma_f32 %0, %8, %13, %0" BLO "\n\tv_pk_fma_f32 %1, %8, %13, %1" BHI "\n\tv_pk_fma_f32 %2, %9, %13, %2" BLO "\n\tv_pk_fma_f32 %3, %9, %13, %3" BHI "\n\t"
            "v_pk_fma_f32 %4, %10, %13, %4" BLO "\n\tv_pk_fma_f32 %5, %10, %13, %5" BHI "\n\tv_pk_fma_f32 %6, %11, %13, %6" BLO "\n\tv_pk_fma_f32 %7, %11, %13, %7" BHI
            : "+v"(s0), "+v"(s1), "+v"(s2), "+v"(s3), "+v"(s4), "+v"(s5), "+v"(s6), "+v"(s7)
            : "v"(sap[0]), "v"(sap[1]), "v"(sap[2]), "v"(sap[3]), "v"(w), "v"(kka));
}
#undef BLO
#undef BHI
__device__ __forceinline__ int modidx(int row) { return row < NPTOK ? 0 : 1 + ((row - NPTOK) >> 12); }

#define XB_TMO      128
#define XB_XCNT(j)  (256  + 64 * (j))
#define XB_XSUB(j)  (1280 + 64 * (j))
#define XB_XGEN(j)  (2304 + 64 * (j))
#define XB_TOP      3328
#define XB_TOPGEN   3392
#define XCD_BAR_WORDS 3456
#define XB_SPIN_CAP (1u << 22)
__device__ __forceinline__ unsigned xb_ld(unsigned* p)              { return __hip_atomic_load(p, __ATOMIC_RELAXED, __HIP_MEMORY_SCOPE_AGENT); }
__device__ __forceinline__ unsigned xb_add(unsigned* p, unsigned v) { return __hip_atomic_fetch_add(p, v, __ATOMIC_RELAXED, __HIP_MEMORY_SCOPE_AGENT); }
__device__ __forceinline__ unsigned xb_xcc_id() { return (unsigned)__builtin_amdgcn_s_getreg((3 << 11) | 20) & 0xFu; }
#define XB_SPIN(cond, bar) do { unsigned _sp = 0; while (cond) { __builtin_amdgcn_s_sleep(1); \
    if ((++_sp & 255u) == 0u) { if (xb_ld(&(bar)[XB_TMO])) break; if (_sp > XB_SPIN_CAP) { atomicAdd(&(bar)[XB_TMO], 1u); break; } } } } while (0)
struct XcdBarrier { unsigned* bar; unsigned x; volatile LAS unsigned* st; };
__device__ __forceinline__ XcdBarrier xcd_barrier_post(unsigned* bar, volatile LAS unsigned* st) {
    XcdBarrier b; b.bar = bar; b.x = xb_xcc_id(); b.st = st;
    if (threadIdx.x == 0) (void)xb_add(&bar[XB_XCNT(b.x)], 1u);
    return b;
}
__device__ __forceinline__ void xcd_barrier_complete(unsigned* bar, unsigned x, unsigned& nloc, unsigned& nx) {
    const unsigned G = gridDim.x * gridDim.y * gridDim.z;
    unsigned sum, cnt, mine, sp = 0u;
    for (;;) {
        sum = 0u; cnt = 0u; mine = 0u;
#pragma unroll
        for (unsigned j = 0; j < 16; ++j) { const unsigned c = xb_ld(&bar[XB_XCNT(j)]); sum += c; cnt += (c > 0u) ? 1u : 0u; mine = (j == x) ? c : mine; }
        if (sum == G) break;
        __builtin_amdgcn_s_sleep(1);
        if ((++sp & 255u) == 0u) { if (xb_ld(&bar[XB_TMO])) break; if (sp > XB_SPIN_CAP) { atomicAdd(&bar[XB_TMO], 1u); break; } }
    }
    nloc = mine > 0u ? mine : 1u; nx = cnt > 0u ? cnt : 1u;
}
__device__ __forceinline__ void xcd_barrier(const XcdBarrier& b) {
    asm volatile("s_waitcnt vmcnt(0)" ::: "memory");
    __syncthreads();
    if (threadIdx.x == 0) {
        unsigned* bar = b.bar;
        __builtin_amdgcn_s_waitcnt(0);
        unsigned nloc = b.st[0], nx = b.st[1];
        if (nloc == 0u) { xcd_barrier_complete(bar, b.x, nloc, nx); b.st[0] = nloc; b.st[1] = nx; }
        const unsigned old = xb_add(&bar[XB_XSUB(b.x)], 1u);
        const unsigned gen = old / nloc;
        if (old + 1u == (gen + 1u) * nloc) {
            __builtin_amdgcn_fence(__ATOMIC_RELEASE, "agent");
            asm volatile("s_waitcnt vmcnt(0)" ::: "memory");
            const unsigned og = xb_add(&bar[XB_TOP], 1u);
            const unsigned tg = og / nx;
            if (og + 1u == (tg + 1u) * nx) xb_add(&bar[XB_TOPGEN], 1u);
            else XB_SPIN(xb_ld(&bar[XB_TOPGEN]) == tg, bar);
            __builtin_amdgcn_fence(__ATOMIC_ACQUIRE, "agent");
            xb_add(&bar[XB_XGEN(b.x)], 1u);
            asm volatile("s_waitcnt vmcnt(0)" ::: "memory");
        } else {
            XB_SPIN(xb_ld(&bar[XB_XGEN(b.x)]) == gen, bar);
            __builtin_amdgcn_fence(__ATOMIC_ACQUIRE, "agent");
            asm volatile("s_waitcnt vmcnt(0)" ::: "memory");
        }
    }
    __syncthreads();
}

struct Args { const float* in[34]; float* out; unsigned char* ws; int ph_lo, ph_hi; };
struct Frame {
    LAS unsigned char* lds;
    int tid, lane, wave, G;
    const float* const* in;
    float* out; unsigned char* ws;
};
#define IN_XP 0
#define IN_XS 1
#define IN_SLRU 2
#define IN_SWKV 3
#define IN_C 4
#define IN_CCTX 5
#define IN_NMPRE 6
#define IN_NMPOST 7
#define IN_NFPRE 8
#define IN_NFPOST 9
#define IN_WMOD 10
#define IN_BMOD 11
#define IN_WIN 12
#define IN_CONVW 13
#define IN_CONVB 14
#define IN_WR 15
#define IN_BR 16
#define IN_WI 17
#define IN_BI 18
#define IN_LAM 19
#define IN_MU 20
#define IN_W0 21
#define IN_WUP 22
#define IN_A0 23
#define IN_AUP 24
#define IN_GUP 25
#define IN_KK 26
#define IN_KA 27
#define IN_RK 28
#define IN_LNW 29
#define IN_LNB 30
#define IN_WOUT 31
#define IN_WGU 32
#define IN_WDN 33

namespace pg8 {
constexpr int BM = 256, BK = 64, HALF = 128, HTB = HALF * BK * 2, STAGE_BYTES = 8 * HTB, NXCD = 8, WGM = 8;
__host__ __device__ __forceinline__ int lds_byte(int r, int c) { const int st = (r >> 4) * 2 + (c >> 5), rr = r & 15, cc = c & 31, ob = rr * 64 + cc * 2; return st * 1024 + (ob ^ (((ob >> 9) & 1) << 5)); }
__host__ __device__ __forceinline__ void stage_rc(int b, int& R, int& C) { const int st = b / 1024, sb = b % 1024, swz = sb ^ (((sb >> 9) & 1) << 5); R = (st >> 1) * 16 + swz / 64; C = (st & 1) * 32 + (swz % 64) / 2; }
__host__ __device__ __forceinline__ int perm32(int rho) { const int n = rho >> 4, i = rho & 15; return 8 * (i >> 2) + 4 * n + (i & 3); }
struct Unit { int pm, pn; };
struct Gemm { const bf16_t* A; const bf16_t* Bt; int lda, ldb, K; int lruoff; };
struct StaticOrder {
    int nM, nN, nwg, G, c;
    __device__ void init(int M, int N, int G_, int c_) { nM = M / BM; nN = N / BM; nwg = nM * nN; G = G_; c = c_; }
    __device__ bool next(int i, Unit& u) const {
        const long L = (long)i * G + c; if (L >= nwg) return false;
        int wgid = (int)L; { const int q = nwg / NXCD, r = nwg % NXCD, xcd = wgid % NXCD, off = wgid / NXCD; wgid = (xcd < r ? xcd * (q + 1) : r * (q + 1) + (xcd - r) * q) + off; }
        const int nig = WGM * nN, gid = wgid / nig, fm = gid * WGM, gsz = (nM - fm) < WGM ? (nM - fm) : WGM;
        u.pm = fm + ((wgid % nig) % gsz); u.pn = (wgid % nig) / gsz; return true;
    }
};
__device__ __forceinline__ size_t a_unit_off(const Gemm& g, const Unit& u) {
    size_t o = (size_t)u.pm * BM * g.lda * 2;
    if (g.lruoff == 1) { const int hd = u.pn >> 1; o += (size_t)(hd < 7 ? 128 * hd : 768) * 2; }
    if (g.lruoff == 2) { o += (size_t)(u.pn < 16 ? 0 : 128) * 2; }
    return o;
}

template <class Epi, bool ALIGN_EPI = true, bool SP2 = true>
__device__ __forceinline__ void gemm_phase(LAS unsigned char* lds, const Gemm g, const StaticOrder& S, const Epi& E) {
    const int tid = threadIdx.x, wid = __builtin_amdgcn_readfirstlane(tid >> 6), lane = tid & 63, wr = wid >> 2, wc = wid & 3, fr = lane & 15, fq = lane >> 4;
    const int nt = g.K / BK;
    unsigned voffA[2], voffB[2];
#pragma unroll
    for (int i = 0; i < 2; ++i) { int R, C; stage_rc(tid * 16 + i * 8192, R, C); const int Rb = (R & ~31) + perm32(R & 31);
        voffA[i] = (unsigned)(R * g.lda + C) * 2u; voffB[i] = (unsigned)(Rb * g.ldb + C) * 2u; }
    const size_t kstep = (size_t)(BK * 2);
    const size_t hstepA = (size_t)HALF * g.lda * 2, hstepB = (size_t)HALF * g.ldb * 2;
    const size_t tstepB = 2 * hstepB;
    const unsigned ldsw = (unsigned)wid * 1024u;
    const int aoff = lds_byte(wr * 64 + fr, fq * 8), boff = lds_byte(wc * 32 + fr, fq * 8);
#define PG8_SA(b, h) (((b) * 2 + (h)) * HTB)
#define PG8_SB(b, h) ((4 + (b) * 2 + (h)) * HTB)
#define PG8_STAGE(bufoff, gbase, voff) do { _Pragma("unroll") for (int _i = 0; _i < 2; ++_i) \
        __builtin_amdgcn_global_load_lds((const unsigned*)((const char*)(gbase) + (voff)[_i]), (LAS unsigned*)(lds + (bufoff) + ldsw + _i * 8192), 16, 0, 0); } while (0)
#define PG8_LDA(dst, b, h) do { _Pragma("unroll") for (int m = 0; m < 4; ++m) _Pragma("unroll") for (int k = 0; k < 2; ++k) dst[m][k] = *(const LAS bf16x8*)(lds + PG8_SA(b, h) + aoff + m * 2048 + k * 1024); } while (0)
#define PG8_LDB(dst, b, h) do { _Pragma("unroll") for (int n = 0; n < 2; ++n) _Pragma("unroll") for (int k = 0; k < 2; ++k) dst[n][k] = *(const LAS bf16x8*)(lds + PG8_SB(b, h) + boff + n * 2048 + k * 1024); } while (0)
#define PG8_MMA(ai, bj, At, Bt) do { __builtin_amdgcn_s_setprio(1); _Pragma("unroll") for (int m = 0; m < 4; ++m) _Pragma("unroll") for (int n = 0; n < 2; ++n) _Pragma("unroll") for (int k = 0; k < 2; ++k) \
        acc[ai][bj][m][n] = __builtin_amdgcn_mfma_f32_16x16x32_bf16(Bt[n][k], At[m][k], acc[ai][bj][m][n], 0, 0, 0); __builtin_amdgcn_s_setprio(0); } while (0)
#define PG8_WAIT_V(n) asm volatile("s_waitcnt vmcnt(" #n ")" ::: "memory")
#define PG8_WAIT_L(n) asm volatile("s_waitcnt lgkmcnt(" #n ")" ::: "memory")
#define PG8_BAR __builtin_amdgcn_s_barrier()
#define PG8_SCHED __builtin_amdgcn_sched_barrier(0)
    Unit cur, nxt; int ui = 0;
    if (!S.next(0, cur)) return;
    f32x4 acc[2][2][4][2];
#pragma unroll
    for (int a = 0; a < 2; ++a)
#pragma unroll
        for (int b = 0; b < 2; ++b)
#pragma unroll
            for (int m = 0; m < 4; ++m)
#pragma unroll
                for (int n = 0; n < 2; ++n) acc[a][b][m][n] = (f32x4){0.f, 0.f, 0.f, 0.f};
    bf16x8 At[4][2], B0[2][2], B1[2][2];
    const char* cA = (const char*)g.A + a_unit_off(g, cur); const char* cB = (const char*)g.Bt + (size_t)cur.pn * tstepB;
    if constexpr (SP2) {
        PG8_STAGE(PG8_SB(0, 0), cB, voffB); PG8_STAGE(PG8_SB(0, 1), cB + hstepB, voffB); PG8_STAGE(PG8_SA(0, 0), cA, voffA); PG8_STAGE(PG8_SA(0, 1), cA + hstepA, voffA);
        if (wr == 1) PG8_BAR;
        PG8_WAIT_V(2); PG8_BAR;
        PG8_STAGE(PG8_SB(1, 0), cB + kstep, voffB); PG8_STAGE(PG8_SA(1, 0), cA + kstep, voffA); PG8_STAGE(PG8_SB(1, 1), cB + hstepB + kstep, voffB);
        PG8_WAIT_V(6); PG8_BAR;
    } else {
    PG8_STAGE(PG8_SB(0, 0), cB, voffB); PG8_STAGE(PG8_SA(0, 0), cA, voffA); PG8_STAGE(PG8_SB(0, 1), cB + hstepB, voffB); PG8_STAGE(PG8_SA(0, 1), cA + hstepA, voffA);
    if (wr == 1) PG8_BAR;
    PG8_WAIT_V(4); PG8_BAR;
    PG8_STAGE(PG8_SB(1, 0), cB + kstep, voffB); PG8_STAGE(PG8_SA(1, 0), cA + kstep, voffA); PG8_STAGE(PG8_SB(1, 1), cB + hstepB + kstep, voffB);
    PG8_WAIT_V(6); PG8_BAR;
    }
    for (;;) {
        const bool has_next = S.next(ui + 1, nxt);
        const char* nA = has_next ? (const char*)g.A + a_unit_off(g, nxt) : cA; const char* nB = has_next ? (const char*)g.Bt + (size_t)nxt.pn * tstepB : cB;
#pragma unroll 1
        for (int t = 0; t < nt; t += 2) {
            const bool last = (t == nt - 2);
            const char* a1 = cA + (size_t)(t + 1) * kstep;
            const char* a2 = last ? nA : cA + (size_t)(t + 2) * kstep; const char* b2 = last ? nB : cB + (size_t)(t + 2) * kstep;
            const char* a3 = a2 + kstep; const char* b3 = b2 + kstep;
            if constexpr (SP2) {
            PG8_LDB(B0, 0, 0); PG8_LDB(B1, 0, 1); PG8_SCHED; PG8_LDA(At, 0, 0); PG8_STAGE(PG8_SA(1, 1), a1 + hstepA, voffA);
            PG8_WAIT_V(8); PG8_WAIT_L(0); PG8_BAR; PG8_MMA(0, 0, At, B0); PG8_MMA(0, 1, At, B1); PG8_BAR; PG8_SCHED;
            PG8_LDA(At, 0, 1); PG8_STAGE(PG8_SB(0, 0), b2, voffB); PG8_STAGE(PG8_SB(0, 1), b2 + hstepB, voffB); PG8_STAGE(PG8_SA(0, 0), a2, voffA);
            PG8_WAIT_V(8); PG8_WAIT_L(0); PG8_BAR; PG8_MMA(1, 0, At, B0); PG8_MMA(1, 1, At, B1); PG8_BAR; PG8_SCHED;
            PG8_LDB(B0, 1, 0); PG8_LDB(B1, 1, 1); PG8_SCHED; PG8_LDA(At, 1, 0); PG8_STAGE(PG8_SA(0, 1), a2 + hstepA, voffA);
            PG8_WAIT_V(8); PG8_WAIT_L(0); PG8_BAR; PG8_MMA(0, 0, At, B0); PG8_MMA(0, 1, At, B1); PG8_BAR; PG8_SCHED;
            PG8_LDA(At, 1, 1); PG8_STAGE(PG8_SB(1, 0), b3, voffB); PG8_STAGE(PG8_SB(1, 1), b3 + hstepB, voffB); PG8_STAGE(PG8_SA(1, 0), a3, voffA);
            PG8_WAIT_V(8); PG8_WAIT_L(0); PG8_BAR; PG8_MMA(1, 0, At, B0); PG8_MMA(1, 1, At, B1); PG8_BAR; PG8_SCHED;
            } else {
            PG8_LDB(B0, 0, 0); PG8_SCHED; PG8_LDA(At, 0, 0); PG8_STAGE(PG8_SA(1, 1), a1 + hstepA, voffA);
            PG8_WAIT_L(8); PG8_BAR; PG8_WAIT_L(0); PG8_MMA(0, 0, At, B0); PG8_BAR; PG8_SCHED;
            PG8_LDB(B1, 0, 1); PG8_STAGE(PG8_SB(0, 0), b2, voffB);
            PG8_BAR; PG8_WAIT_L(0); PG8_MMA(0, 1, At, B1); PG8_BAR;
            PG8_LDA(At, 0, 1); PG8_STAGE(PG8_SA(0, 0), a2, voffA);
            PG8_BAR; PG8_WAIT_L(0); PG8_MMA(1, 0, At, B0); PG8_BAR; PG8_SCHED;
            PG8_STAGE(PG8_SB(0, 1), b2 + hstepB, voffB);
            PG8_WAIT_V(6); PG8_BAR; PG8_MMA(1, 1, At, B1); PG8_BAR;
            PG8_LDB(B0, 1, 0); PG8_SCHED; PG8_LDA(At, 1, 0); PG8_STAGE(PG8_SA(0, 1), a2 + hstepA, voffA);
            PG8_WAIT_L(8); PG8_BAR; PG8_WAIT_L(0); PG8_MMA(0, 0, At, B0); PG8_BAR; PG8_SCHED;
            PG8_LDB(B1, 1, 1); PG8_STAGE(PG8_SB(1, 0), b3, voffB);
            PG8_BAR; PG8_WAIT_L(0); PG8_MMA(0, 1, At, B1); PG8_BAR;
            PG8_LDA(At, 1, 1); PG8_STAGE(PG8_SA(1, 0), a3, voffA);
            PG8_BAR; PG8_WAIT_L(0); PG8_MMA(1, 0, At, B0); PG8_BAR; PG8_SCHED;
            PG8_STAGE(PG8_SB(1, 1), b3 + hstepB, voffB);
            PG8_WAIT_V(6); PG8_BAR; PG8_MMA(1, 1, At, B1); PG8_BAR;
                    }
        }
        if constexpr (ALIGN_EPI) { if (wr == 0) PG8_BAR; }
        E(acc, cur, wr, wc, fr, fq);
        if (!has_next) break;
#pragma unroll
        for (int a = 0; a < 2; ++a)
#pragma unroll
            for (int b = 0; b < 2; ++b)
#pragma unroll
                for (int m = 0; m < 4; ++m)
#pragma unroll
                    for (int n = 0; n < 2; ++n) acc[a][b][m][n] = (f32x4){0.f, 0.f, 0.f, 0.f};
        cur = nxt; cA = nA; cB = nB; ++ui;
        if constexpr (ALIGN_EPI) { if (wr == 1) PG8_BAR; }
    }
    PG8_WAIT_V(0);
    if constexpr (!ALIGN_EPI) { if (wr == 0) PG8_BAR; }
    PG8_BAR;
#undef PG8_SA
#undef PG8_SB
#undef PG8_STAGE
#undef PG8_LDA
#undef PG8_LDB
#undef PG8_MMA
#undef PG8_WAIT_V
#undef PG8_WAIT_L
#undef PG8_BAR
#undef PG8_SCHED
}

struct EpiBf16 {
    bf16_t* O; int ldc;
    __device__ __forceinline__ void operator()(const f32x4 (&acc)[2][2][4][2], const Unit& u, int wr, int wc, int fr, int fq) const {
        const int row0 = u.pm * BM + wr * 64 + fr, col0 = u.pn * BM + wc * 32 + 8 * fq;
#pragma unroll
        for (int ai = 0; ai < 2; ++ai)
#pragma unroll
            for (int m = 0; m < 4; ++m) { bf16_t* rowp = O + (size_t)(row0 + ai * HALF + m * 16) * ldc + col0;
#pragma unroll
                for (int bj = 0; bj < 2; ++bj) { const f32x4 v0 = acc[ai][bj][m][0], v1 = acc[ai][bj][m][1];
                    *(u32x4*)(rowp + bj * HALF) = (u32x4){pk2(v0[0], v0[1]), pk2(v0[2], v0[3]), pk2(v1[0], v1[1]), pk2(v1[2], v1[3])}; } }
    }
};
struct EpiGu {
    bf16_t* O;
    __device__ __forceinline__ void operator()(const f32x4 (&acc)[2][2][4][2], const Unit& u, int wr, int wc, int fr, int fq) const {
        const int row0 = u.pm * BM + wr * 64 + fr, col0 = u.pn * HALF + wc * 32 + 8 * fq;
#pragma unroll
        for (int ai = 0; ai < 2; ++ai)
#pragma unroll
            for (int m = 0; m < 4; ++m) { bf16_t* rowp = O + (size_t)(row0 + ai * HALF + m * 16) * FFH + col0;
                float o[8];
#pragma unroll
                for (int n = 0; n < 2; ++n)
#pragma unroll
                    for (int i = 0; i < 4; ++i) { const float gt = acc[ai][0][m][n][i], up = acc[ai][1][m][n][i]; o[n * 4 + i] = gt * sigmoidf_(gt) * up; }
                *(u32x4*)rowp = (u32x4){pk2(o[0], o[1]), pk2(o[2], o[3]), pk2(o[4], o[5]), pk2(o[6], o[7])}; }
    }
};
struct EpiLru {
    unsigned* LAB; const bf16_t* XC; const float* br; const float* bi; const float* nl8;
    __device__ __forceinline__ void operator()(const f32x4 (&acc)[2][2][4][2], const Unit& u, int wr, int wc, int fr, int fq) const {
        const int hd = u.pn >> 1, dir = u.pn & 1;
        const int row0 = u.pm * BM + wr * 64 + fr, ch0 = wc * 32 + 8 * fq, chan0 = hd * 128 + ch0;
        const float* brp = br + (dir * 8 + hd) * 128 + ch0; const float* bip = bi + (dir * 8 + hd) * 128 + ch0; const float* nlp = nl8 + dir * 1024 + chan0;
#pragma unroll
        for (int ai = 0; ai < 2; ++ai)
#pragma unroll
            for (int m = 0; m < 4; ++m) { const int row = row0 + ai * HALF + m * 16;
                const u32x4 xw = *(const u32x4*)(XC + (size_t)row * LRUW + chan0);
                unsigned* dst = LAB + ((size_t)row * 2 + dir) * LRUW + chan0;
#pragma unroll
                for (int n = 0; n < 2; ++n) { const f32x4 brv = *(const f32x4*)(brp + 4 * n), biv = *(const f32x4*)(bip + 4 * n), nlv = *(const f32x4*)(nlp + 4 * n);
                    unsigned o[4];
#pragma unroll
                    for (int i = 0; i < 4; ++i) { const int e = n * 4 + i;
                        const float xc = (e & 1) ? bfhi(xw[e >> 1]) : bflo(xw[e >> 1]);
                        const float rg = sigmoidf_(acc[ai][0][m][n][i] + brv[i]), ig = sigmoidf_(acc[ai][1][m][n][i] + biv[i]);
                        const float la = rg * nlv[i], x2 = 2.f * la;
                        const float om = 1.f - __builtin_amdgcn_exp2f(x2 * 1.44269504f);
                        const float bb = __builtin_amdgcn_sqrtf(om) * ig * xc;
                        o[i] = pk2(la, bb); }
                    *(u32x4*)(dst + 4 * n) = (u32x4){o[0], o[1], o[2], o[3]};
                    __builtin_amdgcn_sched_barrier(0); } }
    }
};
struct EpiLora {
    bf16_t* E; bf16_t* AA; bf16_t* Gt; const float* w0; const float* a0;
    __device__ __forceinline__ void operator()(const f32x4 (&acc)[2][2][4][2], const Unit& u, int wr, int wc, int fr, int fq) const {
        const int type = u.pn >> 2, d = type & 1;
        const int row0 = u.pm * BM + wr * 64 + fr;
        const float* bsrc = type < 2 ? w0 + d * RW : a0 + d * RW;
        bf16_t* obase = type < 2 ? E + d * RW : (type < 4 ? AA + d * RW : Gt);
        const int opitch = type < 4 ? 2 * RW : RW;
        const float sc = type < 2 ? 0.60653066f : 1.f;
#pragma unroll
        for (int bj = 0; bj < 2; ++bj) { const int ch0 = (u.pn & 3) * 256 + bj * HALF + wc * 32 + 8 * fq;
#pragma unroll
            for (int ai = 0; ai < 2; ++ai)
#pragma unroll
                for (int m = 0; m < 4; ++m) { const int row = row0 + ai * HALF + m * 16;
                    float o[8];
#pragma unroll
                    for (int n = 0; n < 2; ++n) { f32x4 bias = (f32x4){0.f, 0.f, 0.f, 0.f}; if (type < 4) bias = *(const f32x4*)(bsrc + ch0 + 4 * n);
#pragma unroll
                        for (int i = 0; i < 4; ++i) { const float z = acc[ai][bj][m][n][i] + bias[i]; o[n * 4 + i] = type < 4 ? sc * sigmoidf_(z) : z; } }
                    *(u32x4*)(obase + (size_t)row * opitch + ch0) = (u32x4){pk2(o[0], o[1]), pk2(o[2], o[3]), pk2(o[4], o[5]), pk2(o[6], o[7])};
                    __builtin_amdgcn_sched_barrier(0); } }
    }
};
}

struct XTile { const float* src; int ldsrc, ncv, k0, n0; bf16_t* dst; int lddst, drow0; };
__device__ __forceinline__ XTile xtile_desc(Frame& F, int ti) {
    const int T_IN = 32 * 88, T_OUT = 32 * 32, T_GU = 32 * 176;
    unsigned char* ws = F.ws; XTile t;
    if (ti < T_IN) { const int kt = ti / 88, nt = ti % 88; t = XTile{F.in[IN_WIN], INW, INW, kt * 64, nt * 64, (bf16_t*)(ws + WS_WTIN), D, nt * 64}; }
    else if (ti < T_IN + T_OUT) { const int t2 = ti - T_IN, kt = t2 / 32, nt = t2 % 32; t = XTile{F.in[IN_WOUT], D, D, kt * 64, nt * 64, (bf16_t*)(ws + WS_WTOUT), D, nt * 64}; }
    else if (ti < T_IN + T_OUT + T_GU) { const int t2 = ti - T_IN - T_OUT, kt = t2 / 176, nt = t2 % 176, n0 = nt * 64;
        const int drow0 = n0 < FFH ? (n0 / 128) * 256 + (n0 % 128) : ((n0 - FFH) / 128) * 256 + 128 + ((n0 - FFH) % 128);
        t = XTile{F.in[IN_WGU], 2 * FFH, 2 * FFH, kt * 64, n0, (bf16_t*)(ws + WS_WTGU), D, drow0}; }
    else { const int t2 = ti - T_IN - T_OUT - T_GU, kt = t2 / 32, nt = t2 % 32; t = XTile{F.in[IN_WDN], D, D, kt * 64, nt * 64, (bf16_t*)(ws + WS_WTDN), FFH, nt * 64}; }
    return t;
}
__device__ __forceinline__ void xtile_load(const XTile& t, int tid, float4& v0, float4& v1) {
    const int r = tid >> 4, c4 = (tid & 15) * 4;
    v0 = make_float4(0.f, 0.f, 0.f, 0.f); v1 = v0;
    if (t.n0 + c4 < t.ncv) { v0 = *(const float4*)(t.src + (size_t)(t.k0 + r) * t.ldsrc + t.n0 + c4); v1 = *(const float4*)(t.src + (size_t)(t.k0 + r + 32) * t.ldsrc + t.n0 + c4); }
}
__device__ __forceinline__ void xpose_all(Frame& F) {
    const int T_ALL = 32 * 88;
    LAS bf16_t* tl = (LAS bf16_t*)F.lds;
    const int tid = F.tid, r = tid >> 4, c4 = (tid & 15) * 4;
    int ti = blockIdx.x; if (ti >= T_ALL) return;
    XTile cur = xtile_desc(F, ti); float4 v0, v1; xtile_load(cur, tid, v0, v1);
    for (;;) {
        const int tn = ti + F.G; const bool has = tn < T_ALL;
        XTile nxt = cur; float4 n0 = v0, n1 = v1;
        if (has) { nxt = xtile_desc(F, tn); xtile_load(nxt, tid, n0, n1); }
        tl[(c4 + 0) * 68 + r] = (bf16_t)f2bf(v0.x); tl[(c4 + 1) * 68 + r] = (bf16_t)f2bf(v0.y); tl[(c4 + 2) * 68 + r] = (bf16_t)f2bf(v0.z); tl[(c4 + 3) * 68 + r] = (bf16_t)f2bf(v0.w);
        tl[(c4 + 0) * 68 + r + 32] = (bf16_t)f2bf(v1.x); tl[(c4 + 1) * 68 + r + 32] = (bf16_t)f2bf(v1.y); tl[(c4 + 2) * 68 + r + 32] = (bf16_t)f2bf(v1.z); tl[(c4 + 3) * 68 + r + 32] = (bf16_t)f2bf(v1.w);
        __syncthreads();
        { const int n = tid >> 3, kc = (tid & 7) * 8;
          const u32x2 va = *(const LAS u32x2*)(tl + n * 68 + kc), vb = *(const LAS u32x2*)(tl + n * 68 + kc + 4);
          *(u32x4*)(cur.dst + (size_t)(cur.drow0 + n) * cur.lddst + cur.k0 + kc) = (u32x4){va[0], va[1], vb[0], vb[1]}; }
        __syncthreads();
        if (!has) break;
        cur = nxt; v0 = n0; v1 = n1; ti = tn;
    }
}

__device__ __forceinline__ void xpose_tile_wave(const XTile& t, LAS bf16_t* tl, int lane) {
    const int q = lane >> 4, c4 = (lane & 15) * 4;
#pragma unroll
    for (int hf = 0; hf < 2; ++hf) {
        float4 v[8];
#pragma unroll
        for (int j = 0; j < 8; ++j) { const int k = 8 * (hf * 4 + (j >> 1)) + 2 * q + (j & 1);
            v[j] = (t.n0 + c4 < t.ncv) ? *(const float4*)(t.src + (size_t)(t.k0 + k) * t.ldsrc + t.n0 + c4) : make_float4(0.f, 0.f, 0.f, 0.f); }
#pragma unroll
        for (int m = 0; m < 4; ++m) { const int k0 = 8 * (hf * 4 + m) + 2 * q; const float4 a = v[2 * m], b = v[2 * m + 1];
            *(LAS unsigned*)(tl + (c4 + 0) * 68 + k0) = pk2(a.x, b.x); *(LAS unsigned*)(tl + (c4 + 1) * 68 + k0) = pk2(a.y, b.y);
            *(LAS unsigned*)(tl + (c4 + 2) * 68 + k0) = pk2(a.z, b.z); *(LAS unsigned*)(tl + (c4 + 3) * 68 + k0) = pk2(a.w, b.w); }
    }
    const int nr = lane >> 3, kc = (lane & 7) * 8;
#pragma unroll
    for (int r = 0; r < 8; ++r) { const int n = r * 8 + nr;
        const u32x2 va = *(const LAS u32x2*)(tl + n * 68 + kc), vb = *(const LAS u32x2*)(tl + n * 68 + kc + 4);
        *(u32x4*)(t.dst + (size_t)(t.drow0 + n) * t.lddst + t.k0 + kc) = (u32x4){va[0], va[1], vb[0], vb[1]}; }
}

__device__ __forceinline__ bool xtile_group_b(int ti) {
    const int T_IN = 32 * 88, T_OUT = 32 * 32, T_GU = 32 * 176;
    if (ti < T_IN + T_OUT) return true;
    if (ti < T_IN + T_OUT + T_GU) { const int nt = (ti - T_IN - T_OUT) % 176; const int unit = nt < 88 ? nt >> 1 : (nt - 88) >> 1; return unit < 24; }
    return false;
}
__device__ __forceinline__ void xpose_deferred(Frame& F, bool group_b, int first, int stride, LAS bf16_t* tl) {
    const int T0 = 32 * 88, T1 = 32 * 88 + 32 * 32 + 32 * 176 + 88 * 32;
    for (int ti = T0 + first; ti < T1; ti += stride) if (xtile_group_b(ti) == group_b) { const XTile t = xtile_desc(F, ti); xpose_tile_wave(t, tl, F.lane); }
}

__device__ __forceinline__ void p0_prologue(Frame& F) {
    const int tid = F.tid, G = F.G, bid = blockIdx.x;
    unsigned char* ws = F.ws;
    {
        LAS float* sv = (LAS float*)F.lds;
        LAS float* red = (LAS float*)(F.lds + 24576);
        const float* c = F.in[IN_C]; const float* cctx = F.in[IN_CCTX];
        for (int i = tid; i < 3 * D; i += 512) { const int r = i / D, k = i % D; const float cv = r == 0 ? cctx[k] : c[(r - 1) * D + k]; sv[i] = cv * sigmoidf_(cv); }
        __syncthreads();
        const float* wm = F.in[IN_WMOD]; const float* bm = F.in[IN_BMOD]; float* MOD = (float*)(ws + WS_MOD);
        for (int cb = bid; cb < 256; cb += G) {
            const int n0 = cb * 48;
            if (tid < 504) { const int cg4 = (tid % 12) * 4, kl = tid / 12;
                float a0[4] = {0, 0, 0, 0}, a1[4] = {0, 0, 0, 0}, a2[4] = {0, 0, 0, 0};
#pragma unroll 8
                for (int k = kl; k < D; k += 42) { const float4 w = *(const float4*)(wm + (size_t)k * 12288 + n0 + cg4);
                    const float s0 = sv[k], s1 = sv[D + k], s2 = sv[2 * D + k];
                    a0[0] += s0 * w.x; a0[1] += s0 * w.y; a0[2] += s0 * w.z; a0[3] += s0 * w.w;
                    a1[0] += s1 * w.x; a1[1] += s1 * w.y; a1[2] += s1 * w.z; a1[3] += s1 * w.w;
                    a2[0] += s2 * w.x; a2[1] += s2 * w.y; a2[2] += s2 * w.z; a2[3] += s2 * w.w; }
#pragma unroll
                for (int i = 0; i < 4; ++i) { red[(kl * 3 + 0) * 48 + cg4 + i] = a0[i]; red[(kl * 3 + 1) * 48 + cg4 + i] = a1[i]; red[(kl * 3 + 2) * 48 + cg4 + i] = a2[i]; } }
            __syncthreads();
            if (tid < 144) { const int r = tid / 48, j = tid % 48; float s = 0.f; for (int kl = 0; kl < 42; ++kl) s += red[(kl * 3 + r) * 48 + j]; MOD[r * 12288 + n0 + j] = s + bm[n0 + j]; }
            __syncthreads();
        }
    }
    xpose_all(F);
    {
        const size_t gt = (size_t)bid * 512 + tid, gs = (size_t)G * 512;
        bf16_t* btl = (bf16_t*)(ws + WS_BTLRU);
        const float* wr = F.in[IN_WR]; const float* wi = F.in[IN_WI];
        for (size_t it = gt; it < (size_t)4096 * 32; it += gs) { const int row = (int)(it & 4095), c0 = (int)(it >> 12) * 8;
            const int hd = row >> 9, q = (row >> 7) & 3, j = row & 127, koff = hd < 7 ? 128 * hd : 768, kk0 = c0 - (128 * hd - koff);
            float v[8];
            const float* W = ((q & 1) ? wi : wr) + ((size_t)((q >> 1) * 8 + hd) * 128) * 128 + j;
#pragma unroll
            for (int i = 0; i < 8; ++i) v[i] = (kk0 >= 0 && kk0 < 128) ? W[(size_t)(kk0 + i) * 128] : 0.f;
            *(u32x4*)(btl + (size_t)row * 256 + c0) = (u32x4){pk2(v[0], v[1]), pk2(v[2], v[3]), pk2(v[4], v[5]), pk2(v[6], v[7])}; }
        bf16_t* bto = (bf16_t*)(ws + WS_BTLORA);
        const float* wup = F.in[IN_WUP]; const float* aup = F.in[IN_AUP]; const float* gup = F.in[IN_GUP];
        for (size_t it = gt; it < (size_t)5120 * 32; it += gs) { const int n = (int)(it % 5120), k0 = (int)(it / 5120) * 8;
            float v[8];
            const float* src = nullptr;
            if (n < 2048) { if (k0 < 64) src = wup + ((size_t)(n >> 10) * 64 + k0) * RW + (n & 1023); }
            else if (n < 4096) { if (k0 >= 64 && k0 < 128) src = aup + ((size_t)((n - 2048) >> 10) * 64 + (k0 - 64)) * RW + (n & 1023); }
            else { if (k0 < 160) src = gup + (size_t)k0 * RW + (n - 4096); }
#pragma unroll
            for (int i = 0; i < 8; ++i) v[i] = src ? src[(size_t)i * RW] : 0.f;
            *(u32x4*)(bto + (size_t)n * 256 + k0) = (u32x4){pk2(v[0], v[1]), pk2(v[2], v[3]), pk2(v[4], v[5]), pk2(v[6], v[7])}; }
        float* nl8 = (float*)(ws + WS_NL8); const float* lam = F.in[IN_LAM];
        for (size_t idx = gt; idx < 2048; idx += gs) { const float l = lam[idx]; nl8[idx] = -8.f * log1pf(__expf(-l)); }
    }
}

__device__ __forceinline__ void p1_normmod(Frame& F) {
    const float* MOD = (const float*)(F.ws + WS_MOD); const float* g1 = F.in[IN_NMPRE]; bf16_t* H = (bf16_t*)(F.ws + WS_H);
    for (int row = blockIdx.x * 8 + F.wave; row < NTOK; row += F.G * 8) {
        const float* xr = row < NPTOK ? F.in[IN_XP] + (size_t)row * D : F.in[IN_XS] + (size_t)(row - NPTOK) * D;
        float4 v[8]; float ss = 0.f;
#pragma unroll
        for (int i = 0; i < 8; ++i) { v[i] = *(const float4*)(xr + (i * 64 + F.lane) * 4); ss += v[i].x * v[i].x + v[i].y * v[i].y + v[i].z * v[i].z + v[i].w * v[i].w; }
        ss = wave_sum(ss);
        const float rstd = rsqrtf(ss * (1.f / D) + 1e-6f);
        const float* md = MOD + modidx(row) * 12288;
#pragma unroll
        for (int i = 0; i < 8; ++i) { const int col = (i * 64 + F.lane) * 4;
            const float4 g = *(const float4*)(g1 + col), sc = *(const float4*)(md + D + col), sh = *(const float4*)(md + col);
            const float h0 = v[i].x * rstd * g.x * (1.f + sc.x) + sh.x, h1 = v[i].y * rstd * g.y * (1.f + sc.y) + sh.y;
            const float h2 = v[i].z * rstd * g.z * (1.f + sc.z) + sh.z, h3 = v[i].w * rstd * g.w * (1.f + sc.w) + sh.w;
            *(u32x2*)(H + (size_t)row * D + col) = (u32x2){pk2(h0, h1), pk2(h2, h3)}; }
    }
}

struct NbrOff { int o0, o1, o2, o3; };
__device__ __forceinline__ NbrOff nbr_offsets(int g) {
    NbrOff n;
    if (g < NPTOK) { const int t = g & (PSEQ - 1); n.o0 = t >= 1 ? -1 : 0; n.o1 = t < PSEQ - 1 ? 1 : 0; n.o2 = 0; n.o3 = 0; }
    else { const int t = (g - NPTOK) & (SSEQ - 1), row = t >> 6, col = t & 63; n.o0 = col >= 1 ? -1 : 0; n.o1 = col < 63 ? 1 : 0; n.o2 = row >= 1 ? -64 : 0; n.o3 = row < 63 ? 64 : 0; }
    return n;
}
__device__ __forceinline__ int nbr_kind(bool sample, int j) { return sample ? (j < 840 ? 0 : (j < 1680 ? 1 : (j < 2520 ? 2 : 3))) : (j < 1680 ? 0 : 1); }
__device__ __forceinline__ int nbr_pick(const NbrOff& n, int kind) { return kind == 0 ? n.o0 : (kind == 1 ? n.o1 : (kind == 2 ? n.o2 : n.o3)); }
__device__ __forceinline__ float mixed_val(const bf16_t* PR, int g, int j, int off, float mu) {
    const float p = bf2f(PR[(size_t)g * INWP + j]);
    const float q = off ? bf2f(PR[(size_t)(g + off) * INWP + j]) : 0.f;
    return p + mu * (q - p);
}

__device__ __forceinline__ void p3_elem(Frame& F) {
    const bf16_t* PROJ = (const bf16_t*)(F.ws + WS_PROJ); const bf16_t* PR = PROJ + 2048;
    bf16_t* XC = (bf16_t*)(F.ws + WS_XC); bf16_t* LA = (bf16_t*)(F.ws + WS_LA);
    const float* cw = F.in[IN_CONVW]; const float* cb = F.in[IN_CONVB]; const float* mu = F.in[IN_MU];
    const int lane = F.lane;
    for (int g = blockIdx.x * 8 + F.wave; g < NTOK; g += F.G * 8) {
        const bool sample = g >= NPTOK; const int T = sample ? SSEQ : PSEQ, t = sample ? ((g - NPTOK) & (SSEQ - 1)) : (g & (PSEQ - 1));
#pragma unroll
        for (int half = 0; half < 2; ++half) { const int c0 = half * 512 + lane * 8;
            float o[8];
#pragma unroll
            for (int i = 0; i < 8; ++i) o[i] = cb[c0 + i];
#pragma unroll
            for (int k = 0; k < 4; ++k) { const int tt = t + k - 2;
                if (tt >= 0 && tt < T) { const u32x4 w = *(const u32x4*)(PROJ + (size_t)(g + k - 2) * INWP + c0);
                    const float4 w0 = *(const float4*)(cw + k * LRUW + c0), w1 = *(const float4*)(cw + k * LRUW + c0 + 4);
                    o[0] += bflo(w[0]) * w0.x; o[1] += bfhi(w[0]) * w0.y; o[2] += bflo(w[1]) * w0.z; o[3] += bfhi(w[1]) * w0.w;
                    o[4] += bflo(w[2]) * w1.x; o[5] += bfhi(w[2]) * w1.y; o[6] += bflo(w[3]) * w1.z; o[7] += bfhi(w[3]) * w1.w; } }
            *(u32x4*)(XC + (size_t)g * LRUW + c0) = (u32x4){pk2(o[0], o[1]), pk2(o[2], o[3]), pk2(o[4], o[5]), pk2(o[6], o[7])}; }
        const NbrOff no = nbr_offsets(g);
        if (lane < 48) {
            u32x4 ov = (u32x4){0u, 0u, 0u, 0u};
            if (lane < 36) { const int j = 3072 + lane * 8; const int off = sample ? no.o3 : no.o1;
                const u32x4 pw = *(const u32x4*)(PR + (size_t)g * INWP + j), qw = *(const u32x4*)(PR + (size_t)(g + off) * INWP + j);
                float p[8], q[8], m[8], v[8]; unpack8(pw, p); unpack8(qw, q); ld8(mu + j, m); const float fl = off ? 1.f : 0.f;
#pragma unroll
                for (int i = 0; i < 8; ++i) { const float x = p[i] + m[i] * (q[i] * fl - p[i]); v[i] = lane < 8 ? tanhf(x) : (lane < 16 ? x : sigmoidf_(x)); }
                ov = (u32x4){pk2(v[0], v[1]), pk2(v[2], v[3]), pk2(v[4], v[5]), pk2(v[6], v[7])}; }
            *(u32x4*)(LA + (size_t)g * LAK + lane * 8) = ov; }
    }
}

template <bool SAMPLE>
__device__ __forceinline__ void lru_unit(Frame& F, int uu) {
    constexpr int CH = SAMPLE ? 16 : 64, CHP = CH / 2, NCH = 512 / CHP, NSEG = SAMPLE ? 4 : 1, CL = 16, SEGT = NCH * CL;
    const unsigned* LAB = (const unsigned*)F.out;
    const bf16_t* PROJ = (const bf16_t*)(F.ws + WS_PROJ); bf16_t* MIX = (bf16_t*)(F.ws + WS_H);
    LAS float* cinF = (LAS float*)F.lds;
    LAS float* cinB = (LAS float*)(F.lds + 16384);
    LAS float* aggA = (LAS float*)(F.lds + 32768);
    LAS float* aggB = (LAS float*)(F.lds + 32768 + 4096);
    LAS float* segc = (LAS float*)(F.lds + 32768 + 8192);
    const int tid = F.tid, c = tid / CHP, ch = (tid % CHP) * 2;
    float* nsl = F.out + (size_t)2 * NPTOK * D;
    const int ngrp = LRUW / CH, b = uu / ngrp, cgp = uu % ngrp, chan = cgp * CH + ch;
    const int g0 = SAMPLE ? NPTOK + b * SSEQ : b * PSEQ;
    for (int dir = 0; dir < 2; ++dir) {
        LAS float* cin = dir ? cinB : cinF;
        if (c == 0) { segc[ch] = SAMPLE ? F.in[IN_SLRU][(b * 2 + dir) * LRUW + chan] : 0.f; segc[ch + 1] = SAMPLE ? F.in[IN_SLRU][(b * 2 + dir) * LRUW + chan + 1] : 0.f; }
        __syncthreads();
        for (int si = 0; si < NSEG; ++si) { const int s = dir ? NSEG - 1 - si : si;
            const unsigned* p = LAB + ((size_t)(g0 + s * SEGT + c * CL) * 2 + dir) * LRUW + chan;
            u32x2 wv[CL];
#pragma unroll
            for (int i = 0; i < CL; ++i) wv[i] = *(const u32x2*)(p + (size_t)i * 2 * LRUW);
            float A0 = 1.f, B0 = 0.f, A1 = 1.f, B1 = 0.f;
            if (dir == 0) {
#pragma unroll
                for (int i = 0; i < CL; ++i) { const float a0 = __expf(bflo(wv[i][0])), a1 = __expf(bflo(wv[i][1])); B0 = a0 * B0 + bfhi(wv[i][0]); A0 *= a0; B1 = a1 * B1 + bfhi(wv[i][1]); A1 *= a1; }
            } else {
#pragma unroll
                for (int i = CL - 1; i >= 0; --i) { const float a0 = __expf(bflo(wv[i][0])), a1 = __expf(bflo(wv[i][1])); B0 = a0 * B0 + bfhi(wv[i][0]); A0 *= a0; B1 = a1 * B1 + bfhi(wv[i][1]); A1 *= a1; }
            }
            aggA[c * CH + ch] = A0; aggB[c * CH + ch] = B0; aggA[c * CH + ch + 1] = A1; aggB[c * CH + ch + 1] = B1;
            __syncthreads();
            if (tid < CH) { float carry = segc[tid];
                for (int k = 0; k < NCH; ++k) { const int cc = dir ? NCH - 1 - k : k; cin[(s * NCH + cc) * CH + tid] = carry; carry = aggA[cc * CH + tid] * carry + aggB[cc * CH + tid]; }
                segc[tid] = carry; }
            __syncthreads();
        }
        if (!SAMPLE && tid < CH) nsl[(size_t)(b * 2 + dir) * LRUW + cgp * CH + tid] = segc[tid];
        __syncthreads();
    }
    for (int s = 0; s < NSEG; ++s) {
        const int gb = g0 + s * SEGT + c * CL;
        const unsigned* pf = LAB + ((size_t)gb * 2 + 0) * LRUW + chan;
        const unsigned* pb = LAB + ((size_t)gb * 2 + 1) * LRUW + chan;
        float hf0[CL], hf1[CL]; float h0 = cinF[(s * NCH + c) * CH + ch], h1 = cinF[(s * NCH + c) * CH + ch + 1];
        u32x2 wv[CL]; unsigned glw[CL];
#pragma unroll
        for (int i = 0; i < CL; ++i) wv[i] = *(const u32x2*)(pf + (size_t)i * 2 * LRUW);
#pragma unroll
        for (int i = 0; i < CL; ++i) glw[i] = *(const unsigned*)(PROJ + (size_t)(gb + i) * INWP + LRUW + chan);
#pragma unroll
        for (int i = 0; i < CL; ++i) { h0 = __expf(bflo(wv[i][0])) * h0 + bfhi(wv[i][0]); h1 = __expf(bflo(wv[i][1])) * h1 + bfhi(wv[i][1]); hf0[i] = h0; hf1[i] = h1; }
#pragma unroll
        for (int i = 0; i < CL; ++i) wv[i] = *(const u32x2*)(pb + (size_t)i * 2 * LRUW);
        h0 = cinB[(s * NCH + c) * CH + ch]; h1 = cinB[(s * NCH + c) * CH + ch + 1];
#pragma unroll
        for (int i = CL - 1; i >= 0; --i) { h0 = __expf(bflo(wv[i][0])) * h0 + bfhi(wv[i][0]); h1 = __expf(bflo(wv[i][1])) * h1 + bfhi(wv[i][1]);
            *(unsigned*)(MIX + (size_t)(gb + i) * D + chan) = pk2((hf0[i] + h0) * gelu_tanh(bflo(glw[i])), (hf1[i] + h1) * gelu_tanh(bfhi(glw[i]))); }
    }
    __syncthreads();
}
__device__ __forceinline__ void p5_lru_scan(Frame& F) {
    const int half = F.G / 2;
    if ((int)blockIdx.x < half) { for (int u = blockIdx.x; u < 128; u += half) lru_unit<true>(F, u); }
    else { for (int u = blockIdx.x - half; u < 512; u += F.G - half) lru_unit<false>(F, u); }
}

struct WkvJob { int g0; int gstep; bool sample; int h; int dir; const float* S0; float* Sout; bf16_t* Y; int ypitch; };
constexpr int WNS = 8;
constexpr int WKV_LDS_PER_WAVE = (6 * WNS * 64 + WNS * 64) * 4;
template <int KIND, bool HAS_S0>
__device__ __forceinline__ void wkv_unit(Frame& F, const WkvJob& J) {
    const int lane = F.lane, vi = lane >> 3, ki = lane & 7;
    LAS float* L = (LAS float*)(F.lds + F.wave * WKV_LDS_PER_WAVE);
    LAS float* Ys = L + 6 * WNS * 64;
    const bf16_t* PR = (const bf16_t*)(F.ws + WS_PROJ) + 2048;
    const bf16_t* Eb = (const bf16_t*)F.out; const bf16_t* Ab = Eb + (size_t)NTOK * 2 * RW;
    const int ch8 = J.h * 64 + ki * 8, dir = J.dir;
    const int kd_r = nbr_kind(J.sample, ch8), kd_k = nbr_kind(J.sample, 1024 + ch8), kd_v = nbr_kind(J.sample, 2048 + ch8);
    float mu_r[8], mu_k[8], mu_v[8], k_k[8], k_a[8];
    ld8(F.in[IN_MU] + ch8, mu_r); ld8(F.in[IN_MU] + 1024 + ch8, mu_k); ld8(F.in[IN_MU] + 2048 + ch8, mu_v); ld8(F.in[IN_KK] + ch8, k_k); ld8(F.in[IN_KA] + ch8, k_a);
    f32x2 S[8][4];
    if (HAS_S0) {
#pragma unroll
        for (int i = 0; i < 8; ++i) { float t[8]; ld8(J.S0 + (vi * 8 + i) * 64 + ki * 8, t);
#pragma unroll
            for (int jp = 0; jp < 4; ++jp) S[i][jp] = (f32x2){t[2 * jp], t[2 * jp + 1]}; }
    } else {
#pragma unroll
        for (int i = 0; i < 8; ++i)
#pragma unroll
            for (int jp = 0; jp < 4; ++jp) S[i][jp] = (f32x2){(KIND == 1 && vi == ki && i == 2 * jp) ? 1.f : 0.f, (KIND == 1 && vi == ki && i == 2 * jp + 1) ? 1.f : 0.f};
    }
    u32x4 ro, rn, ko, kn, vo, vn, ee, aa; int vflags = 0;
#define WKV_FETCH(mc) do { const int g = J.g0 + ((mc) * WNS + vi) * J.gstep; const NbrOff no = nbr_offsets(g); \
        const int ofr = nbr_pick(no, kd_r), ofk = nbr_pick(no, kd_k), ofv = nbr_pick(no, kd_v); \
        vflags = (ofr ? 1 : 0) | (ofk ? 2 : 0) | (ofv ? 4 : 0); \
        const bf16_t* pg = PR + (size_t)g * INWP + ch8; \
        ro = *(const u32x4*)pg; rn = *(const u32x4*)(pg + (ptrdiff_t)ofr * INWP); ko = *(const u32x4*)(pg + 1024); kn = *(const u32x4*)(pg + (ptrdiff_t)ofk * INWP + 1024); \
        if (KIND != 1) { vo = *(const u32x4*)(pg + 2048); vn = *(const u32x4*)(pg + (ptrdiff_t)ofv * INWP + 2048); } \
        ee = *(const u32x4*)(Eb + ((size_t)g * 2 + dir) * RW + ch8); aa = *(const u32x4*)(Ab + ((size_t)g * 2 + dir) * RW + ch8); } while (0)
#define WKV_CONVERT() do { float t0[8], t1[8], rr[8], kx[8], kk[8], o[8]; \
        unpack8(ro, t0); unpack8(rn, t1); const float fr_ = (vflags & 1) ? 1.f : 0.f, fk_ = (vflags & 2) ? 1.f : 0.f, fv_ = (vflags & 4) ? 1.f : 0.f; \
        _Pragma("unroll") for (int i = 0; i < 8; ++i) rr[i] = t0[i] + mu_r[i] * (t1[i] * fr_ - t0[i]); \
        lds_st8(L + (4 * WNS + vi) * 64 + ki * 8, rr); \
        unpack8(ko, t0); unpack8(kn, t1); float ssq = 0.f; \
        _Pragma("unroll") for (int i = 0; i < 8; ++i) { kx[i] = t0[i] + mu_k[i] * (t1[i] * fk_ - t0[i]); kk[i] = kx[i] * k_k[i]; ssq += kk[i] * kk[i]; } \
        ssq = red8(ssq); const float rs = rsqrtf(fmaxf(ssq, 1e-24f)); \
        unpack8(aa, t1); unpack8(ee, t0); \
        _Pragma("unroll") for (int i = 0; i < 8; ++i) { kk[i] *= rs; o[i] = -kk[i]; } \
        lds_st8(L + (1 * WNS + vi) * 64 + ki * 8, o); \
        _Pragma("unroll") for (int i = 0; i < 8; ++i) o[i] = kk[i] * t1[i]; \
        lds_st8(L + (2 * WNS + vi) * 64 + ki * 8, o); \
        _Pragma("unroll") for (int i = 0; i < 8; ++i) o[i] = __expf(-t0[i]); \
        lds_st8(L + (0 * WNS + vi) * 64 + ki * 8, o); \
        if (KIND != 1) { \
            _Pragma("unroll") for (int i = 0; i < 8; ++i) o[i] = kx[i] * (1.f + (t1[i] - 1.f) * k_a[i]); \
            lds_st8(L + (3 * WNS + vi) * 64 + ki * 8, o); \
            unpack8(vo, t0); unpack8(vn, t1); \
            _Pragma("unroll") for (int i = 0; i < 8; ++i) o[i] = t0[i] + mu_v[i] * (t1[i] * fv_ - t0[i]); \
            lds_st8(L + (5 * WNS + vi) * 64 + ki * 8, o); } } while (0)
    WKV_FETCH(0);
    WKV_CONVERT();
    for (int mc = 0; mc < 256 / WNS; ++mc) {
        if (mc + 1 < 256 / WNS) WKV_FETCH(mc + 1);
#pragma unroll 2
        for (int s = 0; s < WNS; ++s) {
            f32x2 w[4], kk[4], kka[4], kd[4], r[4], vp[4];
#define WKV_LD8(dst, arr, off) do { const f32x4 _a = *(const LAS f32x4*)(L + ((arr) * WNS + s) * 64 + (off)), _b = *(const LAS f32x4*)(L + ((arr) * WNS + s) * 64 + (off) + 4); \
            dst[0] = (f32x2){_a[0], _a[1]}; dst[1] = (f32x2){_a[2], _a[3]}; dst[2] = (f32x2){_b[0], _b[1]}; dst[3] = (f32x2){_b[2], _b[3]}; } while (0)
            WKV_LD8(w, 0, ki * 8); WKV_LD8(kk, 1, ki * 8); WKV_LD8(kka, 2, ki * 8);
            if (KIND != 1) { WKV_LD8(kd, 3, ki * 8); WKV_LD8(vp, 5, vi * 8); }
            if (KIND == 0) WKV_LD8(r, 4, ki * 8);
            f32x2 acc[8]; float sa[8];
            pk_mul8(acc, S[0][0], S[1][0], S[2][0], S[3][0], S[4][0], S[5][0], S[6][0], S[7][0], kk[0]);
#pragma unroll
            for (int jp = 1; jp < 4; ++jp) pk_mac8(acc, S[0][jp], S[1][jp], S[2][jp], S[3][jp], S[4][jp], S[5][jp], S[6][jp], S[7][jp], kk[jp]);
#pragma unroll
            for (int i = 0; i < 8; ++i) sa[i] = vadd(acc[i][0], acc[i][1]);
            red8x8(sa);
            f32x2 sap[4];
#pragma unroll
            for (int p = 0; p < 4; ++p) sap[p] = (f32x2){sa[2 * p], sa[2 * p + 1]};
#pragma unroll
            for (int jp = 0; jp < 4; ++jp) pk_upd8<KIND != 1>(S[0][jp], S[1][jp], S[2][jp], S[3][jp], S[4][jp], S[5][jp], S[6][jp], S[7][jp], sap, vp, w[jp], kka[jp], kd[jp]);
            if (KIND == 0) {
                float y[8];
                pk_mul8(acc, S[0][0], S[1][0], S[2][0], S[3][0], S[4][0], S[5][0], S[6][0], S[7][0], r[0]);
#pragma unroll
                for (int jp = 1; jp < 4; ++jp) pk_mac8(acc, S[0][jp], S[1][jp], S[2][jp], S[3][jp], S[4][jp], S[5][jp], S[6][jp], S[7][jp], r[jp]);
#pragma unroll
                for (int i = 0; i < 8; ++i) y[i] = vadd(acc[i][0], acc[i][1]);
                red8x8(y);
                if (ki == 0) lds_st8(Ys + s * 64 + vi * 8, y);
            }
        }
        if (KIND == 0) {
            const f32x4 a = *(const LAS f32x4*)(Ys + vi * 64 + ki * 8), b = *(const LAS f32x4*)(Ys + vi * 64 + ki * 8 + 4);
            const int g = J.g0 + (mc * WNS + vi) * J.gstep;
            *(u32x4*)(J.Y + (size_t)g * J.ypitch + ch8) = (u32x4){pk2(a[0], a[1]), pk2(a[2], a[3]), pk2(b[0], b[1]), pk2(b[2], b[3])};
        }
        if (mc + 1 < 256 / WNS) WKV_CONVERT();
    }
    if (J.Sout) {
#pragma unroll
        for (int i = 0; i < 8; ++i) { float* d = J.Sout + (vi * 8 + i) * 64 + ki * 8;
            *(float4*)d = make_float4(S[i][0][0], S[i][0][1], S[i][1][0], S[i][1][1]); *(float4*)(d + 4) = make_float4(S[i][2][0], S[i][2][1], S[i][3][0], S[i][3][1]); }
    }
#undef WKV_FETCH
#undef WKV_CONVERT
#undef WKV_LD8
}

typedef __bf16 bf16x2_t __attribute__((ext_vector_type(2)));
__device__ __forceinline__ unsigned cvt2(f32x2 v) { return __builtin_bit_cast(unsigned, __builtin_convertvector(v, bf16x2_t)); }
#define BLO " op_sel:[0,0,0] op_sel_hi:[0,1,1]"
#define BHI " op_sel:[1,0,0] op_sel_hi:[1,1,1]"
template <bool HASV>
__device__ __forceinline__ void pk_upd8m(f32x2& s0, f32x2& s1, f32x2& s2, f32x2& s3, f32x2& s4, f32x2& s5, f32x2& s6, f32x2& s7, const f32x2 (&sv)[4],
                                         f32x2 w0, f32x2 w1, f32x2 ka0, f32x2 ka1, f32x2 kd0, f32x2 kd1) {
    if (HASV)
        asm("v_pk_mul_f32 %0, %0, %12\n\tv_pk_mul_f32 %1, %1, %13\n\tv_pk_mul_f32 %2, %2, %12\n\tv_pk_mul_f32 %3, %3, %13\n\tv_pk_mul_f32 %4, %4, %12\n\tv_pk_mul_f32 %5, %5, %13\n\tv_pk_mul_f32 %6, %6, %12\n\tv_pk_mul_f32 %7, %7, %13\n\t"
            "v_pk_fma_f32 %0, %8, %14, %0" BLO "\n\tv_pk_fma_f32 %1, %8, %15, %1" BLO "\n\tv_pk_fma_f32 %2, %9, %14, %2" BLO "\n\tv_pk_fma_f32 %3, %9, %15, %3" BLO "\n\t"
            "v_pk_fma_f32 %4, %10, %14, %4" BLO "\n\tv_pk_fma_f32 %5, %10, %15, %5" BLO "\n\tv_pk_fma_f32 %6, %11, %14, %6" BLO "\n\tv_pk_fma_f32 %7, %11, %15, %7" BLO "\n\t"
            "v_pk_fma_f32 %0, %8, %16, %0" BHI "\n\tv_pk_fma_f32 %1, %8, %17, %1" BHI "\n\tv_pk_fma_f32 %2, %9, %16, %2" BHI "\n\tv_pk_fma_f32 %3, %9, %17, %3" BHI "\n\t"
            "v_pk_fma_f32 %4, %10, %16, %4" BHI "\n\tv_pk_fma_f32 %5, %10, %17, %5" BHI "\n\tv_pk_fma_f32 %6, %11, %16, %6" BHI "\n\tv_pk_fma_f32 %7, %11, %17, %7" BHI
            : "+v"(s0), "+v"(s1), "+v"(s2), "+v"(s3), "+v"(s4), "+v"(s5), "+v"(s6), "+v"(s7)
            : "v"(sv[0]), "v"(sv[1]), "v"(sv[2]), "v"(sv[3]), "v"(w0), "v"(w1), "v"(ka0), "v"(ka1), "v"(kd0), "v"(kd1));
    else
        asm("v_pk_mul_f32 %0, %0, %12\n\tv_pk_mul_f32 %1, %1, %13\n\tv_pk_mul_f32 %2, %2, %12\n\tv_pk_mul_f32 %3, %3, %13\n\tv_pk_mul_f32 %4, %4, %12\n\tv_pk_mul_f32 %5, %5, %13\n\tv_pk_mul_f32 %6, %6, %12\n\tv_pk_mul_f32 %7, %7, %13\n\t"
            "v_pk_fma_f32 %0, %8, %14, %0" BLO "\n\tv_pk_fma_f32 %1, %8, %15, %1" BLO "\n\tv_pk_fma_f32 %2, %9, %14, %2" BLO "\n\tv_pk_fma_f32 %3, %9, %15, %3" BLO "\n\t"
            "v_pk_fma_f32 %4, %10, %14, %4" BLO "\n\tv_pk_fma_f32 %5, %10, %15, %5" BLO "\n\tv_pk_fma_f32 %6, %11, %14, %6" BLO "\n\tv_pk_fma_f32 %7, %11, %15, %7" BLO
            : "+v"(s0), "+v"(s1), "+v"(s2), "+v"(s3), "+v"(s4), "+v"(s5), "+v"(s6), "+v"(s7)
            : "v"(sv[0]), "v"(sv[1]), "v"(sv[2]), "v"(sv[3]), "v"(w0), "v"(w1), "v"(ka0), "v"(ka1));
}
#undef BLO
#undef BHI
constexpr int WKM_LDS_PER_WAVE = 12352;
template <int KIND, bool HAS_S0>
__device__ __forceinline__ void wkv_unit_m(Frame& F, const WkvJob& J) {
    const int lane = F.lane, vi = lane >> 3, ki = lane & 7;
    const int nl = lane & 15, q = lane >> 4;
    constexpr bool HASV = (KIND == 0 || KIND == 2), HASY = (KIND == 0 || KIND == 3), IDENT = (KIND == 1 || KIND == 3);
    LAS float* LW = (LAS float*)(F.lds + F.wave * WKM_LDS_PER_WAVE);
    LAS float* LKA = LW + 512; LAS float* LKD = LW + 1024; LAS float* LV = LW + 1536; LAS float* Ys = LW + 2048; LAS float* LC = LW + 2560;
    LAS bf16_t* LNK = (LAS bf16_t*)(LW + 2576); LAS bf16_t* LWR = LNK + 512;
    const bf16_t* PR = (const bf16_t*)(F.ws + WS_PROJ) + 2048;
    const bf16_t* Eb = (const bf16_t*)F.out; const bf16_t* Ab = Eb + (size_t)NTOK * 2 * RW;
    const int ch8 = J.h * 64 + ki * 8, dir = J.dir;
    const int kd_r = nbr_kind(J.sample, ch8), kd_k = nbr_kind(J.sample, 1024 + ch8), kd_v = nbr_kind(J.sample, 2048 + ch8);
    float one; asm volatile("v_mov_b32 %0, 1.0" : "=v"(one));
    f32x2 S[4][2][4];
#pragma unroll
    for (int tn = 0; tn < 4; ++tn)
#pragma unroll
        for (int ks = 0; ks < 2; ++ks) {
            if (HAS_S0) { float t[8]; ld8(J.S0 + (16 * tn + nl) * 64 + 32 * ks + 8 * q, t);
#pragma unroll
                for (int jp = 0; jp < 4; ++jp) S[tn][ks][jp] = (f32x2){t[2 * jp], t[2 * jp + 1]}; }
            else {
#pragma unroll
                for (int jp = 0; jp < 4; ++jp) { const int row = 16 * tn + nl, col = 32 * ks + 8 * q + 2 * jp;
                    S[tn][ks][jp] = (f32x2){(IDENT && row == col) ? 1.f : 0.f, (IDENT && row == col + 1) ? 1.f : 0.f}; } }
        }
    u32x4 ro, rn, ko, kn, vo, vn, ee, aa; int vflags = 0;
#define WKV_FETCH(mc) do { const int g = J.g0 + ((mc) * WNS + vi) * J.gstep; const NbrOff no = nbr_offsets(g); \
        const int ofr = nbr_pick(no, kd_r), ofk = nbr_pick(no, kd_k), ofv = nbr_pick(no, kd_v); \
        vflags = (ofr ? 1 : 0) | (ofk ? 2 : 0) | (ofv ? 4 : 0); \
        const bf16_t* pg = PR + (size_t)g * INWP + ch8; \
        ko = *(const u32x4*)(pg + 1024); kn = *(const u32x4*)(pg + (ptrdiff_t)ofk * INWP + 1024); \
        if (HASY) { ro = *(const u32x4*)pg; rn = *(const u32x4*)(pg + (ptrdiff_t)ofr * INWP); } \
        if (HASV) { vo = *(const u32x4*)(pg + 2048); vn = *(const u32x4*)(pg + (ptrdiff_t)ofv * INWP + 2048); } \
        ee = *(const u32x4*)(Eb + ((size_t)g * 2 + dir) * RW + ch8); aa = *(const u32x4*)(Ab + ((size_t)g * 2 + dir) * RW + ch8); } while (0)
#define WKV_CONVERT() do { float t0[8], t1[8], m[8], rr[8], kx[8], kk[8], wv[8], o[8]; \
        const float fr_ = (vflags & 1) ? 1.f : 0.f, fk_ = (vflags & 2) ? 1.f : 0.f, fv_ = (vflags & 4) ? 1.f : 0.f; \
        unpack8(ko, t0); unpack8(kn, t1); ld8(F.in[IN_MU] + 1024 + ch8, m); float ssq = 0.f; \
        _Pragma("unroll") for (int i = 0; i < 8; ++i) kx[i] = t0[i] + m[i] * (t1[i] * fk_ - t0[i]); \
        ld8(F.in[IN_KK] + ch8, m); \
        _Pragma("unroll") for (int i = 0; i < 8; ++i) { kk[i] = kx[i] * m[i]; ssq += kk[i] * kk[i]; } \
        ssq = red8(ssq); const float rs = rsqrtf(fmaxf(ssq, 1e-24f)); \
        _Pragma("unroll") for (int i = 0; i < 8; ++i) kk[i] *= rs; \
        *(LAS u32x4*)(LNK + vi * 64 + ki * 8) = (u32x4){pk2(-kk[0], -kk[1]), pk2(-kk[2], -kk[3]), pk2(-kk[4], -kk[5]), pk2(-kk[6], -kk[7])}; \
        unpack8(aa, t1); unpack8(ee, t0); \
        _Pragma("unroll") for (int i = 0; i < 8; ++i) { wv[i] = __expf(-t0[i]); kk[i] *= t1[i]; } \
        lds_st8(LW + vi * 64 + ki * 8, wv); lds_st8(LKA + vi * 64 + ki * 8, kk); \
        if (HASV) { ld8(F.in[IN_KA] + ch8, m); \
            _Pragma("unroll") for (int i = 0; i < 8; ++i) kx[i] = kx[i] * (1.f + (t1[i] - 1.f) * m[i]); \
            lds_st8(LKD + vi * 64 + ki * 8, kx); \
            unpack8(vo, t0); unpack8(vn, t1); ld8(F.in[IN_MU] + 2048 + ch8, m); \
            _Pragma("unroll") for (int i = 0; i < 8; ++i) o[i] = t0[i] + m[i] * (t1[i] * fv_ - t0[i]); \
            lds_st8(LV + vi * 64 + ki * 8, o); } \
        if (HASY) { unpack8(ro, t0); unpack8(rn, t1); ld8(F.in[IN_MU] + ch8, m); float c1 = 0.f, c2 = 0.f; \
            _Pragma("unroll") for (int i = 0; i < 8; ++i) { rr[i] = t0[i] + m[i] * (t1[i] * fr_ - t0[i]); c1 += kk[i] * rr[i]; if (HASV) c2 += kx[i] * rr[i]; wv[i] *= rr[i]; } \
            c1 = red8(c1); c2 = red8(c2); if (ki == 0) { LC[vi * 2] = c1; LC[vi * 2 + 1] = c2; } \
            *(LAS u32x4*)(LWR + vi * 64 + ki * 8) = (u32x4){pk2(wv[0], wv[1]), pk2(wv[2], wv[3]), pk2(wv[4], wv[5]), pk2(wv[6], wv[7])}; } } while (0)
    WKV_FETCH(0);
    WKV_CONVERT();
    for (int mc = 0; mc < 256 / WNS; ++mc) {
        if (mc + 1 < 256 / WNS) WKV_FETCH(mc + 1);
#pragma unroll 1
        for (int s = 0; s < WNS; ++s) {
            f32x2 w[2][4], ka[2][4], kd[2][4]; bf16x8 af[2]; float v[4];
#pragma unroll
            for (int ks = 0; ks < 2; ++ks) { const int o = s * 64 + 32 * ks + 8 * q;
                { const f32x4 a = *(const LAS f32x4*)(LW + o), b = *(const LAS f32x4*)(LW + o + 4); w[ks][0] = (f32x2){a[0], a[1]}; w[ks][1] = (f32x2){a[2], a[3]}; w[ks][2] = (f32x2){b[0], b[1]}; w[ks][3] = (f32x2){b[2], b[3]}; }
                { const f32x4 a = *(const LAS f32x4*)(LKA + o), b = *(const LAS f32x4*)(LKA + o + 4); ka[ks][0] = (f32x2){a[0], a[1]}; ka[ks][1] = (f32x2){a[2], a[3]}; ka[ks][2] = (f32x2){b[0], b[1]}; ka[ks][3] = (f32x2){b[2], b[3]}; }
                if (HASV) { const f32x4 a = *(const LAS f32x4*)(LKD + o), b = *(const LAS f32x4*)(LKD + o + 4); kd[ks][0] = (f32x2){a[0], a[1]}; kd[ks][1] = (f32x2){a[2], a[3]}; kd[ks][2] = (f32x2){b[0], b[1]}; kd[ks][3] = (f32x2){b[2], b[3]}; }
                af[ks] = *(const LAS bf16x8*)(((HASY && (nl & 1)) ? LWR : LNK) + o); }
#pragma unroll
            for (int tn = 0; tn < 4; ++tn) v[tn] = HASV ? LV[s * 64 + 16 * tn + nl] : 0.f;
            f32x4 d[4];
#pragma unroll
            for (int tn = 0; tn < 4; ++tn) { d[tn] = (f32x4){0.f, 0.f, 0.f, 0.f};
#pragma unroll
                for (int ks = 0; ks < 2; ++ks) { const u32x4 bw = (u32x4){cvt2(S[tn][ks][0]), cvt2(S[tn][ks][1]), cvt2(S[tn][ks][2]), cvt2(S[tn][ks][3])};
                    d[tn] = __builtin_amdgcn_mfma_f32_16x16x32_bf16(af[ks], __builtin_bit_cast(bf16x8, bw), d[tn], 0, 0, 0); } }
            f32x2 sv[4];
#pragma unroll
            for (int tn = 0; tn < 4; ++tn) sv[tn] = (f32x2){d[tn][0] * one, v[tn]};
#pragma unroll
            for (int jp = 0; jp < 4; ++jp)
                pk_upd8m<HASV>(S[0][0][jp], S[0][1][jp], S[1][0][jp], S[1][1][jp], S[2][0][jp], S[2][1][jp], S[3][0][jp], S[3][1][jp], sv, w[0][jp], w[1][jp], ka[0][jp], ka[1][jp], kd[0][jp], kd[1][jp]);
            if (HASY) { const float c1 = LC[s * 2], c2 = HASV ? LC[s * 2 + 1] : 0.f;
#pragma unroll
                for (int tn = 0; tn < 4; ++tn) { const float y = d[tn][1] + sv[tn][0] * c1 + v[tn] * c2; if (q == 0) Ys[s * 64 + 16 * tn + nl] = y; } }
        }
        if (HASY) {
            const f32x4 a = *(const LAS f32x4*)(Ys + vi * 64 + ki * 8), b = *(const LAS f32x4*)(Ys + vi * 64 + ki * 8 + 4);
            const int g = J.g0 + (mc * WNS + vi) * J.gstep;
            *(u32x4*)(J.Y + (size_t)g * J.ypitch + ch8) = (u32x4){pk2(a[0], a[1]), pk2(a[2], a[3]), pk2(b[0], b[1]), pk2(b[2], b[3])};
        }
        if (mc + 1 < 256 / WNS) WKV_CONVERT();
    }
    if (J.Sout) {
#pragma unroll
        for (int tn = 0; tn < 4; ++tn)
#pragma unroll
            for (int ks = 0; ks < 2; ++ks) { float* dp = J.Sout + (16 * tn + nl) * 64 + 32 * ks + 8 * q;
                *(float4*)dp = make_float4(S[tn][ks][0][0], S[tn][ks][0][1], S[tn][ks][1][0], S[tn][ks][1][1]); *(float4*)(dp + 4) = make_float4(S[tn][ks][2][0], S[tn][ks][2][1], S[tn][ks][3][0], S[tn][ks][3][1]); }
    }
#undef WKV_FETCH
#undef WKV_CONVERT
}
#ifndef WKV_MFMA
#define WKV_MFMA 1
#endif
#if WKV_MFMA
#define WKV_UNIT wkv_unit_m
#else
#define WKV_UNIT wkv_unit
#endif

__device__ __forceinline__ void p7_job_sample(WkvJob& J, float* PQ, int uq, int pq) {
    const int h = uq & 15, dir = (uq >> 4) & 1, chunk = (uq >> 5) & 15, b = uq >> 9;
    const int tt0 = chunk * 256, t0 = dir ? SSEQ - 1 - tt0 : tt0;
    J.sample = true; J.h = h; J.dir = dir; J.g0 = NPTOK + b * SSEQ + t0; J.gstep = dir ? -1 : 1; J.S0 = nullptr; J.Y = nullptr; J.ypitch = 0;
    const int chain = (b * 2 + dir) * 16 + h;
    J.Sout = PQ + ((size_t)(chain * 16 + chunk) * 2 + pq) * 4096;
}
__device__ __forceinline__ void p7_wkv_pass1(Frame& F) {
    float* PQ = (float*)(F.ws + WS_PQ); float* nsw = F.out + (size_t)2 * NPTOK * D + 32 * 2 * LRUW;
    bf16_t* MIX = (bf16_t*)(F.ws + WS_H); bf16_t* YB = (bf16_t*)(F.ws + WS_YB); bf16_t* PRB = (bf16_t*)(F.ws + WS_PRB);
    const int kindQ = (F.wave ^ (F.wave >> 2)) & 1;
    for (int bb = blockIdx.x; bb < 256; bb += F.G) { const int uq = bb * 4 + (F.wave & 3); WkvJob J;
        if (!kindQ) { const int h = uq & 15, dir = (uq >> 4) & 1, b = uq >> 5;
            J.sample = false; J.h = h; J.dir = dir; J.g0 = b * PSEQ + (dir ? PSEQ - 1 : 0); J.gstep = dir ? -1 : 1; J.S0 = nullptr;
            J.Sout = nsw + (size_t)((b * 2 + dir) * 16 + h) * 4096; }
        else p7_job_sample(J, PQ, uq, 1);
        J.Y = J.dir ? YB : MIX + 1024; J.ypitch = J.dir ? RW : D;
        wkv_unit_m<0, false>(F, J); }
    if (F.wave < 4) {
        for (int bb = blockIdx.x; bb < 256; bb += F.G) { WkvJob J; p7_job_sample(J, PQ, bb * 4 + F.wave, 0);
            J.Y = PRB + (ptrdiff_t)J.dir * RW - (ptrdiff_t)NPTOK * 2 * RW; J.ypitch = 2 * RW;
            wkv_unit_m<3, false>(F, J); }
    } else {
        xpose_deferred(F, false, blockIdx.x * 4 + (F.wave - 4), F.G * 4, (LAS bf16_t*)(F.lds + F.wave * WKM_LDS_PER_WAVE));
    }
}
__device__ __forceinline__ void p8_wkv_combine(Frame& F) {
    float* PQ = (float*)(F.ws + WS_PQ);
    LAS float* Sl = (LAS float*)F.lds; LAS float* Pl = (LAS float*)(F.lds + 16384);
    const int tid = F.tid, v = tid >> 3, kq = tid & 7;
    for (int chain = blockIdx.x; chain < 64; chain += F.G) {
        const float* s0 = F.in[IN_SWKV] + (size_t)chain * 4096;
        __syncthreads();
        { const float4 a = *(const float4*)(s0 + tid * 8), b = *(const float4*)(s0 + tid * 8 + 4);
          *(LAS f32x4*)(Sl + tid * 8) = (f32x4){a.x, a.y, a.z, a.w}; *(LAS f32x4*)(Sl + tid * 8 + 4) = (f32x4){b.x, b.y, b.z, b.w}; }
        const float* P0 = PQ + ((size_t)(chain * 16) * 2 + 0) * 4096; const float* Q0 = PQ + ((size_t)(chain * 16) * 2 + 1) * 4096;
        float4 pa = *(const float4*)(P0 + tid * 8), pb = *(const float4*)(P0 + tid * 8 + 4), qa = *(const float4*)(Q0 + v * 64 + kq * 8), qb = *(const float4*)(Q0 + v * 64 + kq * 8 + 4);
        for (int c = 0; c < 15; ++c) {
            float* Qc = PQ + ((size_t)(chain * 16 + c) * 2 + 1) * 4096;
            *(LAS f32x4*)(Pl + tid * 8) = (f32x4){pa.x, pa.y, pa.z, pa.w}; *(LAS f32x4*)(Pl + tid * 8 + 4) = (f32x4){pb.x, pb.y, pb.z, pb.w};
            float acc[8] = {qa.x, qa.y, qa.z, qa.w, qb.x, qb.y, qb.z, qb.w};
            if (c + 1 < 15) { const float* Pn = PQ + ((size_t)(chain * 16 + c + 1) * 2 + 0) * 4096; const float* Qn = Pn + 4096;
                pa = *(const float4*)(Pn + tid * 8); pb = *(const float4*)(Pn + tid * 8 + 4); qa = *(const float4*)(Qn + v * 64 + kq * 8); qb = *(const float4*)(Qn + v * 64 + kq * 8 + 4); }
            __syncthreads();
#pragma unroll 8
            for (int k = 0; k < 64; ++k) { const float s = Sl[v * 64 + k]; const f32x4 p0 = *(const LAS f32x4*)(Pl + k * 64 + kq * 8), p1 = *(const LAS f32x4*)(Pl + k * 64 + kq * 8 + 4);
                acc[0] += s * p0[0]; acc[1] += s * p0[1]; acc[2] += s * p0[2]; acc[3] += s * p0[3]; acc[4] += s * p1[0]; acc[5] += s * p1[1]; acc[6] += s * p1[2]; acc[7] += s * p1[3]; }
            __syncthreads();
            *(LAS f32x4*)(Sl + v * 64 + kq * 8) = (f32x4){acc[0], acc[1], acc[2], acc[3]}; *(LAS f32x4*)(Sl + v * 64 + kq * 8 + 4) = (f32x4){acc[4], acc[5], acc[6], acc[7]};
            *(float4*)(Qc + v * 64 + kq * 8) = make_float4(acc[0], acc[1], acc[2], acc[3]); *(float4*)(Qc + v * 64 + kq * 8 + 4) = make_float4(acc[4], acc[5], acc[6], acc[7]);
        }
    }
}
__device__ __forceinline__ void p9_wkv_pass3(Frame& F) {
    float* PQ = (float*)(F.ws + WS_PQ); bf16_t* MIX = (bf16_t*)(F.ws + WS_H); bf16_t* YB = (bf16_t*)(F.ws + WS_YB); const bf16_t* PRB = (const bf16_t*)(F.ws + WS_PRB);
    const int nl = F.lane & 15, q = F.lane >> 4;
    for (int u = blockIdx.x * 8 + F.wave; u < 1024; u += F.G * 8) {
        const int h = u & 15, dir = (u >> 4) & 1, chunk = (u >> 5) & 15, b = u >> 9;
        const int tt0 = chunk * 256, t0 = dir ? SSEQ - 1 - tt0 : tt0, chain = (b * 2 + dir) * 16 + h, gstep = dir ? -1 : 1, g0 = NPTOK + b * SSEQ + t0;
        const float* Sc = chunk == 0 ? F.in[IN_SWKV] + (size_t)chain * 4096 : PQ + ((size_t)(chain * 16 + chunk - 1) * 2 + 1) * 4096;
        bf16_t* Y = dir ? YB : MIX + 1024; const int ypitch = dir ? RW : D;
        bf16x8 a[4][2];
#pragma unroll
        for (int mt = 0; mt < 4; ++mt)
#pragma unroll
            for (int ks = 0; ks < 2; ++ks) { float t[8]; ld8(Sc + (16 * mt + nl) * 64 + 32 * ks + 8 * q, t);
                const u32x4 w = (u32x4){pk2(t[0], t[1]), pk2(t[2], t[3]), pk2(t[4], t[5]), pk2(t[6], t[7])}; a[mt][ks] = __builtin_bit_cast(bf16x8, w); }
#pragma unroll 2
        for (int nt = 0; nt < 16; ++nt) { const int g = g0 + (16 * nt + nl) * gstep;
            const bf16_t* pr = PRB + ((size_t)(g - NPTOK) * 2 + dir) * RW + h * 64 + 8 * q;
            const bf16x8 b0 = *(const bf16x8*)pr, b1 = *(const bf16x8*)(pr + 32);
            bf16_t* yp = Y + (size_t)g * ypitch + h * 64 + 4 * q;
#pragma unroll
            for (int mt = 0; mt < 4; ++mt) { f32x4 d = (f32x4){0.f, 0.f, 0.f, 0.f};
                d = __builtin_amdgcn_mfma_f32_16x16x32_bf16(a[mt][0], b0, d, 0, 0, 0); d = __builtin_amdgcn_mfma_f32_16x16x32_bf16(a[mt][1], b1, d, 0, 0, 0);
                const u32x2 yq = *(const u32x2*)(yp + 16 * mt);
                *(u32x2*)(yp + 16 * mt) = (u32x2){pk2(bflo(yq[0]) + d[0], bfhi(yq[0]) + d[1]), pk2(bflo(yq[1]) + d[2], bfhi(yq[1]) + d[3])}; } }
    }
}

__device__ __forceinline__ void p10_wkv_finish(Frame& F) {
    const bf16_t* PR = (const bf16_t*)(F.ws + WS_PROJ) + 2048; bf16_t* MIX = (bf16_t*)(F.ws + WS_H);
    const bf16_t* YB = (const bf16_t*)(F.ws + WS_YB); const bf16_t* Gt = (const bf16_t*)(F.ws + WS_G);
    const float* mu = F.in[IN_MU]; const float* rk = F.in[IN_RK]; const float* lnw = F.in[IN_LNW]; const float* lnb = F.in[IN_LNB];
    const int t8 = F.lane >> 3, cg8 = (F.lane & 7) * 8;
    for (int gb = (blockIdx.x * 8 + F.wave) * 8; gb < NTOK; gb += F.G * 64) {
        const int g = gb + t8; const bool sample = g >= NPTOK; const NbrOff no = nbr_offsets(g);
        const bf16_t* pg = PR + (size_t)g * INWP;
#pragma unroll 2
        for (int h = 0; h < NH; ++h) { const int ch8 = h * 64 + cg8;
            const int ofr = nbr_pick(no, nbr_kind(sample, ch8)), ofk = nbr_pick(no, nbr_kind(sample, 1024 + ch8)), ofv = nbr_pick(no, nbr_kind(sample, 2048 + ch8));
            const u32x4 ro = *(const u32x4*)(pg + ch8), rn = *(const u32x4*)(pg + (ptrdiff_t)ofr * INWP + ch8);
            const u32x4 ko = *(const u32x4*)(pg + 1024 + ch8), kn = *(const u32x4*)(pg + (ptrdiff_t)ofk * INWP + 1024 + ch8);
            const u32x4 vo = *(const u32x4*)(pg + 2048 + ch8), vn = *(const u32x4*)(pg + (ptrdiff_t)ofv * INWP + 2048 + ch8);
            const u32x4 yfw = *(const u32x4*)(MIX + (size_t)g * D + 1024 + ch8), ybw = *(const u32x4*)(YB + (size_t)g * RW + ch8), gw = *(const u32x4*)(Gt + (size_t)g * RW + ch8);
            float a[8], b[8], m[8], r[8], k[8], y[8];
            unpack8(ro, a); unpack8(rn, b); ld8(mu + ch8, m);
            const float fr_ = ofr ? 1.f : 0.f, fk_ = ofk ? 1.f : 0.f, fv_ = ofv ? 1.f : 0.f;
#pragma unroll
            for (int i = 0; i < 8; ++i) r[i] = a[i] + m[i] * (b[i] * fr_ - a[i]);
            unpack8(ko, a); unpack8(kn, b); ld8(mu + 1024 + ch8, m);
#pragma unroll
            for (int i = 0; i < 8; ++i) k[i] = a[i] + m[i] * (b[i] * fk_ - a[i]);
            ld8(rk + ch8, m); float bon = 0.f;
#pragma unroll
            for (int i = 0; i < 8; ++i) bon += r[i] * k[i] * m[i];
            bon = red8(bon);
            unpack8(vo, a); unpack8(vn, b); ld8(mu + 2048 + ch8, m);
            unpack8(yfw, r); unpack8(ybw, k); float sm = 0.f;
#pragma unroll
            for (int i = 0; i < 8; ++i) { const float v = a[i] + m[i] * (b[i] * fv_ - a[i]); y[i] = r[i] + k[i] + bon * v; sm += y[i]; }
            const float mean = red8(sm) * (1.f / 64.f); float sq = 0.f;
#pragma unroll
            for (int i = 0; i < 8; ++i) { y[i] -= mean; sq += y[i] * y[i]; }
            const float rstd = rsqrtf(red8(sq) * (1.f / 64.f) + 64e-5f);
            ld8(lnw + ch8, a); ld8(lnb + ch8, b); unpack8(gw, m);
#pragma unroll
            for (int i = 0; i < 8; ++i) y[i] = (y[i] * rstd * a[i] + b[i]) * m[i];
            *(u32x4*)(MIX + (size_t)g * D + 1024 + ch8) = (u32x4){pk2(y[0], y[1]), pk2(y[2], y[3]), pk2(y[4], y[5]), pk2(y[6], y[7])}; }
    }
    xpose_deferred(F, true, blockIdx.x * 8 + F.wave, F.G * 8, (LAS bf16_t*)(F.lds + F.wave * 8704));
}

__device__ __forceinline__ void p12_rows(Frame& F) {
    const float* MOD = (const float*)(F.ws + WS_MOD); const bf16_t* OUTB = (const bf16_t*)(F.ws + WS_PROJ); bf16_t* H2 = (bf16_t*)(F.ws + WS_H);
    const float* gpost = F.in[IN_NMPOST]; const float* gpre = F.in[IN_NFPRE];
    for (int row = blockIdx.x * 8 + F.wave; row < NTOK; row += F.G * 8) {
        const float* xr = row < NPTOK ? F.in[IN_XP] + (size_t)row * D : F.in[IN_XS] + (size_t)(row - NPTOK) * D;
        const float* md = MOD + modidx(row) * 12288;
        float4 o[8], x[8]; float ss = 0.f;
#pragma unroll
        for (int i = 0; i < 8; ++i) { const int col = (i * 64 + F.lane) * 4; const u32x2 w = *(const u32x2*)(OUTB + (size_t)row * D + col); x[i] = *(const float4*)(xr + col);
            o[i] = make_float4(bflo(w[0]), bfhi(w[0]), bflo(w[1]), bfhi(w[1])); ss += o[i].x * o[i].x + o[i].y * o[i].y + o[i].z * o[i].z + o[i].w * o[i].w; }
        ss = wave_sum(ss);
        const float rstd = rsqrtf(ss * (1.f / D) + 1e-6f);
        float ss2 = 0.f;
#pragma unroll
        for (int i = 0; i < 8; ++i) { const int col = (i * 64 + F.lane) * 4;
            const float4 gp = *(const float4*)(gpost + col), gm = *(const float4*)(md + 2 * D + col);
            float4 r;
            r.x = x[i].x + gm.x * (o[i].x * rstd * gp.x); r.y = x[i].y + gm.y * (o[i].y * rstd * gp.y);
            r.z = x[i].z + gm.z * (o[i].z * rstd * gp.z); r.w = x[i].w + gm.w * (o[i].w * rstd * gp.w);
            *(float4*)(F.out + (size_t)row * D + col) = r; o[i] = r;
            ss2 += r.x * r.x + r.y * r.y + r.z * r.z + r.w * r.w; }
        ss2 = wave_sum(ss2);
        const float rstd2 = rsqrtf(ss2 * (1.f / D) + 1e-6f);
#pragma unroll
        for (int i = 0; i < 8; ++i) { const int col = (i * 64 + F.lane) * 4;
            const float4 g = *(const float4*)(gpre + col), sc = *(const float4*)(md + 4 * D + col), sh = *(const float4*)(md + 3 * D + col);
            const float h0 = o[i].x * rstd2 * g.x * (1.f + sc.x) + sh.x, h1 = o[i].y * rstd2 * g.y * (1.f + sc.y) + sh.y;
            const float h2 = o[i].z * rstd2 * g.z * (1.f + sc.z) + sh.z, h3 = o[i].w * rstd2 * g.w * (1.f + sc.w) + sh.w;
            *(u32x2*)(H2 + (size_t)row * D + col) = (u32x2){pk2(h0, h1), pk2(h2, h3)}; }
    }
}
__device__ __forceinline__ void p15_rows(Frame& F) {
    const float* MOD = (const float*)(F.ws + WS_MOD); const bf16_t* Fb = (const bf16_t*)(F.ws + WS_H); const float* gpost = F.in[IN_NFPOST];
    for (int row = blockIdx.x * 8 + F.wave; row < NTOK; row += F.G * 8) {
        const float* md = MOD + modidx(row) * 12288;
        float4 o[8], x[8]; float ss = 0.f;
#pragma unroll
        for (int i = 0; i < 8; ++i) { const int col = (i * 64 + F.lane) * 4; const u32x2 w = *(const u32x2*)(Fb + (size_t)row * D + col); x[i] = *(const float4*)(F.out + (size_t)row * D + col);
            o[i] = make_float4(bflo(w[0]), bfhi(w[0]), bflo(w[1]), bfhi(w[1])); ss += o[i].x * o[i].x + o[i].y * o[i].y + o[i].z * o[i].z + o[i].w * o[i].w; }
        ss = wave_sum(ss);
        const float rstd = rsqrtf(ss * (1.f / D) + 1e-6f);
#pragma unroll
        for (int i = 0; i < 8; ++i) { const int col = (i * 64 + F.lane) * 4;
            const float4 gp = *(const float4*)(gpost + col), gf = *(const float4*)(md + 5 * D + col);
            float4 r;
            r.x = x[i].x + gf.x * (o[i].x * rstd * gp.x); r.y = x[i].y + gf.y * (o[i].y * rstd * gp.y);
            r.z = x[i].z + gf.z * (o[i].z * rstd * gp.z); r.w = x[i].w + gf.w * (o[i].w * rstd * gp.w);
            *(float4*)(F.out + (size_t)row * D + col) = r; }
    }
}

constexpr int LDS_MISC = 131072, LDS_BYTES = 131072 + 256;
__global__ void __launch_bounds__(512, 2) fwd_kernel(Args args) {
    extern __shared__ __attribute__((aligned(16))) unsigned char lds_raw[];
    Frame F;
    F.lds = (LAS unsigned char*)lds_raw;
    F.tid = threadIdx.x; F.lane = F.tid & 63; F.wave = __builtin_amdgcn_readfirstlane(F.tid >> 6); F.G = gridDim.x;
    F.in = args.in; F.out = args.out; F.ws = args.ws;
    volatile LAS unsigned* MISC = (volatile LAS unsigned*)(F.lds + LDS_MISC);
    const int lo = args.ph_lo, hi = args.ph_hi;
    const bool fused = (hi - lo) > 1;
    if (F.tid < 64) MISC[F.tid] = 0u;
    __syncthreads();
    XcdBarrier bar; bar.bar = (unsigned*)(F.ws + WS_CTL); bar.x = 0; bar.st = MISC;
    if (fused) bar = xcd_barrier_post((unsigned*)(F.ws + WS_CTL), MISC);
#ifndef PH_MASK
#define PH_MASK 0xFFFF
#endif
#define IN(k) (((PH_MASK >> (k)) & 1) && lo <= (k) && (k) < hi)
#define SEAM(k) do { if (IN(k) && IN((k) + 1)) { if (MK_CG_FIRST && (k) == 8) { cg::this_grid().sync(); } else xcd_barrier(bar); } } while (0)
    unsigned char* ws = F.ws;
#ifndef REP_MASK
#define REP_MASK 0
#endif
#define NREP(k) ((((REP_MASK) >> (k)) & 1) ? 2 : 1)
#define FRESH() asm volatile("" : "+v"(F.tid), "+v"(F.lane))
#define RUN(k, ...) do { if (IN(k)) { for (int _rep = 0; _rep < NREP(k); ++_rep) { if (_rep) xcd_barrier(bar); FRESH(); __VA_ARGS__; } } } while (0)
    RUN(0, p0_prologue(F));
    SEAM(0);
    RUN(1, p1_normmod(F));
    SEAM(1);
    RUN(2, { pg8::Gemm g{(const bf16_t*)(ws + WS_H), (const bf16_t*)(ws + WS_WTIN), D, D, D, 0}; pg8::StaticOrder S; S.init(NTOK, INWP, F.G, blockIdx.x);
        pg8::EpiBf16 E{(bf16_t*)(ws + WS_PROJ), INWP}; pg8::gemm_phase(F.lds, g, S, E); });
    SEAM(2);
    RUN(3, p3_elem(F));
    SEAM(3);
    RUN(4, { pg8::Gemm g{(const bf16_t*)(ws + WS_XC), (const bf16_t*)(ws + WS_BTLRU), LRUW, 256, 256, 1}; pg8::StaticOrder S; S.init(NTOK, 4096, F.G, blockIdx.x);
        pg8::EpiLru E{(unsigned*)F.out, (const bf16_t*)(ws + WS_XC), F.in[IN_BR], F.in[IN_BI], (const float*)(ws + WS_NL8)}; pg8::gemm_phase(F.lds, g, S, E); });
    SEAM(4);
    RUN(5, p5_lru_scan(F));
    SEAM(5);
    RUN(6, { pg8::Gemm g{(const bf16_t*)(ws + WS_LA), (const bf16_t*)(ws + WS_BTLORA), LAK, 256, 256, 2}; pg8::StaticOrder S; S.init(NTOK, 5120, F.G, blockIdx.x);
        pg8::EpiLora E{(bf16_t*)F.out, (bf16_t*)F.out + (size_t)NTOK * 2 * RW, (bf16_t*)(ws + WS_G), F.in[IN_W0], F.in[IN_A0]}; pg8::gemm_phase(F.lds, g, S, E); });
    SEAM(6);
    for (int _r78 = 0; _r78 < NREP(7); ++_r78) {
        if (_r78) xcd_barrier(bar);
        if (IN(7)) { FRESH(); p7_wkv_pass1(F); }
        SEAM(7);
        if (IN(8)) { FRESH(); p8_wkv_combine(F); }
    }
    SEAM(8);
    RUN(9, p9_wkv_pass3(F));
    SEAM(9);
    if (IN(10)) { FRESH(); p10_wkv_finish(F); }
    SEAM(10);
    RUN(11, { pg8::Gemm g{(const bf16_t*)(ws + WS_H), (const bf16_t*)(ws + WS_WTOUT), D, D, D, 0}; pg8::StaticOrder S; S.init(NTOK, D, F.G, blockIdx.x);
        pg8::EpiBf16 E{(bf16_t*)(ws + WS_PROJ), D}; pg8::gemm_phase(F.lds, g, S, E); });
    SEAM(11);
    RUN(12, p12_rows(F));
    SEAM(12);
    RUN(13, { pg8::Gemm g{(const bf16_t*)(ws + WS_H), (const bf16_t*)(ws + WS_WTGU), D, D, D, 0}; pg8::StaticOrder S; S.init(NTOK, 2 * FFH, F.G, blockIdx.x);
        pg8::EpiGu E{(bf16_t*)(ws + WS_PROJ)}; pg8::gemm_phase(F.lds, g, S, E); });
    SEAM(13);
    RUN(14, { pg8::Gemm g{(const bf16_t*)(ws + WS_PROJ), (const bf16_t*)(ws + WS_WTDN), FFH, FFH, FFH, 0}; pg8::StaticOrder S; S.init(NTOK, D, F.G, blockIdx.x);
        pg8::EpiBf16 E{(bf16_t*)(ws + WS_H), D}; pg8::gemm_phase(F.lds, g, S, E); });
    SEAM(14);
    if (IN(15)) { FRESH(); p15_rows(F); }
#undef IN
#undef SEAM
}

extern "C" void kernel_launch(void* const* d_in, const int* in_sizes, int n_in, void* d_out, int out_size, void* d_ws, size_t ws_size, hipStream_t stream) {
    static int grid = 0;
    if (grid == 0) {
        if (n_in != 34 || ws_size < WS_END) { fprintf(stderr, "kernel_launch: need 34 inputs and >= %zu bytes of workspace; got %d, %zu\n", (size_t)WS_END, n_in, ws_size); grid = -1; return; }
        int dev = 0, cus = 0, per_cu = 0;
        if (hipGetDevice(&dev) != hipSuccess || hipDeviceGetAttribute(&cus, hipDeviceAttributeMultiprocessorCount, dev) != hipSuccess) { grid = -1; return; }
        if (hipFuncSetAttribute((const void*)fwd_kernel, hipFuncAttributeMaxDynamicSharedMemorySize, LDS_BYTES) != hipSuccess) { fprintf(stderr, "kernel_launch: hipFuncSetAttribute failed\n"); grid = -1; return; }
        if (hipOccupancyMaxActiveBlocksPerMultiprocessor(&per_cu, (const void*)fwd_kernel, 512, LDS_BYTES) != hipSuccess || per_cu < 1) { fprintf(stderr, "kernel_launch: occupancy query says %d\n", per_cu); per_cu = 1; }
        (void)hipGetLastError();
        grid = cus;
    }
    if (grid < 0) return;
    (void)hipMemsetAsync((char*)d_ws + WS_CTL, 0, 64 * 1024, stream);
    Args a{};
    for (int i = 0; i < 34; ++i) a.in[i] = (const float*)d_in[i];
    a.out = (float*)d_out; a.ws = (unsigned char*)d_ws;
#if MK_ONE_LAUNCH
    a.ph_lo = 0; a.ph_hi = NPHASE;
    void* kargs[] = {&a};
    hipError_t e = hipLaunchCooperativeKernel((const void*)fwd_kernel, dim3(grid), dim3(512), kargs, LDS_BYTES, stream);
    if (e != hipSuccess) fprintf(stderr, "cooperative launch failed: %s (grid %d)\n", hipGetErrorString(e), grid);
#else
    for (int p = 0; p < NPHASE; ++p) { a.ph_lo = p; a.ph_hi = p + 1; hipLaunchKernelGGL(fwd_kernel, dim3(grid), dim3(512), LDS_BYTES, stream, a); }
#endif
}
```

```cpp
#include <hip/hip_runtime.h>
#include <hip/hip_cooperative_groups.h>
#include <cstdio>
namespace cg = cooperative_groups;

#ifndef MK_ONE_LAUNCH
#define MK_ONE_LAUNCH 1
#endif
#ifndef MK_CG_FIRST
#define MK_CG_FIRST 1
#endif

#define LAS __attribute__((address_space(3)))
typedef unsigned short bf16_t;
typedef short bf16x8 __attribute__((ext_vector_type(8)));
typedef float f32x4 __attribute__((ext_vector_type(4)));
typedef unsigned u32x4 __attribute__((ext_vector_type(4)));
typedef unsigned u32x2 __attribute__((ext_vector_type(2)));

constexpr int D = 2048, NTOK = 16384, NPTOK = 8192, PSEQ = 256, SSEQ = 4096;
constexpr int LRUW = 1024, RW = 1024, NH = 16, RIN = 3360, INW = 5408, INWP = 5632, FFH = 5632;
constexpr int LAK = 384;
constexpr int NPHASE = 16;

constexpr size_t MiB = 1024 * 1024;
constexpr size_t WS_CTL = 0;
constexpr size_t WS_MOD = 64 * 1024;
constexpr size_t WS_NL8 = 256 * 1024;
constexpr size_t WS_BTLRU = 1 * MiB;
constexpr size_t WS_BTLORA = 3 * MiB;
constexpr size_t WS_WTOUT = 7 * MiB;
constexpr size_t WS_WTGU = 15 * MiB;
constexpr size_t WS_WTDN = 59 * MiB;
constexpr size_t WS_H = 81 * MiB;
constexpr size_t WS_PROJ = 145 * MiB;
constexpr size_t WS_S = 321 * MiB;
constexpr size_t WS_WTIN = WS_S;
constexpr size_t WS_XC = WS_S;
constexpr size_t WS_G = WS_S;
constexpr size_t WS_LA = WS_S + 32 * MiB;
constexpr size_t WS_YB = WS_S + 32 * MiB;
constexpr size_t WS_PQ = WS_S + 64 * MiB;
constexpr size_t WS_END = WS_S + 96 * MiB;
constexpr size_t WS_PRB = WS_WTOUT;

__device__ __forceinline__ float bf2f(unsigned b) { return __uint_as_float(b << 16); }
__device__ __forceinline__ float bflo(unsigned w) { return __uint_as_float(w << 16); }
__device__ __forceinline__ float bfhi(unsigned w) { return __uint_as_float(w & 0xffff0000u); }
__device__ __forceinline__ unsigned pk2(float lo, float hi) { unsigned r; asm("v_cvt_pk_bf16_f32 %0, %1, %2" : "=v"(r) : "v"(lo), "v"(hi)); return r; }
__device__ __forceinline__ unsigned f2bf(float f) { return pk2(f, 0.f) & 0xffffu; }
__device__ __forceinline__ void unpack8(const u32x4 w, float (&o)[8]) { o[0] = bflo(w[0]); o[1] = bfhi(w[0]); o[2] = bflo(w[1]); o[3] = bfhi(w[1]); o[4] = bflo(w[2]); o[5] = bfhi(w[2]); o[6] = bflo(w[3]); o[7] = bfhi(w[3]); }
__device__ __forceinline__ void lds_st8(LAS float* p, const float (&v)[8]) { *(LAS f32x4*)p = (f32x4){v[0], v[1], v[2], v[3]}; *(LAS f32x4*)(p + 4) = (f32x4){v[4], v[5], v[6], v[7]}; }
__device__ __forceinline__ void ld8(const float* p, float (&v)[8]) { const float4 a = *(const float4*)p, b = *(const float4*)(p + 4); v[0] = a.x; v[1] = a.y; v[2] = a.z; v[3] = a.w; v[4] = b.x; v[5] = b.y; v[6] = b.z; v[7] = b.w; }
__device__ __forceinline__ float sigmoidf_(float x) { return __builtin_amdgcn_rcpf(1.f + __expf(-x)); }
__device__ __forceinline__ float gelu_tanh(float x) { const float u = 0.7978845608028654f * (x + 0.044715f * x * x * x); return 0.5f * x * (1.f + tanhf(u)); }
template <int CTRL> __device__ __forceinline__ float dpp_f(float x) { return __builtin_bit_cast(float, __builtin_amdgcn_update_dpp(0, __builtin_bit_cast(int, x), CTRL, 0xf, 0xf, true)); }
__device__ __forceinline__ float red8(float x) { x += dpp_f<0xB1>(x); x += dpp_f<0x4E>(x); x += dpp_f<0x141>(x); return x; }
__device__ __forceinline__ float wave_sum(float x) { x = red8(x); x += dpp_f<0x140>(x); x += __shfl_xor(x, 16); x += __shfl_xor(x, 32); return x; }

__device__ __forceinline__ float vfma(float a, float b, float c) { float d; asm("v_fma_f32 %0, %1, %2, %3" : "=v"(d) : "v"(a), "v"(b), "v"(c)); return d; }
__device__ __forceinline__ float vadd(float a, float b) { float d; asm("v_add_f32 %0, %1, %2" : "=v"(d) : "v"(a), "v"(b)); return d; }
__device__ __forceinline__ float vmul(float a, float b) { float d; asm("v_mul_f32 %0, %1, %2" : "=v"(d) : "v"(a), "v"(b)); return d; }
__device__ __forceinline__ void red8x8(float (&x)[8]) {
    asm volatile(
        "s_nop 1\n\t"
        "v_add_f32_dpp %0, %0, %0 quad_perm:[1,0,3,2] row_mask:0xf bank_mask:0xf bound_ctrl:1\n\t"
        "v_add_f32_dpp %1, %1, %1 quad_perm:[1,0,3,2] row_mask:0xf bank_mask:0xf bound_ctrl:1\n\t"
        "v_add_f32_dpp %2, %2, %2 quad_perm:[1,0,3,2] row_mask:0xf bank_mask:0xf bound_ctrl:1\n\t"
        "v_add_f32_dpp %3, %3, %3 quad_perm:[1,0,3,2] row_mask:0xf bank_mask:0xf bound_ctrl:1\n\t"
        "v_add_f32_dpp %4, %4, %4 quad_perm:[1,0,3,2] row_mask:0xf bank_mask:0xf bound_ctrl:1\n\t"
        "v_add_f32_dpp %5, %5, %5 quad_perm:[1,0,3,2] row_mask:0xf bank_mask:0xf bound_ctrl:1\n\t"
        "v_add_f32_dpp %6, %6, %6 quad_perm:[1,0,3,2] row_mask:0xf bank_mask:0xf bound_ctrl:1\n\t"
        "v_add_f32_dpp %7, %7, %7 quad_perm:[1,0,3,2] row_mask:0xf bank_mask:0xf bound_ctrl:1\n\t"
        "v_add_f32_dpp %0, %0, %0 quad_perm:[2,3,0,1] row_mask:0xf bank_mask:0xf bound_ctrl:1\n\t"
        "v_add_f32_dpp %1, %1, %1 quad_perm:[2,3,0,1] row_mask:0xf bank_mask:0xf bound_ctrl:1\n\t"
        "v_add_f32_dpp %2, %2, %2 quad_perm:[2,3,0,1] row_mask:0xf bank_mask:0xf bound_ctrl:1\n\t"
        "v_add_f32_dpp %3, %3, %3 quad_perm:[2,3,0,1] row_mask:0xf bank_mask:0xf bound_ctrl:1\n\t"
        "v_add_f32_dpp %4, %4, %4 quad_perm:[2,3,0,1] row_mask:0xf bank_mask:0xf bound_ctrl:1\n\t"
        "v_add_f32_dpp %5, %5, %5 quad_perm:[2,3,0,1] row_mask:0xf bank_mask:0xf bound_ctrl:1\n\t"
        "v_add_f32_dpp %6, %6, %6 quad_perm:[2,3,0,1] row_mask:0xf bank_mask:0xf bound_ctrl:1\n\t"
        "v_add_f32_dpp %7, %7, %7 quad_perm:[2,3,0,1] row_mask:0xf bank_mask:0xf bound_ctrl:1\n\t"
        "v_add_f32_dpp %0, %0, %0 row_half_mirror row_mask:0xf bank_mask:0xf bound_ctrl:1\n\t"
        "v_add_f32_dpp %1, %1, %1 row_half_mirror row_mask:0xf bank_mask:0xf bound_ctrl:1\n\t"
        "v_add_f32_dpp %2, %2, %2 row_half_mirror row_mask:0xf bank_mask:0xf bound_ctrl:1\n\t"
        "v_add_f32_dpp %3, %3, %3 row_half_mirror row_mask:0xf bank_mask:0xf bound_ctrl:1\n\t"
        "v_add_f32_dpp %4, %4, %4 row_half_mirror row_mask:0xf bank_mask:0xf bound_ctrl:1\n\t"
        "v_add_f32_dpp %5, %5, %5 row_half_mirror row_mask:0xf bank_mask:0xf bound_ctrl:1\n\t"
        "v_add_f32_dpp %6, %6, %6 row_half_mirror row_mask:0xf bank_mask:0xf bound_ctrl:1\n\t"
        "v_add_f32_dpp %7, %7, %7 row_half_mirror row_mask:0xf bank_mask:0xf bound_ctrl:1\n\t"
        "s_nop 1"
        : "+v"(x[0]), "+v"(x[1]), "+v"(x[2]), "+v"(x[3]), "+v"(x[4]), "+v"(x[5]), "+v"(x[6]), "+v"(x[7]));
}

#define A8(op) op " %0, %8, %16\n\t" op " %1, %9, %16\n\t" op " %2, %10, %16\n\t" op " %3, %11, %16\n\t" op " %4, %12, %16\n\t" op " %5, %13, %16\n\t" op " %6, %14, %16\n\t" op " %7, %15, %16"
__device__ __forceinline__ void col_mul8(float (&acc)[8], float s0, float s1, float s2, float s3, float s4, float s5, float s6, float s7, float k) {
    asm(A8("v_mul_f32") : "=&v"(acc[0]), "=&v"(acc[1]), "=&v"(acc[2]), "=&v"(acc[3]), "=&v"(acc[4]), "=&v"(acc[5]), "=&v"(acc[6]), "=&v"(acc[7])
        : "v"(s0), "v"(s1), "v"(s2), "v"(s3), "v"(s4), "v"(s5), "v"(s6), "v"(s7), "v"(k));
}
__device__ __forceinline__ void col_mac8(float (&acc)[8], float s0, float s1, float s2, float s3, float s4, float s5, float s6, float s7, float k) {
    asm(A8("v_fmac_f32") : "+v"(acc[0]), "+v"(acc[1]), "+v"(acc[2]), "+v"(acc[3]), "+v"(acc[4]), "+v"(acc[5]), "+v"(acc[6]), "+v"(acc[7])
        : "v"(s0), "v"(s1), "v"(s2), "v"(s3), "v"(s4), "v"(s5), "v"(s6), "v"(s7), "v"(k));
}
#undef A8
template <bool HASV>
__device__ __forceinline__ void col_upd8(float& s0, float& s1, float& s2, float& s3, float& s4, float& s5, float& s6, float& s7, const float (&sa)[8], const float (&v)[8], float w, float kka, float kd) {
    if (HASV)
        asm("v_mul_f32 %0, %0, %24\n\tv_mul_f32 %1, %1, %24\n\tv_mul_f32 %2, %2, %24\n\tv_mul_f32 %3, %3, %24\n\tv_mul_f32 %4, %4, %24\n\tv_mul_f32 %5, %5, %24\n\tv_mul_f32 %6, %6, %24\n\tv_mul_f32 %7, %7, %24\n\t"
            "v_fmac_f32 %0, %8, %25\n\tv_fmac_f32 %1, %9, %25\n\tv_fmac_f32 %2, %10, %25\n\tv_fmac_f32 %3, %11, %25\n\tv_fmac_f32 %4, %12, %25\n\tv_fmac_f32 %5, %13, %25\n\tv_fmac_f32 %6, %14, %25\n\tv_fmac_f32 %7, %15, %25\n\t"
            "v_fmac_f32 %0, %16, %26\n\tv_fmac_f32 %1, %17, %26\n\tv_fmac_f32 %2, %18, %26\n\tv_fmac_f32 %3, %19, %26\n\tv_fmac_f32 %4, %20, %26\n\tv_fmac_f32 %5, %21, %26\n\tv_fmac_f32 %6, %22, %26\n\tv_fmac_f32 %7, %23, %26"
            : "+v"(s0), "+v"(s1), "+v"(s2), "+v"(s3), "+v"(s4), "+v"(s5), "+v"(s6), "+v"(s7)
            : "v"(sa[0]), "v"(sa[1]), "v"(sa[2]), "v"(sa[3]), "v"(sa[4]), "v"(sa[5]), "v"(sa[6]), "v"(sa[7]),
              "v"(v[0]), "v"(v[1]), "v"(v[2]), "v"(v[3]), "v"(v[4]), "v"(v[5]), "v"(v[6]), "v"(v[7]), "v"(w), "v"(kka), "v"(kd));
    else
        asm("v_mul_f32 %0, %0, %16\n\tv_mul_f32 %1, %1, %16\n\tv_mul_f32 %2, %2, %16\n\tv_mul_f32 %3, %3, %16\n\tv_mul_f32 %4, %4, %16\n\tv_mul_f32 %5, %5, %16\n\tv_mul_f32 %6, %6, %16\n\tv_mul_f32 %7, %7, %16\n\t"
            "v_fmac_f32 %0, %8, %17\n\tv_fmac_f32 %1, %9, %17\n\tv_fmac_f32 %2, %10, %17\n\tv_fmac_f32 %3, %11, %17\n\tv_fmac_f32 %4, %12, %17\n\tv_fmac_f32 %5, %13, %17\n\tv_fmac_f32 %6, %14, %17\n\tv_fmac_f32 %7, %15, %17"
            : "+v"(s0), "+v"(s1), "+v"(s2), "+v"(s3), "+v"(s4), "+v"(s5), "+v"(s6), "+v"(s7)
            : "v"(sa[0]), "v"(sa[1]), "v"(sa[2]), "v"(sa[3]), "v"(sa[4]), "v"(sa[5]), "v"(sa[6]), "v"(sa[7]), "v"(w), "v"(kka));
}

typedef float f32x2 __attribute__((ext_vector_type(2)));
#define PK8(op, tail) op " %0, %8, %16" tail "\n\t" op " %1, %9, %16" tail "\n\t" op " %2, %10, %16" tail "\n\t" op " %3, %11, %16" tail "\n\t" op " %4, %12, %16" tail "\n\t" op " %5, %13, %16" tail "\n\t" op " %6, %14, %16" tail "\n\t" op " %7, %15, %16" tail
__device__ __forceinline__ void pk_mul8(f32x2 (&acc)[8], f32x2 s0, f32x2 s1, f32x2 s2, f32x2 s3, f32x2 s4, f32x2 s5, f32x2 s6, f32x2 s7, f32x2 k) {
    asm(PK8("v_pk_mul_f32", "") : "=&v"(acc[0]), "=&v"(acc[1]), "=&v"(acc[2]), "=&v"(acc[3]), "=&v"(acc[4]), "=&v"(acc[5]), "=&v"(acc[6]), "=&v"(acc[7])
        : "v"(s0), "v"(s1), "v"(s2), "v"(s3), "v"(s4), "v"(s5), "v"(s6), "v"(s7), "v"(k));
}
__device__ __forceinline__ void pk_mac8(f32x2 (&acc)[8], f32x2 s0, f32x2 s1, f32x2 s2, f32x2 s3, f32x2 s4, f32x2 s5, f32x2 s6, f32x2 s7, f32x2 k) {
    asm("v_pk_fma_f32 %0, %8, %16, %0\n\tv_pk_fma_f32 %1, %9, %16, %1\n\tv_pk_fma_f32 %2, %10, %16, %2\n\tv_pk_fma_f32 %3, %11, %16, %3\n\t"
        "v_pk_fma_f32 %4, %12, %16, %4\n\tv_pk_fma_f32 %5, %13, %16, %5\n\tv_pk_fma_f32 %6, %14, %16, %6\n\tv_pk_fma_f32 %7, %15, %16, %7"
        : "+v"(acc[0]), "+v"(acc[1]), "+v"(acc[2]), "+v"(acc[3]), "+v"(acc[4]), "+v"(acc[5]), "+v"(acc[6]), "+v"(acc[7])
        : "v"(s0), "v"(s1), "v"(s2), "v"(s3), "v"(s4), "v"(s5), "v"(s6), "v"(s7), "v"(k));
}
#undef PK8
#define BLO " op_sel:[0,0,0] op_sel_hi:[0,1,1]"
#define BHI " op_sel:[1,0,0] op_sel_hi:[1,1,1]"
template <bool HASV>
__device__ __forceinline__ void pk_upd8(f32x2& s0, f32x2& s1, f32x2& s2, f32x2& s3, f32x2& s4, f32x2& s5, f32x2& s6, f32x2& s7, const f32x2 (&sap)[4], const f32x2 (&vp)[4], f32x2 w, f32x2 kka, f32x2 kd) {
    if (HASV)
        asm("v_pk_mul_f32 %0, %0, %16\n\tv_pk_mul_f32 %1, %1, %16\n\tv_pk_mul_f32 %2, %2, %16\n\tv_pk_mul_f32 %3, %3, %16\n\tv_pk_mul_f32 %4, %4, %16\n\tv_pk_mul_f32 %5, %5, %16\n\tv_pk_mul_f32 %6, %6, %16\n\tv_pk_mul_f32 %7, %7, %16\n\t"
            "v_pk_fma_f32 %0, %8, %17, %0" BLO "\n\tv_pk_fma_f32 %1, %8, %17, %1" BHI "\n\tv_pk_fma_f32 %2, %9, %17, %2" BLO "\n\tv_pk_fma_f32 %3, %9, %17, %3" BHI "\n\t"
            "v_pk_fma_f32 %4, %10, %17, %4" BLO "\n\tv_pk_fma_f32 %5, %10, %17, %5" BHI "\n\tv_pk_fma_f32 %6, %11, %17, %6" BLO "\n\tv_pk_fma_f32 %7, %11, %17, %7" BHI "\n\t"
            "v_pk_fma_f32 %0, %12, %18, %0" BLO "\n\tv_pk_fma_f32 %1, %12, %18, %1" BHI "\n\tv_pk_fma_f32 %2, %13, %18, %2" BLO "\n\tv_pk_fma_f32 %3, %13, %18, %3" BHI "\n\t"
            "v_pk_fma_f32 %4, %14, %18, %4" BLO "\n\tv_pk_fma_f32 %5, %14, %18, %5" BHI "\n\tv_pk_fma_f32 %6, %15, %18, %6" BLO "\n\tv_pk_fma_f32 %7, %15, %18, %7" BHI
            : "+v"(s0), "+v"(s1), "+v"(s2), "+v"(s3), "+v"(s4), "+v"(s5), "+v"(s6), "+v"(s7)
            : "v"(sap[0]), "v"(sap[1]), "v"(sap[2]), "v"(sap[3]), "v"(vp[0]), "v"(vp[1]), "v"(vp[2]), "v"(vp[3]), "v"(w), "v"(kka), "v"(kd));
    else
        asm("v_pk_mul_f32 %0, %0, %12\n\tv_pk_mul_f32 %1, %1, %12\n\tv_pk_mul_f32 %2, %2, %12\n\tv_pk_mul_f32 %3, %3, %12\n\tv_pk_mul_f32 %4, %4, %12\n\tv_pk_mul_f32 %5, %5, %12\n\tv_pk_mul_f32 %6, %6, %12\n\tv_pk_mul_f32 %7, %7, %12\n\t"
            "v_pk_fma_f32 %0, %8, %13, %0" BLO "\n\tv_pk_fma_f32 %1, %8, %13, %1" BHI "\n\tv_pk_fma_f32 %2, %9, %13, %2" BLO "\n\tv_pk_fma_f32 %3, %9, %13, %3" BHI "\n\t"
            "v_pk_fma_f32 %4, %10, %13, %4" BLO "\n\tv_pk_fma_f32 %5, %10, %13, %5" BHI "\n\tv_pk_fma_f32 %6, %11, %13, %6" BLO "\n\tv_pk_fma_f32 %7, %11, %13, %7" BHI
            : "+v"(s0), "+v"(s1), "+v"(s2), "+v"(s3), "+v"(s4), "+v"(s5), "+v"(s6), "+v"(s7)
            : "v"(sap[0]), "v"(sap[1]), "v"(sap[2]), "v"(sap[3]), "v"(w), "v"(kka));
}
#undef BLO
#undef BHI
__device__ __forceinline__ int modidx(int row) { return row < NPTOK ? 0 : 1 + ((row - NPTOK) >> 12); }

#define XB_TMO      128
#define XB_XCNT(j)  (256  + 64 * (j))
#define XB_XSUB(j)  (1280 + 64 * (j))
#define XB_XGEN(j)  (2304 + 64 * (j))
#define XB_TOP      3328
#define XB_TOPGEN   3392
#define XCD_BAR_WORDS 3456
#define XB_SPIN_CAP (1u << 22)
__device__ __forceinline__ unsigned xb_ld(unsigned* p)              { return __hip_atomic_load(p, __ATOMIC_RELAXED, __HIP_MEMORY_SCOPE_AGENT); }
__device__ __forceinline__ unsigned xb_add(unsigned* p, unsigned v) { return __hip_atomic_fetch_add(p, v, __ATOMIC_RELAXED, __HIP_MEMORY_SCOPE_AGENT); }
__device__ __forceinline__ unsigned xb_xcc_id() { return (unsigned)__builtin_amdgcn_s_getreg((3 << 11) | 20) & 0xFu; }
#define XB_SPIN(cond, bar) do { unsigned _sp = 0; while (cond) { __builtin_amdgcn_s_sleep(1); \
    if ((++_sp & 255u) == 0u) { if (xb_ld(&(bar)[XB_TMO])) break; if (_sp > XB_SPIN_CAP) { atomicAdd(&(bar)[XB_TMO], 1u); break; } } } } while (0)
struct XcdBarrier { unsigned* bar; unsigned x; volatile LAS unsigned* st; };
__device__ __forceinline__ XcdBarrier xcd_barrier_post(unsigned* bar, volatile LAS unsigned* st) {
    XcdBarrier b; b.bar = bar; b.x = xb_xcc_id(); b.st = st;
    if (threadIdx.x == 0) (void)xb_add(&bar[XB_XCNT(b.x)], 1u);
    return b;
}
__device__ __forceinline__ void xcd_barrier_complete(unsigned* bar, unsigned x, unsigned& nloc, unsigned& nx) {
    const unsigned G = gridDim.x * gridDim.y * gridDim.z;
    unsigned sum, cnt, mine, sp = 0u;
    for (;;) {
        sum = 0u; cnt = 0u; mine = 0u;
#pragma unroll
        for (unsigned j = 0; j < 16; ++j) { const unsigned c = xb_ld(&bar[XB_XCNT(j)]); sum += c; cnt += (c > 0u) ? 1u : 0u; mine = (j == x) ? c : mine; }
        if (sum == G) break;
        __builtin_amdgcn_s_sleep(1);
        if ((++sp & 255u) == 0u) { if (xb_ld(&bar[XB_TMO])) break; if (sp > XB_SPIN_CAP) { atomicAdd(&bar[XB_TMO], 1u); break; } }
    }
    nloc = mine > 0u ? mine : 1u; nx = cnt > 0u ? cnt : 1u;
}
__device__ __forceinline__ void xcd_barrier(const XcdBarrier& b) {
    asm volatile("s_waitcnt vmcnt(0)" ::: "memory");
    __syncthreads();
    if (threadIdx.x == 0) {
        unsigned* bar = b.bar;
        __builtin_amdgcn_s_waitcnt(0);
        unsigned nloc = b.st[0], nx = b.st[1];
        if (nloc == 0u) { xcd_barrier_complete(bar, b.x, nloc, nx); b.st[0] = nloc; b.st[1] = nx; }
        const unsigned old = xb_add(&bar[XB_XSUB(b.x)], 1u);
        const unsigned gen = old / nloc;
        if (old + 1u == (gen + 1u) * nloc) {
            __builtin_amdgcn_fence(__ATOMIC_RELEASE, "agent");
            asm volatile("s_waitcnt vmcnt(0)" ::: "memory");
            const unsigned og = xb_add(&bar[XB_TOP], 1u);
            const unsigned tg = og / nx;
            if (og + 1u == (tg + 1u) * nx) xb_add(&bar[XB_TOPGEN], 1u);
            else XB_SPIN(xb_ld(&bar[XB_TOPGEN]) == tg, bar);
            __builtin_amdgcn_fence(__ATOMIC_ACQUIRE, "agent");
            xb_add(&bar[XB_XGEN(b.x)], 1u);
            asm volatile("s_waitcnt vmcnt(0)" ::: "memory");
        } else {
            XB_SPIN(xb_ld(&bar[XB_XGEN(b.x)]) == gen, bar);
            __builtin_amdgcn_fence(__ATOMIC_ACQUIRE, "agent");
            asm volatile("s_waitcnt vmcnt(0)" ::: "memory");
        }
    }
    __syncthreads();
}

struct Args { const float* in[34]; float* out; unsigned char* ws; int ph_lo, ph_hi; };
struct Frame {
    LAS unsigned char* lds;
    int tid, lane, wave, G;
    const float* const* in;
    float* out; unsigned char* ws;
};
#define IN_XP 0
#define IN_XS 1
#define IN_SLRU 2
#define IN_SWKV 3
#define IN_C 4
#define IN_CCTX 5
#define IN_NMPRE 6
#define IN_NMPOST 7
#define IN_NFPRE 8
#define IN_NFPOST 9
#define IN_WMOD 10
#define IN_BMOD 11
#define IN_WIN 12
#define IN_CONVW 13
#define IN_CONVB 14
#define IN_WR 15
#define IN_BR 16
#define IN_WI 17
#define IN_BI 18
#define IN_LAM 19
#define IN_MU 20
#define IN_W0 21
#define IN_WUP 22
#define IN_A0 23
#define IN_AUP 24
#define IN_GUP 25
#define IN_KK 26
#define IN_KA 27
#define IN_RK 28
#define IN_LNW 29
#define IN_LNB 30
#define IN_WOUT 31
#define IN_WGU 32
#define IN_WDN 33

namespace pg8 {
constexpr int BM = 256, BK = 64, HALF = 128, HTB = HALF * BK * 2, STAGE_BYTES = 8 * HTB, NXCD = 8, WGM = 8;
__host__ __device__ __forceinline__ int lds_byte(int r, int c) { const int st = (r >> 4) * 2 + (c >> 5), rr = r & 15, cc = c & 31, ob = rr * 64 + cc * 2; return st * 1024 + (ob ^ (((ob >> 9) & 1) << 5)); }
__host__ __device__ __forceinline__ void stage_rc(int b, int& R, int& C) { const int st = b / 1024, sb = b % 1024, swz = sb ^ (((sb >> 9) & 1) << 5); R = (st >> 1) * 16 + swz / 64; C = (st & 1) * 32 + (swz % 64) / 2; }
__host__ __device__ __forceinline__ int perm32(int rho) { const int n = rho >> 4, i = rho & 15; return 8 * (i >> 2) + 4 * n + (i & 3); }
struct Unit { int pm, pn; };
struct Gemm { const bf16_t* A; const bf16_t* Bt; int lda, ldb, K; int lruoff; };
struct StaticOrder {
    int nM, nN, nwg, G, c;
    __device__ void init(int M, int N, int G_, int c_) { nM = M / BM; nN = N / BM; nwg = nM * nN; G = G_; c = c_; }
    __device__ bool next(int i, Unit& u) const {
        const long L = (long)i * G + c; if (L >= nwg) return false;
        int wgid = (int)L; { const int q = nwg / NXCD, r = nwg % NXCD, xcd = wgid % NXCD, off = wgid / NXCD; wgid = (xcd < r ? xcd * (q + 1) : r * (q + 1) + (xcd - r) * q) + off; }
        const int nig = WGM * nN, gid = wgid / nig, fm = gid * WGM, gsz = (nM - fm) < WGM ? (nM - fm) : WGM;
        u.pm = fm + ((wgid % nig) % gsz); u.pn = (wgid % nig) / gsz; return true;
    }
};
__device__ __forceinline__ size_t a_unit_off(const Gemm& g, const Unit& u) {
    size_t o = (size_t)u.pm * BM * g.lda * 2;
    if (g.lruoff == 1) { const int hd = u.pn >> 1; o += (size_t)(hd < 7 ? 128 * hd : 768) * 2; }
    if (g.lruoff == 2) { o += (size_t)(u.pn < 16 ? 0 : 128) * 2; }
    return o;
}

template <class Epi, bool ALIGN_EPI = true, bool SP2 = true>
__device__ __forceinline__ void gemm_phase(LAS unsigned char* lds, const Gemm g, const StaticOrder& S, const Epi& E) {
    const int tid = threadIdx.x, wid = __builtin_amdgcn_readfirstlane(tid >> 6), lane = tid & 63, wr = wid >> 2, wc = wid & 3, fr = lane & 15, fq = lane >> 4;
    const int nt = g.K / BK;
    unsigned voffA[2], voffB[2];
#pragma unroll
    for (int i = 0; i < 2; ++i) { int R, C; stage_rc(tid * 16 + i * 8192, R, C); const int Rb = (R & ~31) + perm32(R & 31);
        voffA[i] = (unsigned)(R * g.lda + C) * 2u; voffB[i] = (unsigned)(Rb * g.ldb + C) * 2u; }
    const size_t kstep = (size_t)(BK * 2);
    const size_t hstepA = (size_t)HALF * g.lda * 2, hstepB = (size_t)HALF * g.ldb * 2;
    const size_t tstepB = 2 * hstepB;
    const unsigned ldsw = (unsigned)wid * 1024u;
    const int aoff = lds_byte(wr * 64 + fr, fq * 8), boff = lds_byte(wc * 32 + fr, fq * 8);
#define PG8_SA(b, h) (((b) * 2 + (h)) * HTB)
#define PG8_SB(b, h) ((4 + (b) * 2 + (h)) * HTB)
#define PG8_STAGE(bufoff, gbase, voff) do { _Pragma("unroll") for (int _i = 0; _i < 2; ++_i) \
        __builtin_amdgcn_global_load_lds((const unsigned*)((const char*)(gbase) + (voff)[_i]), (LAS unsigned*)(lds + (bufoff) + ldsw + _i * 8192), 16, 0, 0); } while (0)
#define PG8_LDA(dst, b, h) do { _Pragma("unroll") for (int m = 0; m < 4; ++m) _Pragma("unroll") for (int k = 0; k < 2; ++k) dst[m][k] = *(const LAS bf16x8*)(lds + PG8_SA(b, h) + aoff + m * 2048 + k * 1024); } while (0)
#define PG8_LDB(dst, b, h) do { _Pragma("unroll") for (int n = 0; n < 2; ++n) _Pragma("unroll") for (int k = 0; k < 2; ++k) dst[n][k] = *(const LAS bf16x8*)(lds + PG8_SB(b, h) + boff + n * 2048 + k * 1024); } while (0)
#define PG8_MMA(ai, bj, At, Bt) do { __builtin_amdgcn_s_setprio(1); _Pragma("unroll") for (int m = 0; m < 4; ++m) _Pragma("unroll") for (int n = 0; n < 2; ++n) _Pragma("unroll") for (int k = 0; k < 2; ++k) \
        acc[ai][bj][m][n] = __builtin_amdgcn_mfma_f32_16x16x32_bf16(Bt[n][k], At[m][k], acc[ai][bj][m][n], 0, 0, 0); __builtin_amdgcn_s_setprio(0); } while (0)
#define PG8_WAIT_V(n) asm volatile("s_waitcnt vmcnt(" #n ")" ::: "memory")
#define PG8_WAIT_L(n) asm volatile("s_waitcnt lgkmcnt(" #n ")" ::: "memory")
#define PG8_BAR __builtin_amdgcn_s_barrier()
#define PG8_SCHED __builtin_amdgcn_sched_barrier(0)
    Unit cur, nxt; int ui = 0;
    if (!S.next(0, cur)) return;
    f32x4 acc[2][2][4][2];
#pragma unroll
    for (int a = 0; a < 2; ++a)
#pragma unroll
        for (int b = 0; b < 2; ++b)
#pragma unroll
            for (int m = 0; m < 4; ++m)
#pragma unroll
                for (int n = 0; n < 2; ++n) acc[a][b][m][n] = (f32x4){0.f, 0.f, 0.f, 0.f};
    bf16x8 At[4][2], B0[2][2], B1[2][2];
    const char* cA = (const char*)g.A + a_unit_off(g, cur); const char* cB = (const char*)g.Bt + (size_t)cur.pn * tstepB;
    if constexpr (SP2) {
        PG8_STAGE(PG8_SB(0, 0), cB, voffB); PG8_STAGE(PG8_SB(0, 1), cB + hstepB, voffB); PG8_STAGE(PG8_SA(0, 0), cA, voffA); PG8_STAGE(PG8_SA(0, 1), cA + hstepA, voffA);
        if (wr == 1) PG8_BAR;
        PG8_WAIT_V(2); PG8_BAR;
        PG8_STAGE(PG8_SB(1, 0), cB + kstep, voffB); PG8_STAGE(PG8_SA(1, 0), cA + kstep, voffA); PG8_STAGE(PG8_SB(1, 1), cB + hstepB + kstep, voffB);
        PG8_WAIT_V(6); PG8_BAR;
    } else {
    PG8_STAGE(PG8_SB(0, 0), cB, voffB); PG8_STAGE(PG8_SA(0, 0), cA, voffA); PG8_STAGE(PG8_SB(0, 1), cB + hstepB, voffB); PG8_STAGE(PG8_SA(0, 1), cA + hstepA, voffA);
    if (wr == 1) PG8_BAR;
    PG8_WAIT_V(4); PG8_BAR;
    PG8_STAGE(PG8_SB(1, 0), cB + kstep, voffB); PG8_STAGE(PG8_SA(1, 0), cA + kstep, voffA); PG8_STAGE(PG8_SB(1, 1), cB + hstepB + kstep, voffB);
    PG8_WAIT_V(6); PG8_BAR;
    }
    for (;;) {
        const bool has_next = S.next(ui + 1, nxt);
        const char* nA = has_next ? (const char*)g.A + a_unit_off(g, nxt) : cA; const char* nB = has_next ? (const char*)g.Bt + (size_t)nxt.pn * tstepB : cB;
#pragma unroll 1
        for (int t = 0; t < nt; t += 2) {
            const bool last = (t == nt - 2);
            const char* a1 = cA + (size_t)(t + 1) * kstep;
            const char* a2 = last ? nA : cA + (size_t)(t + 2) * kstep; const char* b2 = last ? nB : cB + (size_t)(t + 2) * kstep;
            const char* a3 = a2 + kstep; const char* b3 = b2 + kstep;
            if constexpr (SP2) {
            PG8_LDB(B0, 0, 0); PG8_LDB(B1, 0, 1); PG8_SCHED; PG8_LDA(At, 0, 0); PG8_STAGE(PG8_SA(1, 1), a1 + hstepA, voffA);
            PG8_WAIT_V(8); PG8_WAIT_L(0); PG8_BAR; PG8_MMA(0, 0, At, B0); PG8_MMA(0, 1, At, B1); PG8_BAR; PG8_SCHED;
            PG8_LDA(At, 0, 1); PG8_STAGE(PG8_SB(0, 0), b2, voffB); PG8_STAGE(PG8_SB(0, 1), b2 + hstepB, voffB); PG8_STAGE(PG8_SA(0, 0), a2, voffA);
            PG8_WAIT_V(8); PG8_WAIT_L(0); PG8_BAR; PG8_MMA(1, 0, At, B0); PG8_MMA(1, 1, At, B1); PG8_BAR; PG8_SCHED;
            PG8_LDB(B0, 1, 0); PG8_LDB(B1, 1, 1); PG8_SCHED; PG8_LDA(At, 1, 0); PG8_STAGE(PG8_SA(0, 1), a2 + hstepA, voffA);
            PG8_WAIT_V(8); PG8_WAIT_L(0); PG8_BAR; PG8_MMA(0, 0, At, B0); PG8_MMA(0, 1, At, B1); PG8_BAR; PG8_SCHED;
            PG8_LDA(At, 1, 1); PG8_STAGE(PG8_SB(1, 0), b3, voffB); PG8_STAGE(PG8_SB(1, 1), b3 + hstepB, voffB); PG8_STAGE(PG8_SA(1, 0), a3, voffA);
            PG8_WAIT_V(8); PG8_WAIT_L(0); PG8_BAR; PG8_MMA(1, 0, At, B0); PG8_MMA(1, 1, At, B1); PG8_BAR; PG8_SCHED;
            } else {
            PG8_LDB(B0, 0, 0); PG8_SCHED; PG8_LDA(At, 0, 0); PG8_STAGE(PG8_SA(1, 1), a1 + hstepA, voffA);
            PG8_WAIT_L(8); PG8_BAR; PG8_WAIT_L(0); PG8_MMA(0, 0, At, B0); PG8_BAR; PG8_SCHED;
            PG8_LDB(B1, 0, 1); PG8_STAGE(PG8_SB(0, 0), b2, voffB);
            PG8_BAR; PG8_WAIT_L(0); PG8_MMA(0, 1, At, B1); PG8_BAR;
            PG8_LDA(At, 0, 1); PG8_STAGE(PG8_SA(0, 0), a2, voffA);
            PG8_BAR; PG8_WAIT_L(0); PG8_MMA(1, 0, At, B0); PG8_BAR; PG8_SCHED;
            PG8_STAGE(PG8_SB(0, 1), b2 + hstepB, voffB);
            PG8_WAIT_V(6); PG8_BAR; PG8_MMA(1, 1, At, B1); PG8_BAR;
            PG8_LDB(B0, 1, 0); PG8_SCHED; PG8_LDA(At, 1, 0); PG8_STAGE(PG8_SA(0, 1), a2 + hstepA, voffA);
            PG8_WAIT_L(8); PG8_BAR; PG8_WAIT_L(0); PG8_MMA(0, 0, At, B0); PG8_BAR; PG8_SCHED;
            PG8_LDB(B1, 1, 1); PG8_STAGE(PG8_SB(1, 0), b3, voffB);
            PG8_BAR; PG8_WAIT_L(0); PG8_MMA(0, 1, At, B1); PG8_BAR;
            PG8_LDA(At, 1, 1); PG8_STAGE(PG8_SA(1, 0), a3, voffA);
            PG8_BAR; PG8_WAIT_L(0); PG8_MMA(1, 0, At, B0); PG8_BAR; PG8_SCHED;
            PG8_STAGE(PG8_SB(1, 1), b3 + hstepB, voffB);
            PG8_WAIT_V(6); PG8_BAR; PG8_MMA(1, 1, At, B1); PG8_BAR;
                    }
        }
        if constexpr (ALIGN_EPI) { if (wr == 0) PG8_BAR; }
        E(acc, cur, wr, wc, fr, fq);
        if (!has_next) break;
#pragma unroll
        for (int a = 0; a < 2; ++a)
#pragma unroll
            for (int b = 0; b < 2; ++b)
#pragma unroll
                for (int m = 0; m < 4; ++m)
#pragma unroll
                    for (int n = 0; n < 2; ++n) acc[a][b][m][n] = (f32x4){0.f, 0.f, 0.f, 0.f};
        cur = nxt; cA = nA; cB = nB; ++ui;
        if constexpr (ALIGN_EPI) { if (wr == 1) PG8_BAR; }
    }
    PG8_WAIT_V(0);
    if constexpr (!ALIGN_EPI) { if (wr == 0) PG8_BAR; }
    PG8_BAR;
#undef PG8_SA
#undef PG8_SB
#undef PG8_STAGE
#undef PG8_LDA
#undef PG8_LDB
#undef PG8_MMA
#undef PG8_WAIT_V
#undef PG8_WAIT_L
#undef PG8_BAR
#undef PG8_SCHED
}

struct EpiBf16 {
    bf16_t* O; int ldc;
    __device__ __forceinline__ void operator()(const f32x4 (&acc)[2][2][4][2], const Unit& u, int wr, int wc, int fr, int fq) const {
        const int row0 = u.pm * BM + wr * 64 + fr, col0 = u.pn * BM + wc * 32 + 8 * fq;
#pragma unroll
        for (int ai = 0; ai < 2; ++ai)
#pragma unroll
            for (int m = 0; m < 4; ++m) { bf16_t* rowp = O + (size_t)(row0 + ai * HALF + m * 16) * ldc + col0;
#pragma unroll
                for (int bj = 0; bj < 2; ++bj) { const f32x4 v0 = acc[ai][bj][m][0], v1 = acc[ai][bj][m][1];
                    *(u32x4*)(rowp + bj * HALF) = (u32x4){pk2(v0[0], v0[1]), pk2(v0[2], v0[3]), pk2(v1[0], v1[1]), pk2(v1[2], v1[3])}; } }
    }
};
struct EpiGu {
    bf16_t* O;
    __device__ __forceinline__ void operator()(const f32x4 (&acc)[2][2][4][2], const Unit& u, int wr, int wc, int fr, int fq) const {
        const int row0 = u.pm * BM + wr * 64 + fr, col0 = u.pn * HALF + wc * 32 + 8 * fq;
#pragma unroll
        for (int ai = 0; ai < 2; ++ai)
#pragma unroll
            for (int m = 0; m < 4; ++m) { bf16_t* rowp = O + (size_t)(row0 + ai * HALF + m * 16) * FFH + col0;
                float o[8];
#pragma unroll
                for (int n = 0; n < 2; ++n)
#pragma unroll
                    for (int i = 0; i < 4; ++i) { const float gt = acc[ai][0][m][n][i], up = acc[ai][1][m][n][i]; o[n * 4 + i] = gt * sigmoidf_(gt) * up; }
                *(u32x4*)rowp = (u32x4){pk2(o[0], o[1]), pk2(o[2], o[3]), pk2(o[4], o[5]), pk2(o[6], o[7])}; }
    }
};
struct EpiLru {
    unsigned* LAB; const bf16_t* XC; const float* br; const float* bi; const float* nl8;
    __device__ __forceinline__ void operator()(const f32x4 (&acc)[2][2][4][2], const Unit& u, int wr, int wc, int fr, int fq) const {
        const int hd = u.pn >> 1, dir = u.pn & 1;
        const int row0 = u.pm * BM + wr * 64 + fr, ch0 = wc * 32 + 8 * fq, chan0 = hd * 128 + ch0;
        const float* brp = br + (dir * 8 + hd) * 128 + ch0; const float* bip = bi + (dir * 8 + hd) * 128 + ch0; const float* nlp = nl8 + dir * 1024 + chan0;
#pragma unroll
        for (int ai = 0; ai < 2; ++ai)
#pragma unroll
            for (int m = 0; m < 4; ++m) { const int row = row0 + ai * HALF + m * 16;
                const u32x4 xw = *(const u32x4*)(XC + (size_t)row * LRUW + chan0);
                unsigned* dst = LAB + ((size_t)row * 2 + dir) * LRUW + chan0;
#pragma unroll
                for (int n = 0; n < 2; ++n) { const f32x4 brv = *(const f32x4*)(brp + 4 * n), biv = *(const f32x4*)(bip + 4 * n), nlv = *(const f32x4*)(nlp + 4 * n);
                    unsigned o[4];
#pragma unroll
                    for (int i = 0; i < 4; ++i) { const int e = n * 4 + i;
                        const float xc = (e & 1) ? bfhi(xw[e >> 1]) : bflo(xw[e >> 1]);
                        const float rg = sigmoidf_(acc[ai][0][m][n][i] + brv[i]), ig = sigmoidf_(acc[ai][1][m][n][i] + biv[i]);
                        const float la = rg * nlv[i], x2 = 2.f * la;
                        const float om = 1.f - __builtin_amdgcn_exp2f(x2 * 1.44269504f);
                        const float bb = __builtin_amdgcn_sqrtf(om) * ig * xc;
                        o[i] = pk2(la, bb); }
                    *(u32x4*)(dst + 4 * n) = (u32x4){o[0], o[1], o[2], o[3]};
                    __builtin_amdgcn_sched_barrier(0); } }
    }
};
struct EpiLora {
    bf16_t* E; bf16_t* AA; bf16_t* Gt; const float* w0; const float* a0;
    __device__ __forceinline__ void operator()(const f32x4 (&acc)[2][2][4][2], const Unit& u, int wr, int wc, int fr, int fq) const {
        const int type = u.pn >> 2, d = type & 1;
        const int row0 = u.pm * BM + wr * 64 + fr;
        const float* bsrc = type < 2 ? w0 + d * RW : a0 + d * RW;
        bf16_t* obase = type < 2 ? E + d * RW : (type < 4 ? AA + d * RW : Gt);
        const int opitch = type < 4 ? 2 * RW : RW;
        const float sc = type < 2 ? 0.60653066f : 1.f;
#pragma unroll
        for (int bj = 0; bj < 2; ++bj) { const int ch0 = (u.pn & 3) * 256 + bj * HALF + wc * 32 + 8 * fq;
#pragma unroll
            for (int ai = 0; ai < 2; ++ai)
#pragma unroll
                for (int m = 0; m < 4; ++m) { const int row = row0 + ai * HALF + m * 16;
                    float o[8];
#pragma unroll
                    for (int n = 0; n < 2; ++n) { f32x4 bias = (f32x4){0.f, 0.f, 0.f, 0.f}; if (type < 4) bias = *(const f32x4*)(bsrc + ch0 + 4 * n);
#pragma unroll
                        for (int i = 0; i < 4; ++i) { const float z = acc[ai][bj][m][n][i] + bias[i]; o[n * 4 + i] = type < 4 ? sc * sigmoidf_(z) : z; } }
                    *(u32x4*)(obase + (size_t)row * opitch + ch0) = (u32x4){pk2(o[0], o[1]), pk2(o[2], o[3]), pk2(o[4], o[5]), pk2(o[6], o[7])};
                    __builtin_amdgcn_sched_barrier(0); } }
    }
};
}

struct XTile { const float* src; int ldsrc, ncv, k0, n0; bf16_t* dst; int lddst, drow0; };
__device__ __forceinline__ XTile xtile_desc(Frame& F, int ti) {
    const int T_IN = 32 * 88, T_OUT = 32 * 32, T_GU = 32 * 176;
    unsigned char* ws = F.ws; XTile t;
    if (ti < T_IN) { const int kt = ti / 88, nt = ti % 88; t = XTile{F.in[IN_WIN], INW, INW, kt * 64, nt * 64, (bf16_t*)(ws + WS_WTIN), D, nt * 64}; }
    else if (ti < T_IN + T_OUT) { const int t2 = ti - T_IN, kt = t2 / 32, nt = t2 % 32; t = XTile{F.in[IN_WOUT], D, D, kt * 64, nt * 64, (bf16_t*)(ws + WS_WTOUT), D, nt * 64}; }
    else if (ti < T_IN + T_OUT + T_GU) { const int t2 = ti - T_IN - T_OUT, kt = t2 / 176, nt = t2 % 176, n0 = nt * 64;
        const int drow0 = n0 < FFH ? (n0 / 128) * 256 + (n0 % 128) : ((n0 - FFH) / 128) * 256 + 128 + ((n0 - FFH) % 128);
        t = XTile{F.in[IN_WGU], 2 * FFH, 2 * FFH, kt * 64, n0, (bf16_t*)(ws + WS_WTGU), D, drow0}; }
    else { const int t2 = ti - T_IN - T_OUT - T_GU, kt = t2 / 32, nt = t2 % 32; t = XTile{F.in[IN_WDN], D, D, kt * 64, nt * 64, (bf16_t*)(ws + WS_WTDN), FFH, nt * 64}; }
    return t;
}
__device__ __forceinline__ void xtile_load(const XTile& t, int tid, float4& v0, float4& v1) {
    const int r = tid >> 4, c4 = (tid & 15) * 4;
    v0 = make_float4(0.f, 0.f, 0.f, 0.f); v1 = v0;
    if (t.n0 + c4 < t.ncv) { v0 = *(const float4*)(t.src + (size_t)(t.k0 + r) * t.ldsrc + t.n0 + c4); v1 = *(const float4*)(t.src + (size_t)(t.k0 + r + 32) * t.ldsrc + t.n0 + c4); }
}
__device__ __forceinline__ void xpose_all(Frame& F) {
    const int T_ALL = 32 * 88;
    LAS bf16_t* tl = (LAS bf16_t*)F.lds;
    const int tid = F.tid, r = tid >> 4, c4 = (tid & 15) * 4;
    int ti = blockIdx.x; if (ti >= T_ALL) return;
    XTile cur = xtile_desc(F, ti); float4 v0, v1; xtile_load(cur, tid, v0, v1);
    for (;;) {
        const int tn = ti + F.G; const bool has = tn < T_ALL;
        XTile nxt = cur; float4 n0 = v0, n1 = v1;
        if (has) { nxt = xtile_desc(F, tn); xtile_load(nxt, tid, n0, n1); }
        tl[(c4 + 0) * 68 + r] = (bf16_t)f2bf(v0.x); tl[(c4 + 1) * 68 + r] = (bf16_t)f2bf(v0.y); tl[(c4 + 2) * 68 + r] = (bf16_t)f2bf(v0.z); tl[(c4 + 3) * 68 + r] = (bf16_t)f2bf(v0.w);
        tl[(c4 + 0) * 68 + r + 32] = (bf16_t)f2bf(v1.x); tl[(c4 + 1) * 68 + r + 32] = (bf16_t)f2bf(v1.y); tl[(c4 + 2) * 68 + r + 32] = (bf16_t)f2bf(v1.z); tl[(c4 + 3) * 68 + r + 32] = (bf16_t)f2bf(v1.w);
        __syncthreads();
        { const int n = tid >> 3, kc = (tid & 7) * 8;
          const u32x2 va = *(const LAS u32x2*)(tl + n * 68 + kc), vb = *(const LAS u32x2*)(tl + n * 68 + kc + 4);
          *(u32x4*)(cur.dst + (size_t)(cur.drow0 + n) * cur.lddst + cur.k0 + kc) = (u32x4){va[0], va[1], vb[0], vb[1]}; }
        __syncthreads();
        if (!has) break;
        cur = nxt; v0 = n0; v1 = n1; ti = tn;
    }
}

__device__ __forceinline__ void xpose_tile_wave(const XTile& t, LAS bf16_t* tl, int lane) {
    const int q = lane >> 4, c4 = (lane & 15) * 4;
#pragma unroll
    for (int hf = 0; hf < 2; ++hf) {
        float4 v[8];
#pragma unroll
        for (int j = 0; j < 8; ++j) { const int k = 8 * (hf * 4 + (j >> 1)) + 2 * q + (j & 1);
            v[j] = (t.n0 + c4 < t.ncv) ? *(const float4*)(t.src + (size_t)(t.k0 + k) * t.ldsrc + t.n0 + c4) : make_float4(0.f, 0.f, 0.f, 0.f); }
#pragma unroll
        for (int m = 0; m < 4; ++m) { const int k0 = 8 * (hf * 4 + m) + 2 * q; const float4 a = v[2 * m], b = v[2 * m + 1];
            *(LAS unsigned*)(tl + (c4 + 0) * 68 + k0) = pk2(a.x, b.x); *(LAS unsigned*)(tl + (c4 + 1) * 68 + k0) = pk2(a.y, b.y);
            *(LAS unsigned*)(tl + (c4 + 2) * 68 + k0) = pk2(a.z, b.z); *(LAS unsigned*)(tl + (c4 + 3) * 68 + k0) = pk2(a.w, b.w); }
    }
    const int nr = lane >> 3, kc = (lane & 7) * 8;
#pragma unroll
    for (int r = 0; r < 8; ++r) { const int n = r * 8 + nr;
        const u32x2 va = *(const LAS u32x2*)(tl + n * 68 + kc), vb = *(const LAS u32x2*)(tl + n * 68 + kc + 4);
        *(u32x4*)(t.dst + (size_t)(t.drow0 + n) * t.lddst + t.k0 + kc) = (u32x4){va[0], va[1], vb[0], vb[1]}; }
}

__device__ __forceinline__ bool xtile_group_b(int ti) {
    const int T_IN = 32 * 88, T_OUT = 32 * 32, T_GU = 32 * 176;
    if (ti < T_IN + T_OUT) return true;
    if (ti < T_IN + T_OUT + T_GU) { const int nt = (ti - T_IN - T_OUT) % 176; const int unit = nt < 88 ? nt >> 1 : (nt - 88) >> 1; return unit < 24; }
    return false;
}
__device__ __forceinline__ void xpose_deferred(Frame& F, bool group_b, int first, int stride, LAS bf16_t* tl) {
    const int T0 = 32 * 88, T1 = 32 * 88 + 32 * 32 + 32 * 176 + 88 * 32;
    for (int ti = T0 + first; ti < T1; ti += stride) if (xtile_group_b(ti) == group_b) { const XTile t = xtile_desc(F, ti); xpose_tile_wave(t, tl, F.lane); }
}

__device__ __forceinline__ void p0_prologue(Frame& F) {
    const int tid = F.tid, G = F.G, bid = blockIdx.x;
    unsigned char* ws = F.ws;
    {
        LAS float* sv = (LAS float*)F.lds;
        LAS float* red = (LAS float*)(F.lds + 24576);
        const float* c = F.in[IN_C]; const float* cctx = F.in[IN_CCTX];
        for (int i = tid; i < 3 * D; i += 512) { const int r = i / D, k = i % D; const float cv = r == 0 ? cctx[k] : c[(r - 1) * D + k]; sv[i] = cv * sigmoidf_(cv); }
        __syncthreads();
        const float* wm = F.in[IN_WMOD]; const float* bm = F.in[IN_BMOD]; float* MOD = (float*)(ws + WS_MOD);
        for (int cb = bid; cb < 256; cb += G) {
            const int n0 = cb * 48;
            if (tid < 504) { const int cg4 = (tid % 12) * 4, kl = tid / 12;
                float a0[4] = {0, 0, 0, 0}, a1[4] = {0, 0, 0, 0}, a2[4] = {0, 0, 0, 0};
#pragma unroll 8
                for (int k = kl; k < D; k += 42) { const float4 w = *(const float4*)(wm + (size_t)k * 12288 + n0 + cg4);
                    const float s0 = sv[k], s1 = sv[D + k], s2 = sv[2 * D + k];
                    a0[0] += s0 * w.x; a0[1] += s0 * w.y; a0[2] += s0 * w.z; a0[3] += s0 * w.w;
                    a1[0] += s1 * w.x; a1[1] += s1 * w.y; a1[2] += s1 * w.z; a1[3] += s1 * w.w;
                    a2[0] += s2 * w.x; a2[1] += s2 * w.y; a2[2] += s2 * w.z; a2[3] += s2 * w.w; }
#pragma unroll
                for (int i = 0; i < 4; ++i) { red[(kl * 3 + 0) * 48 + cg4 + i] = a0[i]; red[(kl * 3 + 1) * 48 + cg4 + i] = a1[i]; red[(kl * 3 + 2) * 48 + cg4 + i] = a2[i]; } }
            __syncthreads();
            if (tid < 144) { const int r = tid / 48, j = tid % 48; float s = 0.f; for (int kl = 0; kl < 42; ++kl) s += red[(kl * 3 + r) * 48 + j]; MOD[r * 12288 + n0 + j] = s + bm[n0 + j]; }
            __syncthreads();
        }
    }
    xpose_all(F);
    {
        const size_t gt = (size_t)bid * 512 + tid, gs = (size_t)G * 512;
        bf16_t* btl = (bf16_t*)(ws + WS_BTLRU);
        const float* wr = F.in[IN_WR]; const float* wi = F.in[IN_WI];
        for (size_t it = gt; it < (size_t)4096 * 32; it += gs) { const int row = (int)(it & 4095), c0 = (int)(it >> 12) * 8;
            const int hd = row >> 9, q = (row >> 7) & 3, j = row & 127, koff = hd < 7 ? 128 * hd : 768, kk0 = c0 - (128 * hd - koff);
            float v[8];
            const float* W = ((q & 1) ? wi : wr) + ((size_t)((q >> 1) * 8 + hd) * 128) * 128 + j;
#pragma unroll
            for (int i = 0; i < 8; ++i) v[i] = (kk0 >= 0 && kk0 < 128) ? W[(size_t)(kk0 + i) * 128] : 0.f;
            *(u32x4*)(btl + (size_t)row * 256 + c0) = (u32x4){pk2(v[0], v[1]), pk2(v[2], v[3]), pk2(v[4], v[5]), pk2(v[6], v[7])}; }
        bf16_t* bto = (bf16_t*)(ws + WS_BTLORA);
        const float* wup = F.in[IN_WUP]; const float* aup = F.in[IN_AUP]; const float* gup = F.in[IN_GUP];
        for (size_t it = gt; it < (size_t)5120 * 32; it += gs) { const int n = (int)(it % 5120), k0 = (int)(it / 5120) * 8;
            float v[8];
            const float* src = nullptr;
            if (n < 2048) { if (k0 < 64) src = wup + ((size_t)(n >> 10) * 64 + k0) * RW + (n & 1023); }
            else if (n < 4096) { if (k0 >= 64 && k0 < 128) src = aup + ((size_t)((n - 2048) >> 10) * 64 + (k0 - 64)) * RW + (n & 1023); }
            else { if (k0 < 160) src = gup + (size_t)k0 * RW + (n - 4096); }
#pragma unroll
            for (int i = 0; i < 8; ++i) v[i] = src ? src[(size_t)i * RW] : 0.f;
            *(u32x4*)(bto + (size_t)n * 256 + k0) = (u32x4){pk2(v[0], v[1]), pk2(v[2], v[3]), pk2(v[4], v[5]), pk2(v[6], v[7])}; }
        float* nl8 = (float*)(ws + WS_NL8); const float* lam = F.in[IN_LAM];
        for (size_t idx = gt; idx < 2048; idx += gs) { const float l = lam[idx]; nl8[idx] = -8.f * log1pf(__expf(-l)); }
    }
}

__device__ __forceinline__ void p1_normmod(Frame& F) {
    const float* MOD = (const float*)(F.ws + WS_MOD); const float* g1 = F.in[IN_NMPRE]; bf16_t* H = (bf16_t*)(F.ws + WS_H);
    for (int row = blockIdx.x * 8 + F.wave; row < NTOK; row += F.G * 8) {
        const float* xr = row < NPTOK ? F.in[IN_XP] + (size_t)row * D : F.in[IN_XS] + (size_t)(row - NPTOK) * D;
        float4 v[8]; float ss = 0.f;
#pragma unroll
        for (int i = 0; i < 8; ++i) { v[i] = *(const float4*)(xr + (i * 64 + F.lane) * 4); ss += v[i].x * v[i].x + v[i].y * v[i].y + v[i].z * v[i].z + v[i].w * v[i].w; }
        ss = wave_sum(ss);
        const float rstd = rsqrtf(ss * (1.f / D) + 1e-6f);
        const float* md = MOD + modidx(row) * 12288;
#pragma unroll
        for (int i = 0; i < 8; ++i) { const int col = (i * 64 + F.lane) * 4;
            const float4 g = *(const float4*)(g1 + col), sc = *(const float4*)(md + D + col), sh = *(const float4*)(md + col);
            const float h0 = v[i].x * rstd * g.x * (1.f + sc.x) + sh.x, h1 = v[i].y * rstd * g.y * (1.f + sc.y) + sh.y;
            const float h2 = v[i].z * rstd * g.z * (1.f + sc.z) + sh.z, h3 = v[i].w * rstd * g.w * (1.f + sc.w) + sh.w;
            *(u32x2*)(H + (size_t)row * D + col) = (u32x2){pk2(h0, h1), pk2(h2, h3)}; }
    }
}

struct NbrOff { int o0, o1, o2, o3; };
__device__ __forceinline__ NbrOff nbr_offsets(int g) {
    NbrOff n;
    if (g < NPTOK) { const int t = g & (PSEQ - 1); n.o0 = t >= 1 ? -1 : 0; n.o1 = t < PSEQ - 1 ? 1 : 0; n.o2 = 0; n.o3 = 0; }
    else { const int t = (g - NPTOK) & (SSEQ - 1), row = t >> 6, col = t & 63; n.o0 = col >= 1 ? -1 : 0; n.o1 = col < 63 ? 1 : 0; n.o2 = row >= 1 ? -64 : 0; n.o3 = row < 63 ? 64 : 0; }
    return n;
}
__device__ __forceinline__ int nbr_kind(bool sample, int j) { return sample ? (j < 840 ? 0 : (j < 1680 ? 1 : (j < 2520 ? 2 : 3))) : (j < 1680 ? 0 : 1); }
__device__ __forceinline__ int nbr_pick(const NbrOff& n, int kind) { return kind == 0 ? n.o0 : (kind == 1 ? n.o1 : (kind == 2 ? n.o2 : n.o3)); }
__device__ __forceinline__ float mixed_val(const bf16_t* PR, int g, int j, int off, float mu) {
    const float p = bf2f(PR[(size_t)g * INWP + j]);
    const float q = off ? bf2f(PR[(size_t)(g + off) * INWP + j]) : 0.f;
    return p + mu * (q - p);
}

__device__ __forceinline__ void p3_elem(Frame& F) {
    const bf16_t* PROJ = (const bf16_t*)(F.ws + WS_PROJ); const bf16_t* PR = PROJ + 2048;
    bf16_t* XC = (bf16_t*)(F.ws + WS_XC); bf16_t* LA = (bf16_t*)(F.ws + WS_LA);
    const float* cw = F.in[IN_CONVW]; const float* cb = F.in[IN_CONVB]; const float* mu = F.in[IN_MU];
    const int lane = F.lane;
    for (int g = blockIdx.x * 8 + F.wave; g < NTOK; g += F.G * 8) {
        const bool sample = g >= NPTOK; const int T = sample ? SSEQ : PSEQ, t = sample ? ((g - NPTOK) & (SSEQ - 1)) : (g & (PSEQ - 1));
#pragma unroll
        for (int half = 0; half < 2; ++half) { const int c0 = half * 512 + lane * 8;
            float o[8];
#pragma unroll
            for (int i = 0; i < 8; ++i) o[i] = cb[c0 + i];
#pragma unroll
            for (int k = 0; k < 4; ++k) { const int tt = t + k - 2;
                if (tt >= 0 && tt < T) { const u32x4 w = *(const u32x4*)(PROJ + (size_t)(g + k - 2) * INWP + c0);
                    const float4 w0 = *(const float4*)(cw + k * LRUW + c0), w1 = *(const float4*)(cw + k * LRUW + c0 + 4);
                    o[0] += bflo(w[0]) * w0.x; o[1] += bfhi(w[0]) * w0.y; o[2] += bflo(w[1]) * w0.z; o[3] += bfhi(w[1]) * w0.w;
                    o[4] += bflo(w[2]) * w1.x; o[5] += bfhi(w[2]) * w1.y; o[6] += bflo(w[3]) * w1.z; o[7] += bfhi(w[3]) * w1.w; } }
            *(u32x4*)(XC + (size_t)g * LRUW + c0) = (u32x4){pk2(o[0], o[1]), pk2(o[2], o[3]), pk2(o[4], o[5]), pk2(o[6], o[7])}; }
        const NbrOff no = nbr_offsets(g);
        if (lane < 48) {
            u32x4 ov = (u32x4){0u, 0u, 0u, 0u};
            if (lane < 36) { const int j = 3072 + lane * 8; const int off = sample ? no.o3 : no.o1;
                const u32x4 pw = *(const u32x4*)(PR + (size_t)g * INWP + j), qw = *(const u32x4*)(PR + (size_t)(g + off) * INWP + j);
                float p[8], q[8], m[8], v[8]; unpack8(pw, p); unpack8(qw, q); ld8(mu + j, m); const float fl = off ? 1.f : 0.f;
#pragma unroll
                for (int i = 0; i < 8; ++i) { const float x = p[i] + m[i] * (q[i] * fl - p[i]); v[i] = lane < 8 ? tanhf(x) : (lane < 16 ? x : sigmoidf_(x)); }
                ov = (u32x4){pk2(v[0], v[1]), pk2(v[2], v[3]), pk2(v[4], v[5]), pk2(v[6], v[7])}; }
            *(u32x4*)(LA + (size_t)g * LAK + lane * 8) = ov; }
    }
}

template <bool SAMPLE>
__device__ __forceinline__ void lru_unit(Frame& F, int uu) {
    constexpr int CH = SAMPLE ? 16 : 64, CHP = CH / 2, NCH = 512 / CHP, NSEG = SAMPLE ? 4 : 1, CL = 16, SEGT = NCH * CL;
    const unsigned* LAB = (const unsigned*)F.out;
    const bf16_t* PROJ = (const bf16_t*)(F.ws + WS_PROJ); bf16_t* MIX = (bf16_t*)(F.ws + WS_H);
    LAS float* cinF = (LAS float*)F.lds;
    LAS float* cinB = (LAS float*)(F.lds + 16384);
    LAS float* aggA = (LAS float*)(F.lds + 32768);
    LAS float* aggB = (LAS float*)(F.lds + 32768 + 4096);
    LAS float* segc = (LAS float*)(F.lds + 32768 + 8192);
    const int tid = F.tid, c = tid / CHP, ch = (tid % CHP) * 2;
    float* nsl = F.out + (size_t)2 * NPTOK * D;
    const int ngrp = LRUW / CH, b = uu / ngrp, cgp = uu % ngrp, chan = cgp * CH + ch;
    const int g0 = SAMPLE ? NPTOK + b * SSEQ : b * PSEQ;
    for (int dir = 0; dir < 2; ++dir) {
        LAS float* cin = dir ? cinB : cinF;
        if (c == 0) { segc[ch] = SAMPLE ? F.in[IN_SLRU][(b * 2 + dir) * LRUW + chan] : 0.f; segc[ch + 1] = SAMPLE ? F.in[IN_SLRU][(b * 2 + dir) * LRUW + chan + 1] : 0.f; }
        __syncthreads();
        for (int si = 0; si < NSEG; ++si) { const int s = dir ? NSEG - 1 - si : si;
            const unsigned* p = LAB + ((size_t)(g0 + s * SEGT + c * CL) * 2 + dir) * LRUW + chan;
            u32x2 wv[CL];
#pragma unroll
            for (int i = 0; i < CL; ++i) wv[i] = *(const u32x2*)(p + (size_t)i * 2 * LRUW);
            float A0 = 1.f, B0 = 0.f, A1 = 1.f, B1 = 0.f;
            if (dir == 0) {
#pragma unroll
                for (int i = 0; i < CL; ++i) { const float a0 = __expf(bflo(wv[i][0])), a1 = __expf(bflo(wv[i][1])); B0 = a0 * B0 + bfhi(wv[i][0]); A0 *= a0; B1 = a1 * B1 + bfhi(wv[i][1]); A1 *= a1; }
            } else {
#pragma unroll
                for (int i = CL - 1; i >= 0; --i) { const float a0 = __expf(bflo(wv[i][0])), a1 = __expf(bflo(wv[i][1])); B0 = a0 * B0 + bfhi(wv[i][0]); A0 *= a0; B1 = a1 * B1 + bfhi(wv[i][1]); A1 *= a1; }
            }
            aggA[c * CH + ch] = A0; aggB[c * CH + ch] = B0; aggA[c * CH + ch + 1] = A1; aggB[c * CH + ch + 1] = B1;
            __syncthreads();
            if (tid < CH) { float carry = segc[tid];
                for (int k = 0; k < NCH; ++k) { const int cc = dir ? NCH - 1 - k : k; cin[(s * NCH + cc) * CH + tid] = carry; carry = aggA[cc * CH + tid] * carry + aggB[cc * CH + tid]; }
                segc[tid] = carry; }
            __syncthreads();
        }
        if (!SAMPLE && tid < CH) nsl[(size_t)(b * 2 + dir) * LRUW + cgp * CH + tid] = segc[tid];
        __syncthreads();
    }
    for (int s = 0; s < NSEG; ++s) {
        const int gb = g0 + s * SEGT + c * CL;
        const unsigned* pf = LAB + ((size_t)gb * 2 + 0) * LRUW + chan;
        const unsigned* pb = LAB + ((size_t)gb * 2 + 1) * LRUW + chan;
        float hf0[CL], hf1[CL]; float h0 = cinF[(s * NCH + c) * CH + ch], h1 = cinF[(s * NCH + c) * CH + ch + 1];
        u32x2 wv[CL]; unsigned glw[CL];
#pragma unroll
        for (int i = 0; i < CL; ++i) wv[i] = *(const u32x2*)(pf + (size_t)i * 2 * LRUW);
#pragma unroll
        for (int i = 0; i < CL; ++i) glw[i] = *(const unsigned*)(PROJ + (size_t)(gb + i) * INWP + LRUW + chan);
#pragma unroll
        for (int i = 0; i < CL; ++i) { h0 = __expf(bflo(wv[i][0])) * h0 + bfhi(wv[i][0]); h1 = __expf(bflo(wv[i][1])) * h1 + bfhi(wv[i][1]); hf0[i] = h0; hf1[i] = h1; }
#pragma unroll
        for (int i = 0; i < CL; ++i) wv[i] = *(const u32x2*)(pb + (size_t)i * 2 * LRUW);
        h0 = cinB[(s * NCH + c) * CH + ch]; h1 = cinB[(s * NCH + c) * CH + ch + 1];
#pragma unroll
        for (int i = CL - 1; i >= 0; --i) { h0 = __expf(bflo(wv[i][0])) * h0 + bfhi(wv[i][0]); h1 = __expf(bflo(wv[i][1])) * h1 + bfhi(wv[i][1]);
            *(unsigned*)(MIX + (size_t)(gb + i) * D + chan) = pk2((hf0[i] + h0) * gelu_tanh(bflo(glw[i])), (hf1[i] + h1) * gelu_tanh(bfhi(glw[i]))); }
    }
    __syncthreads();
}
__device__ __forceinline__ void p5_lru_scan(Frame& F) {
    const int half = F.G / 2;
    if ((int)blockIdx.x < half) { for (int u = blockIdx.x; u < 128; u += half) lru_unit<true>(F, u); }
    else { for (int u = blockIdx.x - half; u < 512; u += F.G - half) lru_unit<false>(F, u); }
}

struct WkvJob { int g0; int gstep; bool sample; int h; int dir; const float* S0; float* Sout; bf16_t* Y; int ypitch; };
constexpr int WNS = 8;
constexpr int WKV_LDS_PER_WAVE = (6 * WNS * 64 + WNS * 64) * 4;
template <int KIND, bool HAS_S0>
__device__ __forceinline__ void wkv_unit(Frame& F, const WkvJob& J) {
    const int lane = F.lane, vi = lane >> 3, ki = lane & 7;
    LAS float* L = (LAS float*)(F.lds + F.wave * WKV_LDS_PER_WAVE);
    LAS float* Ys = L + 6 * WNS * 64;
    const bf16_t* PR = (const bf16_t*)(F.ws + WS_PROJ) + 2048;
    const bf16_t* Eb = (const bf16_t*)F.out; const bf16_t* Ab = Eb + (size_t)NTOK * 2 * RW;
    const int ch8 = J.h * 64 + ki * 8, dir = J.dir;
    const int kd_r = nbr_kind(J.sample, ch8), kd_k = nbr_kind(J.sample, 1024 + ch8), kd_v = nbr_kind(J.sample, 2048 + ch8);
    float mu_r[8], mu_k[8], mu_v[8], k_k[8], k_a[8];
    ld8(F.in[IN_MU] + ch8, mu_r); ld8(F.in[IN_MU] + 1024 + ch8, mu_k); ld8(F.in[IN_MU] + 2048 + ch8, mu_v); ld8(F.in[IN_KK] + ch8, k_k); ld8(F.in[IN_KA] + ch8, k_a);
    f32x2 S[8][4];
    if (HAS_S0) {
#pragma unroll
        for (int i = 0; i < 8; ++i) { float t[8]; ld8(J.S0 + (vi * 8 + i) * 64 + ki * 8, t);
#pragma unroll
            for (int jp = 0; jp < 4; ++jp) S[i][jp] = (f32x2){t[2 * jp], t[2 * jp + 1]}; }
    } else {
#pragma unroll
        for (int i = 0; i < 8; ++i)
#pragma unroll
            for (int jp = 0; jp < 4; ++jp) S[i][jp] = (f32x2){(KIND == 1 && vi == ki && i == 2 * jp) ? 1.f : 0.f, (KIND == 1 && vi == ki && i == 2 * jp + 1) ? 1.f : 0.f};
    }
    u32x4 ro, rn, ko, kn, vo, vn, ee, aa; int vflags = 0;
#define WKV_FETCH(mc) do { const int g = J.g0 + ((mc) * WNS + vi) * J.gstep; const NbrOff no = nbr_offsets(g); \
        const int ofr = nbr_pick(no, kd_r), ofk = nbr_pick(no, kd_k), ofv = nbr_pick(no, kd_v); \
        vflags = (ofr ? 1 : 0) | (ofk ? 2 : 0) | (ofv ? 4 : 0); \
        const bf16_t* pg = PR + (size_t)g * INWP + ch8; \
        ro = *(const u32x4*)pg; rn = *(const u32x4*)(pg + (ptrdiff_t)ofr * INWP); ko = *(const u32x4*)(pg + 1024); kn = *(const u32x4*)(pg + (ptrdiff_t)ofk * INWP + 1024); \
        if (KIND != 1) { vo = *(const u32x4*)(pg + 2048); vn = *(const u32x4*)(pg + (ptrdiff_t)ofv * INWP + 2048); } \
        ee = *(const u32x4*)(Eb + ((size_t)g * 2 + dir) * RW + ch8); aa = *(const u32x4*)(Ab + ((size_t)g * 2 + dir) * RW + ch8); } while (0)
#define WKV_CONVERT() do { float t0[8], t1[8], rr[8], kx[8], kk[8], o[8]; \
        unpack8(ro, t0); unpack8(rn, t1); const float fr_ = (vflags & 1) ? 1.f : 0.f, fk_ = (vflags & 2) ? 1.f : 0.f, fv_ = (vflags & 4) ? 1.f : 0.f; \
        _Pragma("unroll") for (int i = 0; i < 8; ++i) rr[i] = t0[i] + mu_r[i] * (t1[i] * fr_ - t0[i]); \
        lds_st8(L + (4 * WNS + vi) * 64 + ki * 8, rr); \
        unpack8(ko, t0); unpack8(kn, t1); float ssq = 0.f; \
        _Pragma("unroll") for (int i = 0; i < 8; ++i) { kx[i] = t0[i] + mu_k[i] * (t1[i] * fk_ - t0[i]); kk[i] = kx[i] * k_k[i]; ssq += kk[i] * kk[i]; } \
        ssq = red8(ssq); const float rs = rsqrtf(fmaxf(ssq, 1e-24f)); \
        unpack8(aa, t1); unpack8(ee, t0); \
        _Pragma("unroll") for (int i = 0; i < 8; ++i) { kk[i] *= rs; o[i] = -kk[i]; } \
        lds_st8(L + (1 * WNS + vi) * 64 + ki * 8, o); \
        _Pragma("unroll") for (int i = 0; i < 8; ++i) o[i] = kk[i] * t1[i]; \
        lds_st8(L + (2 * WNS + vi) * 64 + ki * 8, o); \
        _Pragma("unroll") for (int i = 0; i < 8; ++i) o[i] = __expf(-t0[i]); \
        lds_st8(L + (0 * WNS + vi) * 64 + ki * 8, o); \
        if (KIND != 1) { \
            _Pragma("unroll") for (int i = 0; i < 8; ++i) o[i] = kx[i] * (1.f + (t1[i] - 1.f) * k_a[i]); \
            lds_st8(L + (3 * WNS + vi) * 64 + ki * 8, o); \
            unpack8(vo, t0); unpack8(vn, t1); \
            _Pragma("unroll") for (int i = 0; i < 8; ++i) o[i] = t0[i] + mu_v[i] * (t1[i] * fv_ - t0[i]); \
            lds_st8(L + (5 * WNS + vi) * 64 + ki * 8, o); } } while (0)
    WKV_FETCH(0);
    WKV_CONVERT();
    for (int mc = 0; mc < 256 / WNS; ++mc) {
        if (mc + 1 < 256 / WNS) WKV_FETCH(mc + 1);
#pragma unroll 2
        for (int s = 0; s < WNS; ++s) {
            f32x2 w[4], kk[4], kka[4], kd[4], r[4], vp[4];
#define WKV_LD8(dst, arr, off) do { const f32x4 _a = *(const LAS f32x4*)(L + ((arr) * WNS + s) * 64 + (off)), _b = *(const LAS f32x4*)(L + ((arr) * WNS + s) * 64 + (off) + 4); \
            dst[0] = (f32x2){_a[0], _a[1]}; dst[1] = (f32x2){_a[2], _a[3]}; dst[2] = (f32x2){_b[0], _b[1]}; dst[3] = (f32x2){_b[2], _b[3]}; } while (0)
            WKV_LD8(w, 0, ki * 8); WKV_LD8(kk, 1, ki * 8); WKV_LD8(kka, 2, ki * 8);
            if (KIND != 1) { WKV_LD8(kd, 3, ki * 8); WKV_LD8(vp, 5, vi * 8); }
            if (KIND == 0) WKV_LD8(r, 4, ki * 8);
            f32x2 acc[8]; float sa[8];
            pk_mul8(acc, S[0][0], S[1][0], S[2][0], S[3][0], S[4][0], S[5][0], S[6][0], S[7][0], kk[0]);
#pragma unroll
            for (int jp = 1; jp < 4; ++jp) pk_mac8(acc, S[0][jp], S[1][jp], S[2][jp], S[3][jp], S[4][jp], S[5][jp], S[6][jp], S[7][jp], kk[jp]);
#pragma unroll
            for (int i = 0; i < 8; ++i) sa[i] = vadd(acc[i][0], acc[i][1]);
            red8x8(sa);
            f32x2 sap[4];
#pragma unroll
            for (int p = 0; p < 4; ++p) sap[p] = (f32x2){sa[2 * p], sa[2 * p + 1]};
#pragma unroll
            for (int jp = 0; jp < 4; ++jp) pk_upd8<KIND != 1>(S[0][jp], S[1][jp], S[2][jp], S[3][jp], S[4][jp], S[5][jp], S[6][jp], S[7][jp], sap, vp, w[jp], kka[jp], kd[jp]);
            if (KIND == 0) {
                float y[8];
                pk_mul8(acc, S[0][0], S[1][0], S[2][0], S[3][0], S[4][0], S[5][0], S[6][0], S[7][0], r[0]);
#pragma unroll
                for (int jp = 1; jp < 4; ++jp) pk_mac8(acc, S[0][jp], S[1][jp], S[2][jp], S[3][jp], S[4][jp], S[5][jp], S[6][jp], S[7][jp], r[jp]);
#pragma unroll
                for (int i = 0; i < 8; ++i) y[i] = vadd(acc[i][0], acc[i][1]);
                red8x8(y);
                if (ki == 0) lds_st8(Ys + s * 64 + vi * 8, y);
            }
        }
        if (KIND == 0) {
            const f32x4 a = *(const LAS f32x4*)(Ys + vi * 64 + ki * 8), b = *(const LAS f32x4*)(Ys + vi * 64 + ki * 8 + 4);
            const int g = J.g0 + (mc * WNS + vi) * J.gstep;
            *(u32x4*)(J.Y + (size_t)g * J.ypitch + ch8) = (u32x4){pk2(a[0], a[1]), pk2(a[2], a[3]), pk2(b[0], b[1]), pk2(b[2], b[3])};
        }
        if (mc + 1 < 256 / WNS) WKV_CONVERT();
    }
    if (J.Sout) {
#pragma unroll
        for (int i = 0; i < 8; ++i) { float* d = J.Sout + (vi * 8 + i) * 64 + ki * 8;
            *(float4*)d = make_float4(S[i][0][0], S[i][0][1], S[i][1][0], S[i][1][1]); *(float4*)(d + 4) = make_float4(S[i][2][0], S[i][2][1], S[i][3][0], S[i][3][1]); }
    }
#undef WKV_FETCH
#undef WKV_CONVERT
#undef WKV_LD8
}

typedef __bf16 bf16x2_t __attribute__((ext_vector_type(2)));
__device__ __forceinline__ unsigned cvt2(f32x2 v) { return __builtin_bit_cast(unsigned, __builtin_convertvector(v, bf16x2_t)); }
#define BLO " op_sel:[0,0,0] op_sel_hi:[0,1,1]"
#define BHI " op_sel:[1,0,0] op_sel_hi:[1,1,1]"
template <bool HASV>
__device__ __forceinline__ void pk_upd8m(f32x2& s0, f32x2& s1, f32x2& s2, f32x2& s3, f32x2& s4, f32x2& s5, f32x2& s6, f32x2& s7, const f32x2 (&sv)[4],
                                         f32x2 w0, f32x2 w1, f32x2 ka0, f32x2 ka1, f32x2 kd0, f32x2 kd1) {
    if (HASV)
        asm("v_pk_mul_f32 %0, %0, %12\n\tv_pk_mul_f32 %1, %1, %13\n\tv_pk_mul_f32 %2, %2, %12\n\tv_pk_mul_f32 %3, %3, %13\n\tv_pk_mul_f32 %4, %4, %12\n\tv_pk_mul_f32 %5, %5, %13\n\tv_pk_mul_f32 %6, %6, %12\n\tv_pk_mul_f32 %7, %7, %13\n\t"
            "v_pk_fma_f32 %0, %8, %14, %0" BLO "\n\tv_pk_fma_f32 %1, %8, %15, %1" BLO "\n\tv_pk_fma_f32 %2, %9, %14, %2" BLO "\n\tv_pk_fma_f32 %3, %9, %15, %3" BLO "\n\t"
            "v_pk_fma_f32 %4, %10, %14, %4" BLO "\n\tv_pk_fma_f32 %5, %10, %15, %5" BLO "\n\tv_pk_fma_f32 %6, %11, %14, %6" BLO "\n\tv_pk_fma_f32 %7, %11, %15, %7" BLO "\n\t"
            "v_pk_fma_f32 %0, %8, %16, %0" BHI "\n\tv_pk_fma_f32 %1, %8, %17, %1" BHI "\n\tv_pk_fma_f32 %2, %9, %16, %2" BHI "\n\tv_pk_fma_f32 %3, %9, %17, %3" BHI "\n\t"
            "v_pk_fma_f32 %4, %10, %16, %4" BHI "\n\tv_pk_fma_f32 %5, %10, %17, %5" BHI "\n\tv_pk_fma_f32 %6, %11, %16, %6" BHI "\n\tv_pk_fma_f32 %7, %11, %17, %7" BHI
            : "+v"(s0), "+v"(s1), "+v"(s2), "+v"(s3), "+v"(s4), "+v"(s5), "+v"(s6), "+v"(s7)
            : "v"(sv[0]), "v"(sv[1]), "v"(sv[2]), "v"(sv[3]), "v"(w0), "v"(w1), "v"(ka0), "v"(ka1), "v"(kd0), "v"(kd1));
    else
        asm("v_pk_mul_f32 %0, %0, %12\n\tv_pk_mul_f32 %1, %1, %13\n\tv_pk_mul_f32 %2, %2, %12\n\tv_pk_mul_f32 %3, %3, %13\n\tv_pk_mul_f32 %4, %4, %12\n\tv_pk_mul_f32 %5, %5, %13\n\tv_pk_mul_f32 %6, %6, %12\n\tv_pk_mul_f32 %7, %7, %13\n\t"
            "v_pk_fma_f32 %0, %8, %14, %0" BLO "\n\tv_pk_fma_f32 %1, %8, %15, %1" BLO "\n\tv_pk_fma_f32 %2, %9, %14, %2" BLO "\n\tv_pk_fma_f32 %3, %9, %15, %3" BLO "\n\t"
            "v_pk_fma_f32 %4, %10, %14, %4" BLO "\n\tv_pk_fma_f32 %5, %10, %15, %5" BLO "\n\tv_pk_fma_f32 %6, %11, %14, %6" BLO "\n\tv_pk_fma_f32 %7, %11, %15, %7" BLO
            : "+v"(s0), "+v"(s1), "+v"(s2), "+v"(s3), "+v"(s4), "+v"(s5), "+v"(s6), "+v"(s7)
            : "v"(sv[0]), "v"(sv[1]), "v"(sv[2]), "v"(sv[3]), "v"(w0), "v"(w1), "v"(ka0), "v"(ka1));
}
#undef BLO
#undef BHI
constexpr int WKM_LDS_PER_WAVE = 12352;
template <int KIND, bool HAS_S0>
__device__ __forceinline__ void wkv_unit_m(Frame& F, const WkvJob& J) {
    const int lane = F.lane, vi = lane >> 3, ki = lane & 7;
    const int nl = lane & 15, q = lane >> 4;
    constexpr bool HASV = (KIND == 0 || KIND == 2), HASY = (KIND == 0 || KIND == 3), IDENT = (KIND == 1 || KIND == 3);
    LAS float* LW = (LAS float*)(F.lds + F.wave * WKM_LDS_PER_WAVE);
    LAS float* LKA = LW + 512; LAS float* LKD = LW + 1024; LAS float* LV = LW + 1536; LAS float* Ys = LW + 2048; LAS float* LC = LW + 2560;
    LAS bf16_t* LNK = (LAS bf16_t*)(LW + 2576); LAS bf16_t* LWR = LNK + 512;
    const bf16_t* PR = (const bf16_t*)(F.ws + WS_PROJ) + 2048;
    const bf16_t* Eb = (const bf16_t*)F.out; const bf16_t* Ab = Eb + (size_t)NTOK * 2 * RW;
    const int ch8 = J.h * 64 + ki * 8, dir = J.dir;
    const int kd_r = nbr_kind(J.sample, ch8), kd_k = nbr_kind(J.sample, 1024 + ch8), kd_v = nbr_kind(J.sample, 2048 + ch8);
    float one; asm volatile("v_mov_b32 %0, 1.0" : "=v"(one));
    f32x2 S[4][2][4];
#pragma unroll
    for (int tn = 0; tn < 4; ++tn)
#pragma unroll
        for (int ks = 0; ks < 2; ++ks) {
            if (HAS_S0) { float t[8]; ld8(J.S0 + (16 * tn + nl) * 64 + 32 * ks + 8 * q, t);
#pragma unroll
                for (int jp = 0; jp < 4; ++jp) S[tn][ks][jp] = (f32x2){t[2 * jp], t[2 * jp + 1]}; }
            else {
#pragma unroll
                for (int jp = 0; jp < 4; ++jp) { const int row = 16 * tn + nl, col = 32 * ks + 8 * q + 2 * jp;
                    S[tn][ks][jp] = (f32x2){(IDENT && row == col) ? 1.f : 0.f, (IDENT && row == col + 1) ? 1.f : 0.f}; } }
        }
    u32x4 ro, rn, ko, kn, vo, vn, ee, aa; int vflags = 0;
#define WKV_FETCH(mc) do { const int g = J.g0 + ((mc) * WNS + vi) * J.gstep; const NbrOff no = nbr_offsets(g); \
        const int ofr = nbr_pick(no, kd_r), ofk = nbr_pick(no, kd_k), ofv = nbr_pick(no, kd_v); \
        vflags = (ofr ? 1 : 0) | (ofk ? 2 : 0) | (ofv ? 4 : 0); \
        const bf16_t* pg = PR + (size_t)g * INWP + ch8; \
        ko = *(const u32x4*)(pg + 1024); kn = *(const u32x4*)(pg + (ptrdiff_t)ofk * INWP + 1024); \
        if (HASY) { ro = *(const u32x4*)pg; rn = *(const u32x4*)(pg + (ptrdiff_t)ofr * INWP); } \
        if (HASV) { vo = *(const u32x4*)(pg + 2048); vn = *(const u32x4*)(pg + (ptrdiff_t)ofv * INWP + 2048); } \
        ee = *(const u32x4*)(Eb + ((size_t)g * 2 + dir) * RW + ch8); aa = *(const u32x4*)(Ab + ((size_t)g * 2 + dir) * RW + ch8); } while (0)
#define WKV_CONVERT() do { float t0[8], t1[8], m[8], rr[8], kx[8], kk[8], wv[8], o[8]; \
        const float fr_ = (vflags & 1) ? 1.f : 0.f, fk_ = (vflags & 2) ? 1.f : 0.f, fv_ = (vflags & 4) ? 1.f : 0.f; \
        unpack8(ko, t0); unpack8(kn, t1); ld8(F.in[IN_MU] + 1024 + ch8, m); float ssq = 0.f; \
        _Pragma("unroll") for (int i = 0; i < 8; ++i) kx[i] = t0[i] + m[i] * (t1[i] * fk_ - t0[i]); \
        ld8(F.in[IN_KK] + ch8, m); \
        _Pragma("unroll") for (int i = 0; i < 8; ++i) { kk[i] = kx[i] * m[i]; ssq += kk[i] * kk[i]; } \
        ssq = red8(ssq); const float rs = rsqrtf(fmaxf(ssq, 1e-24f)); \
        _Pragma("unroll") for (int i = 0; i < 8; ++i) kk[i] *= rs; \
        *(LAS u32x4*)(LNK + vi * 64 + ki * 8) = (u32x4){pk2(-kk[0], -kk[1]), pk2(-kk[2], -kk[3]), pk2(-kk[4], -kk[5]), pk2(-kk[6], -kk[7])}; \
        unpack8(aa, t1); unpack8(ee, t0); \
        _Pragma("unroll") for (int i = 0; i < 8; ++i) { wv[i] = __expf(-t0[i]); kk[i] *= t1[i]; } \
        lds_st8(LW + vi * 64 + ki * 8, wv); lds_st8(LKA + vi * 64 + ki * 8, kk); \
        float km[8]; if (HASV && HASY) { _Pragma("unroll") for (int i = 0; i < 8; ++i) km[i] = kx[i]; } \
        if (HASV) { ld8(F.in[IN_KA] + ch8, m); \
            _Pragma("unroll") for (int i = 0; i < 8; ++i) kx[i] = kx[i] * (1.f + (t1[i] - 1.f) * m[i]); \
            lds_st8(LKD + vi * 64 + ki * 8, kx); \
            unpack8(vo, t0); unpack8(vn, t1); ld8(F.in[IN_MU] + 2048 + ch8, m); \
            _Pragma("unroll") for (int i = 0; i < 8; ++i) o[i] = t0[i] + m[i] * (t1[i] * fv_ - t0[i]); \
            lds_st8(LV + vi * 64 + ki * 8, o); } \
        if (HASY) { unpack8(ro, t0); unpack8(rn, t1); ld8(F.in[IN_MU] + ch8, m); float c1 = 0.f, c2 = 0.f; \
            _Pragma("unroll") for (int i = 0; i < 8; ++i) { rr[i] = t0[i] + m[i] * (t1[i] * fr_ - t0[i]); c1 += kk[i] * rr[i]; if (HASV) c2 += kx[i] * rr[i]; wv[i] *= rr[i]; } \
            if (HASV && dir == 0) { ld8(F.in[IN_RK] + ch8, m); _Pragma("unroll") for (int i = 0; i < 8; ++i) c2 += rr[i] * km[i] * m[i]; } \
            c1 = red8(c1); c2 = red8(c2); if (ki == 0) { LC[vi * 2] = c1; LC[vi * 2 + 1] = c2; } \
            *(LAS u32x4*)(LWR + vi * 64 + ki * 8) = (u32x4){pk2(wv[0], wv[1]), pk2(wv[2], wv[3]), pk2(wv[4], wv[5]), pk2(wv[6], wv[7])}; } } while (0)
    WKV_FETCH(0);
    WKV_CONVERT();
    for (int mc = 0; mc < 256 / WNS; ++mc) {
        if (mc + 1 < 256 / WNS) WKV_FETCH(mc + 1);
#pragma unroll 1
        for (int s = 0; s < WNS; ++s) {
            f32x2 w[2][4], ka[2][4], kd[2][4]; bf16x8 af[2]; float v[4];
#pragma unroll
            for (int ks = 0; ks < 2; ++ks) { const int o = s * 64 + 32 * ks + 8 * q;
                { const f32x4 a = *(const LAS f32x4*)(LW + o), b = *(const LAS f32x4*)(LW + o + 4); w[ks][0] = (f32x2){a[0], a[1]}; w[ks][1] = (f32x2){a[2], a[3]}; w[ks][2] = (f32x2){b[0], b[1]}; w[ks][3] = (f32x2){b[2], b[3]}; }
                { const f32x4 a = *(const LAS f32x4*)(LKA + o), b = *(const LAS f32x4*)(LKA + o + 4); ka[ks][0] = (f32x2){a[0], a[1]}; ka[ks][1] = (f32x2){a[2], a[3]}; ka[ks][2] = (f32x2){b[0], b[1]}; ka[ks][3] = (f32x2){b[2], b[3]}; }
                if (HASV) { const f32x4 a = *(const LAS f32x4*)(LKD + o), b = *(const LAS f32x4*)(LKD + o + 4); kd[ks][0] = (f32x2){a[0], a[1]}; kd[ks][1] = (f32x2){a[2], a[3]}; kd[ks][2] = (f32x2){b[0], b[1]}; kd[ks][3] = (f32x2){b[2], b[3]}; }
                af[ks] = *(const LAS bf16x8*)(((HASY && (nl & 1)) ? LWR : LNK) + o); }
#pragma unroll
            for (int tn = 0; tn < 4; ++tn) v[tn] = HASV ? LV[s * 64 + 16 * tn + nl] : 0.f;
            f32x4 d[4];
#pragma unroll
            for (int tn = 0; tn < 4; ++tn) { d[tn] = (f32x4){0.f, 0.f, 0.f, 0.f};
#pragma unroll
                for (int ks = 0; ks < 2; ++ks) { const u32x4 bw = (u32x4){cvt2(S[tn][ks][0]), cvt2(S[tn][ks][1]), cvt2(S[tn][ks][2]), cvt2(S[tn][ks][3])};
                    d[tn] = __builtin_amdgcn_mfma_f32_16x16x32_bf16(af[ks], __builtin_bit_cast(bf16x8, bw), d[tn], 0, 0, 0); } }
            f32x2 sv[4];
#pragma unroll
            for (int tn = 0; tn < 4; ++tn) sv[tn] = (f32x2){d[tn][0] * one, v[tn]};
#pragma unroll
            for (int jp = 0; jp < 4; ++jp)
                pk_upd8m<HASV>(S[0][0][jp], S[0][1][jp], S[1][0][jp], S[1][1][jp], S[2][0][jp], S[2][1][jp], S[3][0][jp], S[3][1][jp], sv, w[0][jp], w[1][jp], ka[0][jp], ka[1][jp], kd[0][jp], kd[1][jp]);
            if (HASY) { const float c1 = LC[s * 2], c2 = HASV ? LC[s * 2 + 1] : 0.f;
#pragma unroll
                for (int tn = 0; tn < 4; ++tn) { const float y = d[tn][1] + sv[tn][0] * c1 + v[tn] * c2; if (q == 0) Ys[s * 64 + 16 * tn + nl] = y; } }
        }
        if (HASY) {
            const f32x4 a = *(const LAS f32x4*)(Ys + vi * 64 + ki * 8), b = *(const LAS f32x4*)(Ys + vi * 64 + ki * 8 + 4);
            const int g = J.g0 + (mc * WNS + vi) * J.gstep;
            *(u32x4*)(J.Y + (size_t)g * J.ypitch + ch8) = (u32x4){pk2(a[0], a[1]), pk2(a[2], a[3]), pk2(b[0], b[1]), pk2(b[2], b[3])};
        }
        if (mc + 1 < 256 / WNS) WKV_CONVERT();
    }
    if (J.Sout) {
#pragma unroll
        for (int tn = 0; tn < 4; ++tn)
#pragma unroll
            for (int ks = 0; ks < 2; ++ks) { float* dp = J.Sout + (16 * tn + nl) * 64 + 32 * ks + 8 * q;
                *(float4*)dp = make_float4(S[tn][ks][0][0], S[tn][ks][0][1], S[tn][ks][1][0], S[tn][ks][1][1]); *(float4*)(dp + 4) = make_float4(S[tn][ks][2][0], S[tn][ks][2][1], S[tn][ks][3][0], S[tn][ks][3][1]); }
    }
#undef WKV_FETCH
#undef WKV_CONVERT
}
#ifndef WKV_MFMA
#define WKV_MFMA 1
#endif
#if WKV_MFMA
#define WKV_UNIT wkv_unit_m
#else
#define WKV_UNIT wkv_unit
#endif

__device__ __forceinline__ void p7_job_sample(WkvJob& J, float* PQ, int uq, int pq) {
    const int h = uq & 15, dir = (uq >> 4) & 1, chunk = (uq >> 5) & 15, b = uq >> 9;
    const int tt0 = chunk * 256, t0 = dir ? SSEQ - 1 - tt0 : tt0;
    J.sample = true; J.h = h; J.dir = dir; J.g0 = NPTOK + b * SSEQ + t0; J.gstep = dir ? -1 : 1; J.S0 = nullptr; J.Y = nullptr; J.ypitch = 0;
    const int chain = (b * 2 + dir) * 16 + h;
    J.Sout = PQ + ((size_t)(chain * 16 + chunk) * 2 + pq) * 4096;
}
__device__ __forceinline__ void p7_wkv_pass1(Frame& F) {
    float* PQ = (float*)(F.ws + WS_PQ); float* nsw = F.out + (size_t)2 * NPTOK * D + 32 * 2 * LRUW;
    bf16_t* MIX = (bf16_t*)(F.ws + WS_H); bf16_t* YB = (bf16_t*)(F.ws + WS_YB); bf16_t* PRB = (bf16_t*)(F.ws + WS_PRB);
    const int kindQ = (F.wave ^ (F.wave >> 2)) & 1;
    for (int bb = blockIdx.x; bb < 256; bb += F.G) { const int uq = bb * 4 + (F.wave & 3); WkvJob J;
        if (!kindQ) { const int h = uq & 15, dir = (uq >> 4) & 1, b = uq >> 5;
            J.sample = false; J.h = h; J.dir = dir; J.g0 = b * PSEQ + (dir ? PSEQ - 1 : 0); J.gstep = dir ? -1 : 1; J.S0 = nullptr;
            J.Sout = nsw + (size_t)((b * 2 + dir) * 16 + h) * 4096; }
        else p7_job_sample(J, PQ, uq, 1);
        J.Y = J.dir ? YB : MIX + 1024; J.ypitch = J.dir ? RW : D;
        wkv_unit_m<0, false>(F, J); }
    if (F.wave < 4) {
        for (int bb = blockIdx.x; bb < 256; bb += F.G) { WkvJob J; p7_job_sample(J, PQ, bb * 4 + F.wave, 0);
            J.Y = PRB + (ptrdiff_t)J.dir * RW - (ptrdiff_t)NPTOK * 2 * RW; J.ypitch = 2 * RW;
            wkv_unit_m<3, false>(F, J); }
    } else {
        xpose_deferred(F, false, blockIdx.x * 4 + (F.wave - 4), F.G * 4, (LAS bf16_t*)(F.lds + F.wave * WKM_LDS_PER_WAVE));
    }
}
__device__ __forceinline__ void p8_wkv_combine(Frame& F) {
    float* PQ = (float*)(F.ws + WS_PQ);
    LAS float* Sl = (LAS float*)F.lds; LAS float* Pl = (LAS float*)(F.lds + 16384);
    const int tid = F.tid, v = tid >> 3, kq = tid & 7;
    for (int chain = blockIdx.x; chain < 64; chain += F.G) {
        const float* s0 = F.in[IN_SWKV] + (size_t)chain * 4096;
        __syncthreads();
        { const float4 a = *(const float4*)(s0 + tid * 8), b = *(const float4*)(s0 + tid * 8 + 4);
          *(LAS f32x4*)(Sl + tid * 8) = (f32x4){a.x, a.y, a.z, a.w}; *(LAS f32x4*)(Sl + tid * 8 + 4) = (f32x4){b.x, b.y, b.z, b.w}; }
        const float* P0 = PQ + ((size_t)(chain * 16) * 2 + 0) * 4096; const float* Q0 = PQ + ((size_t)(chain * 16) * 2 + 1) * 4096;
        float4 pa = *(const float4*)(P0 + tid * 8), pb = *(const float4*)(P0 + tid * 8 + 4), qa = *(const float4*)(Q0 + v * 64 + kq * 8), qb = *(const float4*)(Q0 + v * 64 + kq * 8 + 4);
        for (int c = 0; c < 15; ++c) {
            float* Qc = PQ + ((size_t)(chain * 16 + c) * 2 + 1) * 4096;
            *(LAS f32x4*)(Pl + tid * 8) = (f32x4){pa.x, pa.y, pa.z, pa.w}; *(LAS f32x4*)(Pl + tid * 8 + 4) = (f32x4){pb.x, pb.y, pb.z, pb.w};
            float acc[8] = {qa.x, qa.y, qa.z, qa.w, qb.x, qb.y, qb.z, qb.w};
            if (c + 1 < 15) { const float* Pn = PQ + ((size_t)(chain * 16 + c + 1) * 2 + 0) * 4096; const float* Qn = Pn + 4096;
                pa = *(const float4*)(Pn + tid * 8); pb = *(const float4*)(Pn + tid * 8 + 4); qa = *(const float4*)(Qn + v * 64 + kq * 8); qb = *(const float4*)(Qn + v * 64 + kq * 8 + 4); }
            __syncthreads();
#pragma unroll 8
            for (int k = 0; k < 64; ++k) { const float s = Sl[v * 64 + k]; const f32x4 p0 = *(const LAS f32x4*)(Pl + k * 64 + kq * 8), p1 = *(const LAS f32x4*)(Pl + k * 64 + kq * 8 + 4);
                acc[0] += s * p0[0]; acc[1] += s * p0[1]; acc[2] += s * p0[2]; acc[3] += s * p0[3]; acc[4] += s * p1[0]; acc[5] += s * p1[1]; acc[6] += s * p1[2]; acc[7] += s * p1[3]; }
            __syncthreads();
            *(LAS f32x4*)(Sl + v * 64 + kq * 8) = (f32x4){acc[0], acc[1], acc[2], acc[3]}; *(LAS f32x4*)(Sl + v * 64 + kq * 8 + 4) = (f32x4){acc[4], acc[5], acc[6], acc[7]};
            *(float4*)(Qc + v * 64 + kq * 8) = make_float4(acc[0], acc[1], acc[2], acc[3]); *(float4*)(Qc + v * 64 + kq * 8 + 4) = make_float4(acc[4], acc[5], acc[6], acc[7]);
        }
    }
}
__device__ __forceinline__ void p9_wkv_pass3(Frame& F) {
    float* PQ = (float*)(F.ws + WS_PQ); bf16_t* MIX = (bf16_t*)(F.ws + WS_H); bf16_t* YB = (bf16_t*)(F.ws + WS_YB); const bf16_t* PRB = (const bf16_t*)(F.ws + WS_PRB);
    const int nl = F.lane & 15, q = F.lane >> 4;
    for (int u = blockIdx.x * 8 + F.wave; u < 1024; u += F.G * 8) {
        const int h = u & 15, dir = (u >> 4) & 1, chunk = (u >> 5) & 15, b = u >> 9;
        const int tt0 = chunk * 256, t0 = dir ? SSEQ - 1 - tt0 : tt0, chain = (b * 2 + dir) * 16 + h, gstep = dir ? -1 : 1, g0 = NPTOK + b * SSEQ + t0;
        const float* Sc = chunk == 0 ? F.in[IN_SWKV] + (size_t)chain * 4096 : PQ + ((size_t)(chain * 16 + chunk - 1) * 2 + 1) * 4096;
        bf16_t* Y = dir ? YB : MIX + 1024; const int ypitch = dir ? RW : D;
        bf16x8 a[4][2];
#pragma unroll
        for (int mt = 0; mt < 4; ++mt)
#pragma unroll
            for (int ks = 0; ks < 2; ++ks) { float t[8]; ld8(Sc + (16 * mt + nl) * 64 + 32 * ks + 8 * q, t);
                const u32x4 w = (u32x4){pk2(t[0], t[1]), pk2(t[2], t[3]), pk2(t[4], t[5]), pk2(t[6], t[7])}; a[mt][ks] = __builtin_bit_cast(bf16x8, w); }
#pragma unroll 2
        for (int nt = 0; nt < 16; ++nt) { const int g = g0 + (16 * nt + nl) * gstep;
            const bf16_t* pr = PRB + ((size_t)(g - NPTOK) * 2 + dir) * RW + h * 64 + 8 * q;
            const bf16x8 b0 = *(const bf16x8*)pr, b1 = *(const bf16x8*)(pr + 32);
            bf16_t* yp = Y + (size_t)g * ypitch + h * 64 + 4 * q;
#pragma unroll
            for (int mt = 0; mt < 4; ++mt) { f32x4 d = (f32x4){0.f, 0.f, 0.f, 0.f};
                d = __builtin_amdgcn_mfma_f32_16x16x32_bf16(a[mt][0], b0, d, 0, 0, 0); d = __builtin_amdgcn_mfma_f32_16x16x32_bf16(a[mt][1], b1, d, 0, 0, 0);
                const u32x2 yq = *(const u32x2*)(yp + 16 * mt);
                *(u32x2*)(yp + 16 * mt) = (u32x2){pk2(bflo(yq[0]) + d[0], bfhi(yq[0]) + d[1]), pk2(bflo(yq[1]) + d[2], bfhi(yq[1]) + d[3])}; } }
    }
}

__device__ __forceinline__ void p10_wkv_finish(Frame& F) {
    bf16_t* MIX = (bf16_t*)(F.ws + WS_H);
    const bf16_t* YB = (const bf16_t*)(F.ws + WS_YB); const bf16_t* Gt = (const bf16_t*)(F.ws + WS_G);
    const float* lnw = F.in[IN_LNW]; const float* lnb = F.in[IN_LNB];
    const int t8 = F.lane >> 3, cg8 = (F.lane & 7) * 8;
    for (int gb = (blockIdx.x * 8 + F.wave) * 8; gb < NTOK; gb += F.G * 64) {
        const int g = gb + t8;
#pragma unroll 4
        for (int h = 0; h < NH; ++h) { const int ch8 = h * 64 + cg8;
            const u32x4 yfw = *(const u32x4*)(MIX + (size_t)g * D + 1024 + ch8), ybw = *(const u32x4*)(YB + (size_t)g * RW + ch8), gw = *(const u32x4*)(Gt + (size_t)g * RW + ch8);
            float a[8], b[8], m[8], y[8];
            unpack8(yfw, a); unpack8(ybw, b); float sm = 0.f;
#pragma unroll
            for (int i = 0; i < 8; ++i) { y[i] = a[i] + b[i]; sm += y[i]; }
            const float mean = red8(sm) * (1.f / 64.f); float sq = 0.f;
#pragma unroll
            for (int i = 0; i < 8; ++i) { y[i] -= mean; sq += y[i] * y[i]; }
            const float rstd = rsqrtf(red8(sq) * (1.f / 64.f) + 64e-5f);
            ld8(lnw + ch8, a); ld8(lnb + ch8, b); unpack8(gw, m);
#pragma unroll
            for (int i = 0; i < 8; ++i) y[i] = (y[i] * rstd * a[i] + b[i]) * m[i];
            *(u32x4*)(MIX + (size_t)g * D + 1024 + ch8) = (u32x4){pk2(y[0], y[1]), pk2(y[2], y[3]), pk2(y[4], y[5]), pk2(y[6], y[7])}; }
    }
    xpose_deferred(F, true, blockIdx.x * 8 + F.wave, F.G * 8, (LAS bf16_t*)(F.lds + F.wave * 8704));
}

__device__ __forceinline__ void p12_rows(Frame& F) {
    const float* MOD = (const float*)(F.ws + WS_MOD); const bf16_t* OUTB = (const bf16_t*)(F.ws + WS_PROJ); bf16_t* H2 = (bf16_t*)(F.ws + WS_H);
    const float* gpost = F.in[IN_NMPOST]; const float* gpre = F.in[IN_NFPRE];
    for (int row = blockIdx.x * 8 + F.wave; row < NTOK; row += F.G * 8) {
        const float* xr = row < NPTOK ? F.in[IN_XP] + (size_t)row * D : F.in[IN_XS] + (size_t)(row - NPTOK) * D;
        const float* md = MOD + modidx(row) * 12288;
        float4 o[8], x[8]; float ss = 0.f;
#pragma unroll
        for (int i = 0; i < 8; ++i) { const int col = (i * 64 + F.lane) * 4; const u32x2 w = *(const u32x2*)(OUTB + (size_t)row * D + col); x[i] = *(const float4*)(xr + col);
            o[i] = make_float4(bflo(w[0]), bfhi(w[0]), bflo(w[1]), bfhi(w[1])); ss += o[i].x * o[i].x + o[i].y * o[i].y + o[i].z * o[i].z + o[i].w * o[i].w; }
        ss = wave_sum(ss);
        const float rstd = rsqrtf(ss * (1.f / D) + 1e-6f);
        float ss2 = 0.f;
#pragma unroll
        for (int i = 0; i < 8; ++i) { const int col = (i * 64 + F.lane) * 4;
            const float4 gp = *(const float4*)(gpost + col), gm = *(const float4*)(md + 2 * D + col);
            float4 r;
            r.x = x[i].x + gm.x * (o[i].x * rstd * gp.x); r.y = x[i].y + gm.y * (o[i].y * rstd * gp.y);
            r.z = x[i].z + gm.z * (o[i].z * rstd * gp.z); r.w = x[i].w + gm.w * (o[i].w * rstd * gp.w);
            *(float4*)(F.out + (size_t)row * D + col) = r; o[i] = r;
            ss2 += r.x * r.x + r.y * r.y + r.z * r.z + r.w * r.w; }
        ss2 = wave_sum(ss2);
        const float rstd2 = rsqrtf(ss2 * (1.f / D) + 1e-6f);
#pragma unroll
        for (int i = 0; i < 8; ++i) { const int col = (i * 64 + F.lane) * 4;
            const float4 g = *(const float4*)(gpre + col), sc = *(const float4*)(md + 4 * D + col), sh = *(const float4*)(md + 3 * D + col);
            const float h0 = o[i].x * rstd2 * g.x * (1.f + sc.x) + sh.x, h1 = o[i].y * rstd2 * g.y * (1.f + sc.y) + sh.y;
            const float h2 = o[i].z * rstd2 * g.z * (1.f + sc.z) + sh.z, h3 = o[i].w * rstd2 * g.w * (1.f + sc.w) + sh.w;
            *(u32x2*)(H2 + (size_t)row * D + col) = (u32x2){pk2(h0, h1), pk2(h2, h3)}; }
    }
}
__device__ __forceinline__ void p15_rows(Frame& F) {
    const float* MOD = (const float*)(F.ws + WS_MOD); const bf16_t* Fb = (const bf16_t*)(F.ws + WS_H); const float* gpost = F.in[IN_NFPOST];
    for (int row = blockIdx.x * 8 + F.wave; row < NTOK; row += F.G * 8) {
        const float* md = MOD + modidx(row) * 12288;
        float4 o[8], x[8]; float ss = 0.f;
#pragma unroll
        for (int i = 0; i < 8; ++i) { const int col = (i * 64 + F.lane) * 4; const u32x2 w = *(const u32x2*)(Fb + (size_t)row * D + col); x[i] = *(const float4*)(F.out + (size_t)row * D + col);
            o[i] = make_float4(bflo(w[0]), bfhi(w[0]), bflo(w[1]), bfhi(w[1])); ss += o[i].x * o[i].x + o[i].y * o[i].y + o[i].z * o[i].z + o[i].w * o[i].w; }
        ss = wave_sum(ss);
        const float rstd = rsqrtf(ss * (1.f / D) + 1e-6f);
#pragma unroll
        for (int i = 0; i < 8; ++i) { const int col = (i * 64 + F.lane) * 4;
            const float4 gp = *(const float4*)(gpost + col), gf = *(const float4*)(md + 5 * D + col);
            float4 r;
            r.x = x[i].x + gf.x * (o[i].x * rstd * gp.x); r.y = x[i].y + gf.y * (o[i].y * rstd * gp.y);
            r.z = x[i].z + gf.z * (o[i].z * rstd * gp.z); r.w = x[i].w + gf.w * (o[i].w * rstd * gp.w);
            *(float4*)(F.out + (size_t)row * D + col) = r; }
    }
}

constexpr int LDS_MISC = 131072, LDS_BYTES = 131072 + 256;
__global__ void __launch_bounds__(512, 2) fwd_kernel(Args args) {
    extern __shared__ __attribute__((aligned(16))) unsigned char lds_raw[];
    Frame F;
    F.lds = (LAS unsigned char*)lds_raw;
    F.tid = threadIdx.x; F.lane = F.tid & 63; F.wave = __builtin_amdgcn_readfirstlane(F.tid >> 6); F.G = gridDim.x;
    F.in = args.in; F.out = args.out; F.ws = args.ws;
    volatile LAS unsigned* MISC = (volatile LAS unsigned*)(F.lds + LDS_MISC);
    const int lo = args.ph_lo, hi = args.ph_hi;
    const bool fused = (hi - lo) > 1;
    if (F.tid < 64) MISC[F.tid] = 0u;
    __syncthreads();
    XcdBarrier bar; bar.bar = (unsigned*)(F.ws + WS_CTL); bar.x = 0; bar.st = MISC;
    if (fused) bar = xcd_barrier_post((unsigned*)(F.ws + WS_CTL), MISC);
#ifndef PH_MASK
#define PH_MASK 0xFFFF
#endif
#define IN(k) (((PH_MASK >> (k)) & 1) && lo <= (k) && (k) < hi)
#define SEAM(k) do { if (IN(k) && IN((k) + 1)) { if (MK_CG_FIRST && (k) == 8) { cg::this_grid().sync(); } else xcd_barrier(bar); } } while (0)
    unsigned char* ws = F.ws;
#ifndef REP_MASK
#define REP_MASK 0
#endif
#define NREP(k) ((((REP_MASK) >> (k)) & 1) ? 2 : 1)
#define FRESH() asm volatile("" : "+v"(F.tid), "+v"(F.lane))
#define RUN(k, ...) do { if (IN(k)) { for (int _rep = 0; _rep < NREP(k); ++_rep) { if (_rep) xcd_barrier(bar); FRESH(); __VA_ARGS__; } } } while (0)
    RUN(0, p0_prologue(F));
    SEAM(0);
    RUN(1, p1_normmod(F));
    SEAM(1);
    RUN(2, { pg8::Gemm g{(const bf16_t*)(ws + WS_H), (const bf16_t*)(ws + WS_WTIN), D, D, D, 0}; pg8::StaticOrder S; S.init(NTOK, INWP, F.G, blockIdx.x);
        pg8::EpiBf16 E{(bf16_t*)(ws + WS_PROJ), INWP}; pg8::gemm_phase(F.lds, g, S, E); });
    SEAM(2);
    RUN(3, p3_elem(F));
    SEAM(3);
    RUN(4, { pg8::Gemm g{(const bf16_t*)(ws + WS_XC), (const bf16_t*)(ws + WS_BTLRU), LRUW, 256, 256, 1}; pg8::StaticOrder S; S.init(NTOK, 4096, F.G, blockIdx.x);
        pg8::EpiLru E{(unsigned*)F.out, (const bf16_t*)(ws + WS_XC), F.in[IN_BR], F.in[IN_BI], (const float*)(ws + WS_NL8)}; pg8::gemm_phase(F.lds, g, S, E); });
    SEAM(4);
    RUN(5, p5_lru_scan(F));
    SEAM(5);
    RUN(6, { pg8::Gemm g{(const bf16_t*)(ws + WS_LA), (const bf16_t*)(ws + WS_BTLORA), LAK, 256, 256, 2}; pg8::StaticOrder S; S.init(NTOK, 5120, F.G, blockIdx.x);
        pg8::EpiLora E{(bf16_t*)F.out, (bf16_t*)F.out + (size_t)NTOK * 2 * RW, (bf16_t*)(ws + WS_G), F.in[IN_W0], F.in[IN_A0]}; pg8::gemm_phase(F.lds, g, S, E); });
    SEAM(6);
    for (int _r78 = 0; _r78 < NREP(7); ++_r78) {
        if (_r78) xcd_barrier(bar);
        if (IN(7)) { FRESH(); p7_wkv_pass1(F); }
        SEAM(7);
        if (IN(8)) { FRESH(); p8_wkv_combine(F); }
    }
    SEAM(8);
    RUN(9, p9_wkv_pass3(F));
    SEAM(9);
    if (IN(10)) { FRESH(); p10_wkv_finish(F); }
    SEAM(10);
    RUN(11, { pg8::Gemm g{(const bf16_t*)(ws + WS_H), (const bf16_t*)(ws + WS_WTOUT), D, D, D, 0}; pg8::StaticOrder S; S.init(NTOK, D, F.G, blockIdx.x);
        pg8::EpiBf16 E{(bf16_t*)(ws + WS_PROJ), D}; pg8::gemm_phase(F.lds, g, S, E); });
    SEAM(11);
    RUN(12, p12_rows(F));
    SEAM(12);
    RUN(13, { pg8::Gemm g{(const bf16_t*)(ws + WS_H), (const bf16_t*)(ws + WS_WTGU), D, D, D, 0}; pg8::StaticOrder S; S.init(NTOK, 2 * FFH, F.G, blockIdx.x);
        pg8::EpiGu E{(bf16_t*)(ws + WS_PROJ)}; pg8::gemm_phase(F.lds, g, S, E); });
    SEAM(13);
    RUN(14, { pg8::Gemm g{(const bf16_t*)(ws + WS_PROJ), (const bf16_t*)(ws + WS_WTDN), FFH, FFH, FFH, 0}; pg8::StaticOrder S; S.init(NTOK, D, F.G, blockIdx.x);
        pg8::EpiBf16 E{(bf16_t*)(ws + WS_H), D}; pg8::gemm_phase(F.lds, g, S, E); });
    SEAM(14);
    if (IN(15)) { FRESH(); p15_rows(F); }
#undef IN
#undef SEAM
}

extern "C" void kernel_launch(void* const* d_in, const int* in_sizes, int n_in, void* d_out, int out_size, void* d_ws, size_t ws_size, hipStream_t stream) {
    static int grid = 0;
    if (grid == 0) {
        if (n_in != 34 || ws_size < WS_END) { fprintf(stderr, "kernel_launch: need 34 inputs and >= %zu bytes of workspace; got %d, %zu\n", (size_t)WS_END, n_in, ws_size); grid = -1; return; }
        int dev = 0, cus = 0, per_cu = 0;
        if (hipGetDevice(&dev) != hipSuccess || hipDeviceGetAttribute(&cus, hipDeviceAttributeMultiprocessorCount, dev) != hipSuccess) { grid = -1; return; }
        if (hipFuncSetAttribute((const void*)fwd_kernel, hipFuncAttributeMaxDynamicSharedMemorySize, LDS_BYTES) != hipSuccess) { fprintf(stderr, "kernel_launch: hipFuncSetAttribute failed\n"); grid = -1; return; }
        if (hipOccupancyMaxActiveBlocksPerMultiprocessor(&per_cu, (const void*)fwd_kernel, 512, LDS_BYTES) != hipSuccess || per_cu < 1) { fprintf(stderr, "kernel_launch: occupancy query says %d\n", per_cu); per_cu = 1; }
        (void)hipGetLastError();
        grid = cus;
    }
    if (grid < 0) return;
    (void)hipMemsetAsync((char*)d_ws + WS_CTL, 0, 64 * 1024, stream);
    Args a{};
    for (int i = 0; i < 34; ++i) a.in[i] = (const float*)d_in[i];
    a.out = (float*)d_out; a.ws = (unsigned char*)d_ws;
#if MK_ONE_LAUNCH
    a.ph_lo = 0; a.ph_hi = NPHASE;
    void* kargs[] = {&a};
    hipError_t e = hipLaunchCooperativeKernel((const void*)fwd_kernel, dim3(grid), dim3(512), kargs, LDS_BYTES, stream);
    if (e != hipSuccess) fprintf(stderr, "cooperative launch failed: %s (grid %d)\n", hipGetErrorString(e), grid);
#else
    for (int p = 0; p < NPHASE; ++p) { a.ph_lo = p; a.ph_hi = p + 1; hipLaunchKernelGGL(fwd_kernel, dim3(grid), dim3(512), LDS_BYTES, stream, a); }
#endif
}
```

```cpp
#include <hip/hip_runtime.h>
#include <hip/hip_cooperative_groups.h>
#include <cstdio>
namespace cg = cooperative_groups;

#ifndef MK_ONE_LAUNCH
#define MK_ONE_LAUNCH 1
#endif
#ifndef MK_CG_FIRST
#define MK_CG_FIRST 1
#endif

#define LAS __attribute__((address_space(3)))
typedef unsigned short bf16_t;
typedef short bf16x8 __attribute__((ext_vector_type(8)));
typedef float f32x4 __attribute__((ext_vector_type(4)));
typedef unsigned u32x4 __attribute__((ext_vector_type(4)));
typedef unsigned u32x2 __attribute__((ext_vector_type(2)));

constexpr int D = 2048, NTOK = 16384, NPTOK = 8192, PSEQ = 256, SSEQ = 4096;
constexpr int LRUW = 1024, RW = 1024, NH = 16, RIN = 3360, INW = 5408, INWP = 5632, FFH = 5632;
constexpr int LAK = 384;
constexpr int NPHASE = 16;

constexpr size_t MiB = 1024 * 1024;
constexpr size_t WS_CTL = 0;
constexpr size_t WS_MOD = 64 * 1024;
constexpr size_t WS_NL8 = 256 * 1024;
constexpr size_t WS_BTLRU = 1 * MiB;
constexpr size_t WS_BTLORA = 3 * MiB;
constexpr size_t WS_WTOUT = 7 * MiB;
constexpr size_t WS_WTGU = 15 * MiB;
constexpr size_t WS_WTDN = 59 * MiB;
constexpr size_t WS_H = 81 * MiB;
constexpr size_t WS_PROJ = 145 * MiB;
constexpr size_t WS_S = 321 * MiB;
constexpr size_t WS_WTIN = WS_S;
constexpr size_t WS_XC = WS_S;
constexpr size_t WS_G = WS_S;
constexpr size_t WS_LA = WS_S + 32 * MiB;
constexpr size_t WS_YB = WS_S + 32 * MiB;
constexpr size_t WS_PQ = WS_S + 64 * MiB;
constexpr size_t WS_END = WS_S + 96 * MiB;
constexpr size_t WS_PRB = WS_WTOUT;

__device__ __forceinline__ float bf2f(unsigned b) { return __uint_as_float(b << 16); }
__device__ __forceinline__ float bflo(unsigned w) { return __uint_as_float(w << 16); }
__device__ __forceinline__ float bfhi(unsigned w) { return __uint_as_float(w & 0xffff0000u); }
__device__ __forceinline__ unsigned pk2(float lo, float hi) { unsigned r; asm("v_cvt_pk_bf16_f32 %0, %1, %2" : "=v"(r) : "v"(lo), "v"(hi)); return r; }
__device__ __forceinline__ unsigned f2bf(float f) { return pk2(f, 0.f) & 0xffffu; }
__device__ __forceinline__ void unpack8(const u32x4 w, float (&o)[8]) { o[0] = bflo(w[0]); o[1] = bfhi(w[0]); o[2] = bflo(w[1]); o[3] = bfhi(w[1]); o[4] = bflo(w[2]); o[5] = bfhi(w[2]); o[6] = bflo(w[3]); o[7] = bfhi(w[3]); }
__device__ __forceinline__ void lds_st8(LAS float* p, const float (&v)[8]) { *(LAS f32x4*)p = (f32x4){v[0], v[1], v[2], v[3]}; *(LAS f32x4*)(p + 4) = (f32x4){v[4], v[5], v[6], v[7]}; }
__device__ __forceinline__ void ld8(const float* p, float (&v)[8]) { const float4 a = *(const float4*)p, b = *(const float4*)(p + 4); v[0] = a.x; v[1] = a.y; v[2] = a.z; v[3] = a.w; v[4] = b.x; v[5] = b.y; v[6] = b.z; v[7] = b.w; }
__device__ __forceinline__ float sigmoidf_(float x) { return __builtin_amdgcn_rcpf(1.f + __expf(-x)); }
__device__ __forceinline__ float gelu_tanh(float x) { const float u = 0.7978845608028654f * (x + 0.044715f * x * x * x); return 0.5f * x * (1.f + tanhf(u)); }
template <int CTRL> __device__ __forceinline__ float dpp_f(float x) { return __builtin_bit_cast(float, __builtin_amdgcn_update_dpp(0, __builtin_bit_cast(int, x), CTRL, 0xf, 0xf, true)); }
__device__ __forceinline__ float red8(float x) { x += dpp_f<0xB1>(x); x += dpp_f<0x4E>(x); x += dpp_f<0x141>(x); return x; }
__device__ __forceinline__ float wave_sum(float x) { x = red8(x); x += dpp_f<0x140>(x); x += __shfl_xor(x, 16); x += __shfl_xor(x, 32); return x; }

__device__ __forceinline__ float vfma(float a, float b, float c) { float d; asm("v_fma_f32 %0, %1, %2, %3" : "=v"(d) : "v"(a), "v"(b), "v"(c)); return d; }
__device__ __forceinline__ float vadd(float a, float b) { float d; asm("v_add_f32 %0, %1, %2" : "=v"(d) : "v"(a), "v"(b)); return d; }
__device__ __forceinline__ float vmul(float a, float b) { float d; asm("v_mul_f32 %0, %1, %2" : "=v"(d) : "v"(a), "v"(b)); return d; }
__device__ __forceinline__ void red8x8(float (&x)[8]) {
    asm volatile(
        "s_nop 1\n\t"
        "v_add_f32_dpp %0, %0, %0 quad_perm:[1,0,3,2] row_mask:0xf bank_mask:0xf bound_ctrl:1\n\t"
        "v_add_f32_dpp %1, %1, %1 quad_perm:[1,0,3,2] row_mask:0xf bank_mask:0xf bound_ctrl:1\n\t"
        "v_add_f32_dpp %2, %2, %2 quad_perm:[1,0,3,2] row_mask:0xf bank_mask:0xf bound_ctrl:1\n\t"
        "v_add_f32_dpp %3, %3, %3 quad_perm:[1,0,3,2] row_mask:0xf bank_mask:0xf bound_ctrl:1\n\t"
        "v_add_f32_dpp %4, %4, %4 quad_perm:[1,0,3,2] row_mask:0xf bank_mask:0xf bound_ctrl:1\n\t"
        "v_add_f32_dpp %5, %5, %5 quad_perm:[1,0,3,2] row_mask:0xf bank_mask:0xf bound_ctrl:1\n\t"
        "v_add_f32_dpp %6, %6, %6 quad_perm:[1,0,3,2] row_mask:0xf bank_mask:0xf bound_ctrl:1\n\t"
        "v_add_f32_dpp %7, %7, %7 quad_perm:[1,0,3,2] row_mask:0xf bank_mask:0xf bound_ctrl:1\n\t"
        "v_add_f32_dpp %0, %0, %0 quad_perm:[2,3,0,1] row_mask:0xf bank_mask:0xf bound_ctrl:1\n\t"
        "v_add_f32_dpp %1, %1, %1 quad_perm:[2,3,0,1] row_mask:0xf bank_mask:0xf bound_ctrl:1\n\t"
        "v_add_f32_dpp %2, %2, %2 quad_perm:[2,3,0,1] row_mask:0xf bank_mask:0xf bound_ctrl:1\n\t"
        "v_add_f32_dpp %3, %3, %3 quad_perm:[2,3,0,1] row_mask:0xf bank_mask:0xf bound_ctrl:1\n\t"
        "v_add_f32_dpp %4, %4, %4 quad_perm:[2,3,0,1] row_mask:0xf bank_mask:0xf bound_ctrl:1\n\t"
        "v_add_f32_dpp %5, %5, %5 quad_perm:[2,3,0,1] row_mask:0xf bank_mask:0xf bound_ctrl:1\n\t"
        "v_add_f32_dpp %6, %6, %6 quad_perm:[2,3,0,1] row_mask:0xf bank_mask:0xf bound_ctrl:1\n\t"
        "v_add_f32_dpp %7, %7, %7 quad_perm:[2,3,0,1] row_mask:0xf bank_mask:0xf bound_ctrl:1\n\t"
        "v_add_f32_dpp %0, %0, %0 row_half_mirror row_mask:0xf bank_mask:0xf bound_ctrl:1\n\t"
        "v_add_f32_dpp %1, %1, %1 row_half_mirror row_mask:0xf bank_mask:0xf bound_ctrl:1\n\t"
        "v_add_f32_dpp %2, %2, %2 row_half_mirror row_mask:0xf bank_mask:0xf bound_ctrl:1\n\t"
        "v_add_f32_dpp %3, %3, %3 row_half_mirror row_mask:0xf bank_mask:0xf bound_ctrl:1\n\t"
        "v_add_f32_dpp %4, %4, %4 row_half_mirror row_mask:0xf bank_mask:0xf bound_ctrl:1\n\t"
        "v_add_f32_dpp %5, %5, %5 row_half_mirror row_mask:0xf bank_mask:0xf bound_ctrl:1\n\t"
        "v_add_f32_dpp %6, %6, %6 row_half_mirror row_mask:0xf bank_mask:0xf bound_ctrl:1\n\t"
        "v_add_f32_dpp %7, %7, %7 row_half_mirror row_mask:0xf bank_mask:0xf bound_ctrl:1\n\t"
        "s_nop 1"
        : "+v"(x[0]), "+v"(x[1]), "+v"(x[2]), "+v"(x[3]), "+v"(x[4]), "+v"(x[5]), "+v"(x[6]), "+v"(x[7]));
}

#define A8(op) op " %0, %8, %16\n\t" op " %1, %9, %16\n\t" op " %2, %10, %16\n\t" op " %3, %11, %16\n\t" op " %4, %12, %16\n\t" op " %5, %13, %16\n\t" op " %6, %14, %16\n\t" op " %7, %15, %16"
__device__ __forceinline__ void col_mul8(float (&acc)[8], float s0, float s1, float s2, float s3, float s4, float s5, float s6, float s7, float k) {
    asm(A8("v_mul_f32") : "=&v"(acc[0]), "=&v"(acc[1]), "=&v"(acc[2]), "=&v"(acc[3]), "=&v"(acc[4]), "=&v"(acc[5]), "=&v"(acc[6]), "=&v"(acc[7])
        : "v"(s0), "v"(s1), "v"(s2), "v"(s3), "v"(s4), "v"(s5), "v"(s6), "v"(s7), "v"(k));
}
__device__ __forceinline__ void col_mac8(float (&acc)[8], float s0, float s1, float s2, float s3, float s4, float s5, float s6, float s7, float k) {
    asm(A8("v_fmac_f32") : "+v"(acc[0]), "+v"(acc[1]), "+v"(acc[2]), "+v"(acc[3]), "+v"(acc[4]), "+v"(acc[5]), "+v"(acc[6]), "+v"(acc[7])
        : "v"(s0), "v"(s1), "v"(s2), "v"(s3), "v"(s4), "v"(s5), "v"(s6), "v"(s7), "v"(k));
}
#undef A8
template <bool HASV>
__device__ __forceinline__ void col_upd8(float& s0, float& s1, float& s2, float& s3, float& s4, float& s5, float& s6, float& s7, const float (&sa)[8], const float (&v)[8], float w, float kka, float kd) {
    if (HASV)
        asm("v_mul_f32 %0, %0, %24\n\tv_mul_f32 %1, %1, %24\n\tv_mul_f32 %2, %2, %24\n\tv_mul_f32 %3, %3, %24\n\tv_mul_f32 %4, %4, %24\n\tv_mul_f32 %5, %5, %24\n\tv_mul_f32 %6, %6, %24\n\tv_mul_f32 %7, %7, %24\n\t"
            "v_fmac_f32 %0, %8, %25\n\tv_fmac_f32 %1, %9, %25\n\tv_fmac_f32 %2, %10, %25\n\tv_fmac_f32 %3, %11, %25\n\tv_fmac_f32 %4, %12, %25\n\tv_fmac_f32 %5, %13, %25\n\tv_fmac_f32 %6, %14, %25\n\tv_fmac_f32 %7, %15, %25\n\t"
            "v_fmac_f32 %0, %16, %26\n\tv_fmac_f32 %1, %17, %26\n\tv_fmac_f32 %2, %18, %26\n\tv_fmac_f32 %3, %19, %26\n\tv_fmac_f32 %4, %20, %26\n\tv_fmac_f32 %5, %21, %26\n\tv_fmac_f32 %6, %22, %26\n\tv_fmac_f32 %7, %23, %26"
            : "+v"(s0), "+v"(s1), "+v"(s2), "+v"(s3), "+v"(s4), "+v"(s5), "+v"(s6), "+v"(s7)
            : "v"(sa[0]), "v"(sa[1]), "v"(sa[2]), "v"(sa[3]), "v"(sa[4]), "v"(sa[5]), "v"(sa[6]), "v"(sa[7]),
              "v"(v[0]), "v"(v[1]), "v"(v[2]), "v"(v[3]), "v"(v[4]), "v"(v[5]), "v"(v[6]), "v"(v[7]), "v"(w), "v"(kka), "v"(kd));
    else
        asm("v_mul_f32 %0, %0, %16\n\tv_mul_f32 %1, %1, %16\n\tv_mul_f32 %2, %2, %16\n\tv_mul_f32 %3, %3, %16\n\tv_mul_f32 %4, %4, %16\n\tv_mul_f32 %5, %5, %16\n\tv_mul_f32 %6, %6, %16\n\tv_mul_f32 %7, %7, %16\n\t"
            "v_fmac_f32 %0, %8, %17\n\tv_fmac_f32 %1, %9, %17\n\tv_fmac_f32 %2, %10, %17\n\tv_fmac_f32 %3, %11, %17\n\tv_fmac_f32 %4, %12, %17\n\tv_fmac_f32 %5, %13, %17\n\tv_fmac_f32 %6, %14, %17\n\tv_fmac_f32 %7, %15, %17"
            : "+v"(s0), "+v"(s1), "+v"(s2), "+v"(s3), "+v"(s4), "+v"(s5), "+v"(s6), "+v"(s7)
            : "v"(sa[0]), "v"(sa[1]), "v"(sa[2]), "v"(sa[3]), "v"(sa[4]), "v"(sa[5]), "v"(sa[6]), "v"(sa[7]), "v"(w), "v"(kka));
}

typedef float f32x2 __attribute__((ext_vector_type(2)));
#define PK8(op, tail) op " %0, %8, %16" tail "\n\t" op " %1, %9, %16" tail "\n\t" op " %2, %10, %16" tail "\n\t" op " %3, %11, %16" tail "\n\t" op " %4, %12, %16" tail "\n\t" op " %5, %13, %16" tail "\n\t" op " %6, %14, %16" tail "\n\t" op " %7, %15, %16" tail
__device__ __forceinline__ void pk_mul8(f32x2 (&acc)[8], f32x2 s0, f32x2 s1, f32x2 s2, f32x2 s3, f32x2 s4, f32x2 s5, f32x2 s6, f32x2 s7, f32x2 k) {
    asm(PK8("v_pk_mul_f32", "") : "=&v"(acc[0]), "=&v"(acc[1]), "=&v"(acc[2]), "=&v"(acc[3]), "=&v"(acc[4]), "=&v"(acc[5]), "=&v"(acc[6]), "=&v"(acc[7])
        : "v"(s0), "v"(s1), "v"(s2), "v"(s3), "v"(s4), "v"(s5), "v"(s6), "v"(s7), "v"(k));
}
__device__ __forceinline__ void pk_mac8(f32x2 (&acc)[8], f32x2 s0, f32x2 s1, f32x2 s2, f32x2 s3, f32x2 s4, f32x2 s5, f32x2 s6, f32x2 s7, f32x2 k) {
    asm("v_pk_fma_f32 %0, %8, %16, %0\n\tv_pk_fma_f32 %1, %9, %16, %1\n\tv_pk_fma_f32 %2, %10, %16, %2\n\tv_pk_fma_f32 %3, %11, %16, %3\n\t"
        "v_pk_fma_f32 %4, %12, %16, %4\n\tv_pk_fma_f32 %5, %13, %16, %5\n\tv_pk_fma_f32 %6, %14, %16, %6\n\tv_pk_fma_f32 %7, %15, %16, %7"
        : "+v"(acc[0]), "+v"(acc[1]), "+v"(acc[2]), "+v"(acc[3]), "+v"(acc[4]), "+v"(acc[5]), "+v"(acc[6]), "+v"(acc[7])
        : "v"(s0), "v"(s1), "v"(s2), "v"(s3), "v"(s4), "v"(s5), "v"(s6), "v"(s7), "v"(k));
}
#undef PK8
#define BLO " op_sel:[0,0,0] op_sel_hi:[0,1,1]"
#define BHI " op_sel:[1,0,0] op_sel_hi:[1,1,1]"
template <bool HASV>
__device__ __forceinline__ void pk_upd8(f32x2& s0, f32x2& s1, f32x2& s2, f32x2& s3, f32x2& s4, f32x2& s5, f32x2& s6, f32x2& s7, const f32x2 (&sap)[4], const f32x2 (&vp)[4], f32x2 w, f32x2 kka, f32x2 kd) {
    if (HASV)
        asm("v_pk_mul_f32 %0, %0, %16\n\tv_pk_mul_f32 %1, %1, %16\n\tv_pk_mul_f32 %2, %2, %16\n\tv_pk_mul_f32 %3, %3, %16\n\tv_pk_mul_f32 %4, %4, %16\n\tv_pk_mul_f32 %5, %5, %16\n\tv_pk_mul_f32 %6, %6, %16\n\tv_pk_mul_f32 %7, %7, %16\n\t"
            "v_pk_fma_f32 %0, %8, %17, %0" BLO "\n\tv_pk_fma_f32 %1, %8, %17, %1" BHI "\n\tv_pk_fma_f32 %2, %9, %17, %2" BLO "\n\tv_pk_fma_f32 %3, %9, %17, %3" BHI "\n\t"
            "v_pk_fma_f32 %4, %10, %17, %4" BLO "\n\tv_pk_fma_f32 %5, %10, %17, %5" BHI "\n\tv_pk_fma_f32 %6, %11, %17, %6" BLO "\n\tv_pk_fma_f32 %7, %11, %17, %7" BHI "\n\t"
            "v_pk_fma_f32 %0, %12, %18, %0" BLO "\n\tv_pk_fma_f32 %1, %12, %18, %1" BHI "\n\tv_pk_fma_f32 %2, %13, %18, %2" BLO "\n\tv_pk_fma_f32 %3, %13, %18, %3" BHI "\n\t"
            "v_pk_fma_f32 %4, %14, %18, %4" BLO "\n\tv_pk_fma_f32 %5, %14, %18, %5" BHI "\n\tv_pk_fma_f32 %6, %15, %18, %6" BLO "\n\tv_pk_fma_f32 %7, %15, %18, %7" BHI
            : "+v"(s0), "+v"(s1), "+v"(s2), "+v"(s3), "+v"(s4), "+v"(s5), "+v"(s6), "+v"(s7)
            : "v"(sap[0]), "v"(sap[1]), "v"(sap[2]), "v"(sap[3]), "v"(vp[0]), "v"(vp[1]), "v"(vp[2]), "v"(vp[3]), "v"(w), "v"(kka), "v"(kd));
    else
        asm("v_pk_mul_f32 %0, %0, %12\n\tv_pk_mul_f32 %1, %1, %12\n\tv_pk_mul_f32 %2, %2, %12\n\tv_pk_mul_f32 %3, %3, %12\n\tv_pk_mul_f32 %4, %4, %12\n\tv_pk_mul_f32 %5, %5, %12\n\tv_pk_mul_f32 %6, %6, %12\n\tv_pk_mul_f32 %7, %7, %12\n\t"
            "v_pk_fma_f32 %0, %8, %13, %0" BLO "\n\tv_pk_fma_f32 %1, %8, %13, %1" BHI "\n\tv_pk_fma_f32 %2, %9, %13, %2" BLO "\n\tv_pk_fma_f32 %3, %9, %13, %3" BHI "\n\t"
            "v_pk_fma_f32 %4, %10, %13, %4" BLO "\n\tv_pk_fma_f32 %5, %10, %13, %5" BHI "\n\tv_pk_fma_f32 %6, %11, %13, %6" BLO "\n\tv_pk_fma_f32 %7, %11, %13, %7" BHI
            : "+v"(s0), "+v"(s1), "+v"(s2), "+v"(s3), "+v"(s4), "+v"(s5), "+v"(s6), "+v"(s7)
            : "v"(sap[0]), "v"(sap[1]), "v"(sap[2]), "v"(sap[3]), "v"(w), "v"(kka));
}
#undef BLO
#undef BHI
__device__ __forceinline__ int modidx(int row) { return row < NPTOK ? 0 : 1 + ((row - NPTOK) >> 12); }

#define XB_TMO      128
#define XB_XCNT(j)  (256  + 64 * (j))
#define XB_XSUB(j)  (1280 + 64 * (j))
#define XB_XGEN(j)  (2304 + 64 * (j))
#define XB_TOP      3328
#define XB_TOPGEN   3392
#define XCD_BAR_WORDS 3456
#define XB_SPIN_CAP (1u << 22)
__device__ __forceinline__ unsigned xb_ld(unsigned* p)              { return __hip_atomic_load(p, __ATOMIC_RELAXED, __HIP_MEMORY_SCOPE_AGENT); }
__device__ __forceinline__ unsigned xb_add(unsigned* p, unsigned v) { return __hip_atomic_fetch_add(p, v, __ATOMIC_RELAXED, __HIP_MEMORY_SCOPE_AGENT); }
__device__ __forceinline__ unsigned xb_xcc_id() { return (unsigned)__builtin_amdgcn_s_getreg((3 << 11) | 20) & 0xFu; }
#define XB_SPIN(cond, bar) do { unsigned _sp = 0; while (cond) { __builtin_amdgcn_s_sleep(1); \
    if ((++_sp & 255u) == 0u) { if (xb_ld(&(bar)[XB_TMO])) break; if (_sp > XB_SPIN_CAP) { atomicAdd(&(bar)[XB_TMO], 1u); break; } } } } while (0)
struct XcdBarrier { unsigned* bar; unsigned x; volatile LAS unsigned* st; };
__device__ __forceinline__ XcdBarrier xcd_barrier_post(unsigned* bar, volatile LAS unsigned* st) {
    XcdBarrier b; b.bar = bar; b.x = xb_xcc_id(); b.st = st;
    if (threadIdx.x == 0) (void)xb_add(&bar[XB_XCNT(b.x)], 1u);
    return b;
}
__device__ __forceinline__ void xcd_barrier_complete(unsigned* bar, unsigned x, unsigned& nloc, unsigned& nx) {
    const unsigned G = gridDim.x * gridDim.y * gridDim.z;
    unsigned sum, cnt, mine, sp = 0u;
    for (;;) {
        sum = 0u; cnt = 0u; mine = 0u;
#pragma unroll
        for (unsigned j = 0; j < 16; ++j) { const unsigned c = xb_ld(&bar[XB_XCNT(j)]); sum += c; cnt += (c > 0u) ? 1u : 0u; mine = (j == x) ? c : mine; }
        if (sum == G) break;
        __builtin_amdgcn_s_sleep(1);
        if ((++sp & 255u) == 0u) { if (xb_ld(&bar[XB_TMO])) break; if (sp > XB_SPIN_CAP) { atomicAdd(&bar[XB_TMO], 1u); break; } }
    }
    nloc = mine > 0u ? mine : 1u; nx = cnt > 0u ? cnt : 1u;
}
__device__ __forceinline__ void xcd_barrier(const XcdBarrier& b) {
    asm volatile("s_waitcnt vmcnt(0)" ::: "memory");
    __syncthreads();
    if (threadIdx.x == 0) {
        unsigned* bar = b.bar;
        __builtin_amdgcn_s_waitcnt(0);
        unsigned nloc = b.st[0], nx = b.st[1];
        if (nloc == 0u) { xcd_barrier_complete(bar, b.x, nloc, nx); b.st[0] = nloc; b.st[1] = nx; }
        const unsigned old = xb_add(&bar[XB_XSUB(b.x)], 1u);
        const unsigned gen = old / nloc;
        if (old + 1u == (gen + 1u) * nloc) {
            __builtin_amdgcn_fence(__ATOMIC_RELEASE, "agent");
            asm volatile("s_waitcnt vmcnt(0)" ::: "memory");
            const unsigned og = xb_add(&bar[XB_TOP], 1u);
            const unsigned tg = og / nx;
            if (og + 1u == (tg + 1u) * nx) xb_add(&bar[XB_TOPGEN], 1u);
            else XB_SPIN(xb_ld(&bar[XB_TOPGEN]) == tg, bar);
            __builtin_amdgcn_fence(__ATOMIC_ACQUIRE, "agent");
            xb_add(&bar[XB_XGEN(b.x)], 1u);
            asm volatile("s_waitcnt vmcnt(0)" ::: "memory");
        } else {
            XB_SPIN(xb_ld(&bar[XB_XGEN(b.x)]) == gen, bar);
            __builtin_amdgcn_fence(__ATOMIC_ACQUIRE, "agent");
            asm volatile("s_waitcnt vmcnt(0)" ::: "memory");
        }
    }
    __syncthreads();
}

struct Args { const float* in[34]; float* out; unsigned char* ws; int ph_lo, ph_hi; };
struct Frame {
    LAS unsigned char* lds;
    int tid, lane, wave, G;
    const float* const* in;
    float* out; unsigned char* ws;
};
#define IN_XP 0
#define IN_XS 1
#define IN_SLRU 2
#define IN_SWKV 3
#define IN_C 4
#define IN_CCTX 5
#define IN_NMPRE 6
#define IN_NMPOST 7
#define IN_NFPRE 8
#define IN_NFPOST 9
#define IN_WMOD 10
#define IN_BMOD 11
#define IN_WIN 12
#define IN_CONVW 13
#define IN_CONVB 14
#define IN_WR 15
#define IN_BR 16
#define IN_WI 17
#define IN_BI 18
#define IN_LAM 19
#define IN_MU 20
#define IN_W0 21
#define IN_WUP 22
#define IN_A0 23
#define IN_AUP 24
#define IN_GUP 25
#define IN_KK 26
#define IN_KA 27
#define IN_RK 28
#define IN_LNW 29
#define IN_LNB 30
#define IN_WOUT 31
#define IN_WGU 32
#define IN_WDN 33

namespace pg8 {
constexpr int BM = 256, BK = 64, HALF = 128, HTB = HALF * BK * 2, STAGE_BYTES = 8 * HTB, NXCD = 8, WGM = 8;
__host__ __device__ __forceinline__ int lds_byte(int r, int c) { const int st = (r >> 4) * 2 + (c >> 5), rr = r & 15, cc = c & 31, ob = rr * 64 + cc * 2; return st * 1024 + (ob ^ (((ob >> 9) & 1) << 5)); }
__host__ __device__ __forceinline__ void stage_rc(int b, int& R, int& C) { const int st = b / 1024, sb = b % 1024, swz = sb ^ (((sb >> 9) & 1) << 5); R = (st >> 1) * 16 + swz / 64; C = (st & 1) * 32 + (swz % 64) / 2; }
__host__ __device__ __forceinline__ int perm32(int rho) { const int n = rho >> 4, i = rho & 15; return 8 * (i >> 2) + 4 * n + (i & 3); }
struct Unit { int pm, pn; };
struct Gemm { const bf16_t* A; const bf16_t* Bt; int lda, ldb, K; int lruoff; };
struct StaticOrder {
    int nM, nN, nwg, G, c;
    __device__ void init(int M, int N, int G_, int c_) { nM = M / BM; nN = N / BM; nwg = nM * nN; G = G_; c = c_; }
    __device__ bool next(int i, Unit& u) const {
        const long L = (long)i * G + c; if (L >= nwg) return false;
        int wgid = (int)L; { const int q = nwg / NXCD, r = nwg % NXCD, xcd = wgid % NXCD, off = wgid / NXCD; wgid = (xcd < r ? xcd * (q + 1) : r * (q + 1) + (xcd - r) * q) + off; }
        const int nig = WGM * nN, gid = wgid / nig, fm = gid * WGM, gsz = (nM - fm) < WGM ? (nM - fm) : WGM;
        u.pm = fm + ((wgid % nig) % gsz); u.pn = (wgid % nig) / gsz; return true;
    }
};
__device__ __forceinline__ size_t a_unit_off(const Gemm& g, const Unit& u) {
    size_t o = (size_t)u.pm * BM * g.lda * 2;
    if (g.lruoff == 1) { const int hd = u.pn >> 1; o += (size_t)(hd < 7 ? 128 * hd : 768) * 2; }
    if (g.lruoff == 2) { o += (size_t)(u.pn < 16 ? 0 : 128) * 2; }
    return o;
}

template <class Epi, bool ALIGN_EPI = true, bool SP2 = true>
__device__ __forceinline__ void gemm_phase(LAS unsigned char* lds, const Gemm g, const StaticOrder& S, const Epi& E) {
    const int tid = threadIdx.x, wid = __builtin_amdgcn_readfirstlane(tid >> 6), lane = tid & 63, wr = wid >> 2, wc = wid & 3, fr = lane & 15, fq = lane >> 4;
    const int nt = g.K / BK;
    unsigned voffA[2], voffB[2];
#pragma unroll
    for (int i = 0; i < 2; ++i) { int R, C; stage_rc(tid * 16 + i * 8192, R, C); const int Rb = (R & ~31) + perm32(R & 31);
        voffA[i] = (unsigned)(R * g.lda + C) * 2u; voffB[i] = (unsigned)(Rb * g.ldb + C) * 2u; }
    const size_t kstep = (size_t)(BK * 2);
    const size_t hstepA = (size_t)HALF * g.lda * 2, hstepB = (size_t)HALF * g.ldb * 2;
    const size_t tstepB = 2 * hstepB;
    const unsigned ldsw = (unsigned)wid * 1024u;
    const int aoff = lds_byte(wr * 64 + fr, fq * 8), boff = lds_byte(wc * 32 + fr, fq * 8);
#define PG8_SA(b, h) (((b) * 2 + (h)) * HTB)
#define PG8_SB(b, h) ((4 + (b) * 2 + (h)) * HTB)
#define PG8_STAGE(bufoff, gbase, voff) do { _Pragma("unroll") for (int _i = 0; _i < 2; ++_i) \
        __builtin_amdgcn_global_load_lds((const unsigned*)((const char*)(gbase) + (voff)[_i]), (LAS unsigned*)(lds + (bufoff) + ldsw + _i * 8192), 16, 0, 0); } while (0)
#define PG8_LDA(dst, b, h) do { _Pragma("unroll") for (int m = 0; m < 4; ++m) _Pragma("unroll") for (int k = 0; k < 2; ++k) dst[m][k] = *(const LAS bf16x8*)(lds + PG8_SA(b, h) + aoff + m * 2048 + k * 1024); } while (0)
#define PG8_LDB(dst, b, h) do { _Pragma("unroll") for (int n = 0; n < 2; ++n) _Pragma("unroll") for (int k = 0; k < 2; ++k) dst[n][k] = *(const LAS bf16x8*)(lds + PG8_SB(b, h) + boff + n * 2048 + k * 1024); } while (0)
#define PG8_MMA(ai, bj, At, Bt) do { __builtin_amdgcn_s_setprio(1); _Pragma("unroll") for (int m = 0; m < 4; ++m) _Pragma("unroll") for (int n = 0; n < 2; ++n) _Pragma("unroll") for (int k = 0; k < 2; ++k) \
        acc[ai][bj][m][n] = __builtin_amdgcn_mfma_f32_16x16x32_bf16(Bt[n][k], At[m][k], acc[ai][bj][m][n], 0, 0, 0); __builtin_amdgcn_s_setprio(0); } while (0)
#define PG8_WAIT_V(n) asm volatile("s_waitcnt vmcnt(" #n ")" ::: "memory")
#define PG8_WAIT_L(n) asm volatile("s_waitcnt lgkmcnt(" #n ")" ::: "memory")
#define PG8_BAR __builtin_amdgcn_s_barrier()
#define PG8_SCHED __builtin_amdgcn_sched_barrier(0)
    Unit cur, nxt; int ui = 0;
    if (!S.next(0, cur)) return;
    f32x4 acc[2][2][4][2];
#pragma unroll
    for (int a = 0; a < 2; ++a)
#pragma unroll
        for (int b = 0; b < 2; ++b)
#pragma unroll
            for (int m = 0; m < 4; ++m)
#pragma unroll
                for (int n = 0; n < 2; ++n) acc[a][b][m][n] = (f32x4){0.f, 0.f, 0.f, 0.f};
    bf16x8 At[4][2], B0[2][2], B1[2][2];
    const char* cA = (const char*)g.A + a_unit_off(g, cur); const char* cB = (const char*)g.Bt + (size_t)cur.pn * tstepB;
    if constexpr (SP2) {
        PG8_STAGE(PG8_SB(0, 0), cB, voffB); PG8_STAGE(PG8_SB(0, 1), cB + hstepB, voffB); PG8_STAGE(PG8_SA(0, 0), cA, voffA); PG8_STAGE(PG8_SA(0, 1), cA + hstepA, voffA);
        if (wr == 1) PG8_BAR;
        PG8_WAIT_V(2); PG8_BAR;
        PG8_STAGE(PG8_SB(1, 0), cB + kstep, voffB); PG8_STAGE(PG8_SA(1, 0), cA + kstep, voffA); PG8_STAGE(PG8_SB(1, 1), cB + hstepB + kstep, voffB);
        PG8_WAIT_V(6); PG8_BAR;
    } else {
    PG8_STAGE(PG8_SB(0, 0), cB, voffB); PG8_STAGE(PG8_SA(0, 0), cA, voffA); PG8_STAGE(PG8_SB(0, 1), cB + hstepB, voffB); PG8_STAGE(PG8_SA(0, 1), cA + hstepA, voffA);
    if (wr == 1) PG8_BAR;
    PG8_WAIT_V(4); PG8_BAR;
    PG8_STAGE(PG8_SB(1, 0), cB + kstep, voffB); PG8_STAGE(PG8_SA(1, 0), cA + kstep, voffA); PG8_STAGE(PG8_SB(1, 1), cB + hstepB + kstep, voffB);
    PG8_WAIT_V(6); PG8_BAR;
    }
    for (;;) {
        const bool has_next = S.next(ui + 1, nxt);
        const char* nA = has_next ? (const char*)g.A + a_unit_off(g, nxt) : cA; const char* nB = has_next ? (const char*)g.Bt + (size_t)nxt.pn * tstepB : cB;
#pragma unroll 1
        for (int t = 0; t < nt; t += 2) {
            const bool last = (t == nt - 2);
            const char* a1 = cA + (size_t)(t + 1) * kstep;
            const char* a2 = last ? nA : cA + (size_t)(t + 2) * kstep; const char* b2 = last ? nB : cB + (size_t)(t + 2) * kstep;
            const char* a3 = a2 + kstep; const char* b3 = b2 + kstep;
            if constexpr (SP2) {
            PG8_LDB(B0, 0, 0); PG8_LDB(B1, 0, 1); PG8_SCHED; PG8_LDA(At, 0, 0); PG8_STAGE(PG8_SA(1, 1), a1 + hstepA, voffA);
            PG8_WAIT_V(8); PG8_WAIT_L(0); PG8_BAR; PG8_MMA(0, 0, At, B0); PG8_MMA(0, 1, At, B1); PG8_BAR; PG8_SCHED;
            PG8_LDA(At, 0, 1); PG8_STAGE(PG8_SB(0, 0), b2, voffB); PG8_STAGE(PG8_SB(0, 1), b2 + hstepB, voffB); PG8_STAGE(PG8_SA(0, 0), a2, voffA);
            PG8_WAIT_V(8); PG8_WAIT_L(0); PG8_BAR; PG8_MMA(1, 0, At, B0); PG8_MMA(1, 1, At, B1); PG8_BAR; PG8_SCHED;
            PG8_LDB(B0, 1, 0); PG8_LDB(B1, 1, 1); PG8_SCHED; PG8_LDA(At, 1, 0); PG8_STAGE(PG8_SA(0, 1), a2 + hstepA, voffA);
            PG8_WAIT_V(8); PG8_WAIT_L(0); PG8_BAR; PG8_MMA(0, 0, At, B0); PG8_MMA(0, 1, At, B1); PG8_BAR; PG8_SCHED;
            PG8_LDA(At, 1, 1); PG8_STAGE(PG8_SB(1, 0), b3, voffB); PG8_STAGE(PG8_SB(1, 1), b3 + hstepB, voffB); PG8_STAGE(PG8_SA(1, 0), a3, voffA);
            PG8_WAIT_V(8); PG8_WAIT_L(0); PG8_BAR; PG8_MMA(1, 0, At, B0); PG8_MMA(1, 1, At, B1); PG8_BAR; PG8_SCHED;
            } else {
            PG8_LDB(B0, 0, 0); PG8_SCHED; PG8_LDA(At, 0, 0); PG8_STAGE(PG8_SA(1, 1), a1 + hstepA, voffA);
            PG8_WAIT_L(8); PG8_BAR; PG8_WAIT_L(0); PG8_MMA(0, 0, At, B0); PG8_BAR; PG8_SCHED;
            PG8_LDB(B1, 0, 1); PG8_STAGE(PG8_SB(0, 0), b2, voffB);
            PG8_BAR; PG8_WAIT_L(0); PG8_MMA(0, 1, At, B1); PG8_BAR;
            PG8_LDA(At, 0, 1); PG8_STAGE(PG8_SA(0, 0), a2, voffA);
            PG8_BAR; PG8_WAIT_L(0); PG8_MMA(1, 0, At, B0); PG8_BAR; PG8_SCHED;
            PG8_STAGE(PG8_SB(0, 1), b2 + hstepB, voffB);
            PG8_WAIT_V(6); PG8_BAR; PG8_MMA(1, 1, At, B1); PG8_BAR;
            PG8_LDB(B0, 1, 0); PG8_SCHED; PG8_LDA(At, 1, 0); PG8_STAGE(PG8_SA(0, 1), a2 + hstepA, voffA);
            PG8_WAIT_L(8); PG8_BAR; PG8_WAIT_L(0); PG8_MMA(0, 0, At, B0); PG8_BAR; PG8_SCHED;
            PG8_LDB(B1, 1, 1); PG8_STAGE(PG8_SB(1, 0), b3, voffB);
            PG8_BAR; PG8_WAIT_L(0); PG8_MMA(0, 1, At, B1); PG8_BAR;
            PG8_LDA(At, 1, 1); PG8_STAGE(PG8_SA(1, 0), a3, voffA);
            PG8_BAR; PG8_WAIT_L(0); PG8_MMA(1, 0, At, B0); PG8_BAR; PG8_SCHED;
            PG8_STAGE(PG8_SB(1, 1), b3 + hstepB, voffB);
            PG8_WAIT_V(6); PG8_BAR; PG8_MMA(1, 1, At, B1); PG8_BAR;
                    }
        }
        if constexpr (ALIGN_EPI) { if (wr == 0) PG8_BAR; }
        E(acc, cur, wr, wc, fr, fq);
        if (!has_next) break;
#pragma unroll
        for (int a = 0; a < 2; ++a)
#pragma unroll
            for (int b = 0; b < 2; ++b)
#pragma unroll
                for (int m = 0; m < 4; ++m)
#pragma unroll
                    for (int n = 0; n < 2; ++n) acc[a][b][m][n] = (f32x4){0.f, 0.f, 0.f, 0.f};
        cur = nxt; cA = nA; cB = nB; ++ui;
        if constexpr (ALIGN_EPI) { if (wr == 1) PG8_BAR; }
    }
    PG8_WAIT_V(0);
    if constexpr (!ALIGN_EPI) { if (wr == 0) PG8_BAR; }
    PG8_BAR;
#undef PG8_SA
#undef PG8_SB
#undef PG8_STAGE
#undef PG8_LDA
#undef PG8_LDB
#undef PG8_MMA
#undef PG8_WAIT_V
#undef PG8_WAIT_L
#undef PG8_BAR
#undef PG8_SCHED
}

struct EpiBf16 {
    bf16_t* O; int ldc;
    __device__ __forceinline__ void operator()(const f32x4 (&acc)[2][2][4][2], const Unit& u, int wr, int wc, int fr, int fq) const {
        const int row0 = u.pm * BM + wr * 64 + fr, col0 = u.pn * BM + wc * 32 + 8 * fq;
#pragma unroll
        for (int ai = 0; ai < 2; ++ai)
#pragma unroll
            for (int m = 0; m < 4; ++m) { bf16_t* rowp = O + (size_t)(row0 + ai * HALF + m * 16) * ldc + col0;
#pragma unroll
                for (int bj = 0; bj < 2; ++bj) { const f32x4 v0 = acc[ai][bj][m][0], v1 = acc[ai][bj][m][1];
                    *(u32x4*)(rowp + bj * HALF) = (u32x4){pk2(v0[0], v0[1]), pk2(v0[2], v0[3]), pk2(v1[0], v1[1]), pk2(v1[2], v1[3])}; } }
    }
};
struct EpiGu {
    bf16_t* O;
    __device__ __forceinline__ void operator()(const f32x4 (&acc)[2][2][4][2], const Unit& u, int wr, int wc, int fr, int fq) const {
        const int row0 = u.pm * BM + wr * 64 + fr, col0 = u.pn * HALF + wc * 32 + 8 * fq;
#pragma unroll
        for (int ai = 0; ai < 2; ++ai)
#pragma unroll
            for (int m = 0; m < 4; ++m) { bf16_t* rowp = O + (size_t)(row0 + ai * HALF + m * 16) * FFH + col0;
                float o[8];
#pragma unroll
                for (int n = 0; n < 2; ++n)
#pragma unroll
                    for (int i = 0; i < 4; ++i) { const float gt = acc[ai][0][m][n][i], up = acc[ai][1][m][n][i]; o[n * 4 + i] = gt * sigmoidf_(gt) * up; }
                *(u32x4*)rowp = (u32x4){pk2(o[0], o[1]), pk2(o[2], o[3]), pk2(o[4], o[5]), pk2(o[6], o[7])}; }
    }
};
struct EpiLru {
    unsigned* LAB; const bf16_t* XC; const float* br; const float* bi; const float* nl8;
    __device__ __forceinline__ void operator()(const f32x4 (&acc)[2][2][4][2], const Unit& u, int wr, int wc, int fr, int fq) const {
        const int hd = u.pn >> 1, dir = u.pn & 1;
        const int row0 = u.pm * BM + wr * 64 + fr, ch0 = wc * 32 + 8 * fq, chan0 = hd * 128 + ch0;
        const float* brp = br + (dir * 8 + hd) * 128 + ch0; const float* bip = bi + (dir * 8 + hd) * 128 + ch0; const float* nlp = nl8 + dir * 1024 + chan0;
#pragma unroll
        for (int ai = 0; ai < 2; ++ai)
#pragma unroll
            for (int m = 0; m < 4; ++m) { const int row = row0 + ai * HALF + m * 16;
                const u32x4 xw = *(const u32x4*)(XC + (size_t)row * LRUW + chan0);
                unsigned* dst = LAB + ((size_t)row * 2 + dir) * LRUW + chan0;
#pragma unroll
                for (int n = 0; n < 2; ++n) { const f32x4 brv = *(const f32x4*)(brp + 4 * n), biv = *(const f32x4*)(bip + 4 * n), nlv = *(const f32x4*)(nlp + 4 * n);
                    unsigned o[4];
#pragma unroll
                    for (int i = 0; i < 4; ++i) { const int e = n * 4 + i;
                        const float xc = (e & 1) ? bfhi(xw[e >> 1]) : bflo(xw[e >> 1]);
                        const float rg = sigmoidf_(acc[ai][0][m][n][i] + brv[i]), ig = sigmoidf_(acc[ai][1][m][n][i] + biv[i]);
                        const float la = rg * nlv[i], x2 = 2.f * la;
                        const float om = 1.f - __builtin_amdgcn_exp2f(x2 * 1.44269504f);
                        const float bb = __builtin_amdgcn_sqrtf(om) * ig * xc;
                        o[i] = pk2(la, bb); }
                    *(u32x4*)(dst + 4 * n) = (u32x4){o[0], o[1], o[2], o[3]};
                    __builtin_amdgcn_sched_barrier(0); } }
    }
};
struct EpiLora {
    bf16_t* E; bf16_t* AA; bf16_t* Gt; const float* w0; const float* a0;
    __device__ __forceinline__ void operator()(const f32x4 (&acc)[2][2][4][2], const Unit& u, int wr, int wc, int fr, int fq) const {
        const int type = u.pn >> 2, d = type & 1;
        const int row0 = u.pm * BM + wr * 64 + fr;
        const float* bsrc = type < 2 ? w0 + d * RW : a0 + d * RW;
        bf16_t* obase = type < 2 ? E + d * RW : (type < 4 ? AA + d * RW : Gt);
        const int opitch = type < 4 ? 2 * RW : RW;
        const float sc = type < 2 ? 0.60653066f : 1.f;
#pragma unroll
        for (int bj = 0; bj < 2; ++bj) { const int ch0 = (u.pn & 3) * 256 + bj * HALF + wc * 32 + 8 * fq;
#pragma unroll
            for (int ai = 0; ai < 2; ++ai)
#pragma unroll
                for (int m = 0; m < 4; ++m) { const int row = row0 + ai * HALF + m * 16;
                    float o[8];
#pragma unroll
                    for (int n = 0; n < 2; ++n) { f32x4 bias = (f32x4){0.f, 0.f, 0.f, 0.f}; if (type < 4) bias = *(const f32x4*)(bsrc + ch0 + 4 * n);
#pragma unroll
                        for (int i = 0; i < 4; ++i) { const float z = acc[ai][bj][m][n][i] + bias[i]; o[n * 4 + i] = type < 4 ? sc * sigmoidf_(z) : z; } }
                    *(u32x4*)(obase + (size_t)row * opitch + ch0) = (u32x4){pk2(o[0], o[1]), pk2(o[2], o[3]), pk2(o[4], o[5]), pk2(o[6], o[7])};
                    __builtin_amdgcn_sched_barrier(0); } }
    }
};
}

struct XTile { const float* src; int ldsrc, ncv, k0, n0; bf16_t* dst; int lddst, drow0; };
__device__ __forceinline__ XTile xtile_desc(Frame& F, int ti) {
    const int T_IN = 32 * 88, T_OUT = 32 * 32, T_GU = 32 * 176;
    unsigned char* ws = F.ws; XTile t;
    if (ti < T_IN) { const int kt = ti / 88, nt = ti % 88; t = XTile{F.in[IN_WIN], INW, INW, kt * 64, nt * 64, (bf16_t*)(ws + WS_WTIN), D, nt * 64}; }
    else if (ti < T_IN + T_OUT) { const int t2 = ti - T_IN, kt = t2 / 32, nt = t2 % 32; t = XTile{F.in[IN_WOUT], D, D, kt * 64, nt * 64, (bf16_t*)(ws + WS_WTOUT), D, nt * 64}; }
    else if (ti < T_IN + T_OUT + T_GU) { const int t2 = ti - T_IN - T_OUT, kt = t2 / 176, nt = t2 % 176, n0 = nt * 64;
        const int drow0 = n0 < FFH ? (n0 / 128) * 256 + (n0 % 128) : ((n0 - FFH) / 128) * 256 + 128 + ((n0 - FFH) % 128);
        t = XTile{F.in[IN_WGU], 2 * FFH, 2 * FFH, kt * 64, n0, (bf16_t*)(ws + WS_WTGU), D, drow0}; }
    else { const int t2 = ti - T_IN - T_OUT - T_GU, kt = t2 / 32, nt = t2 % 32; t = XTile{F.in[IN_WDN], D, D, kt * 64, nt * 64, (bf16_t*)(ws + WS_WTDN), FFH, nt * 64}; }
    return t;
}
__device__ __forceinline__ void xtile_load(const XTile& t, int tid, float4& v0, float4& v1) {
    const int r = tid >> 4, c4 = (tid & 15) * 4;
    v0 = make_float4(0.f, 0.f, 0.f, 0.f); v1 = v0;
    if (t.n0 + c4 < t.ncv) { v0 = *(const float4*)(t.src + (size_t)(t.k0 + r) * t.ldsrc + t.n0 + c4); v1 = *(const float4*)(t.src + (size_t)(t.k0 + r + 32) * t.ldsrc + t.n0 + c4); }
}
__device__ __forceinline__ void xpose_all(Frame& F) {
    const int T_ALL = 32 * 88;
    LAS bf16_t* tl = (LAS bf16_t*)F.lds;
    const int tid = F.tid, r = tid >> 4, c4 = (tid & 15) * 4;
    int ti = blockIdx.x; if (ti >= T_ALL) return;
    XTile cur = xtile_desc(F, ti); float4 v0, v1; xtile_load(cur, tid, v0, v1);
    for (;;) {
        const int tn = ti + F.G; const bool has = tn < T_ALL;
        XTile nxt = cur; float4 n0 = v0, n1 = v1;
        if (has) { nxt = xtile_desc(F, tn); xtile_load(nxt, tid, n0, n1); }
        tl[(c4 + 0) * 68 + r] = (bf16_t)f2bf(v0.x); tl[(c4 + 1) * 68 + r] = (bf16_t)f2bf(v0.y); tl[(c4 + 2) * 68 + r] = (bf16_t)f2bf(v0.z); tl[(c4 + 3) * 68 + r] = (bf16_t)f2bf(v0.w);
        tl[(c4 + 0) * 68 + r + 32] = (bf16_t)f2bf(v1.x); tl[(c4 + 1) * 68 + r + 32] = (bf16_t)f2bf(v1.y); tl[(c4 + 2) * 68 + r + 32] = (bf16_t)f2bf(v1.z); tl[(c4 + 3) * 68 + r + 32] = (bf16_t)f2bf(v1.w);
        __syncthreads();
        { const int n = tid >> 3, kc = (tid & 7) * 8;
          const u32x2 va = *(const LAS u32x2*)(tl + n * 68 + kc), vb = *(const LAS u32x2*)(tl + n * 68 + kc + 4);
          *(u32x4*)(cur.dst + (size_t)(cur.drow0 + n) * cur.lddst + cur.k0 + kc) = (u32x4){va[0], va[1], vb[0], vb[1]}; }
        __syncthreads();
        if (!has) break;
        cur = nxt; v0 = n0; v1 = n1; ti = tn;
    }
}

__device__ __forceinline__ void xpose_tile_wave(const XTile& t, LAS bf16_t* tl, int lane) {
    const int q = lane >> 4, c4 = (lane & 15) * 4;
#pragma unroll
    for (int hf = 0; hf < 2; ++hf) {
        float4 v[8];
#pragma unroll
        for (int j = 0; j < 8; ++j) { const int k = 8 * (hf * 4 + (j >> 1)) + 2 * q + (j & 1);
            v[j] = (t.n0 + c4 < t.ncv) ? *(const float4*)(t.src + (size_t)(t.k0 + k) * t.ldsrc + t.n0 + c4) : make_float4(0.f, 0.f, 0.f, 0.f); }
#pragma unroll
        for (int m = 0; m < 4; ++m) { const int k0 = 8 * (hf * 4 + m) + 2 * q; const float4 a = v[2 * m], b = v[2 * m + 1];
            *(LAS unsigned*)(tl + (c4 + 0) * 68 + k0) = pk2(a.x, b.x); *(LAS unsigned*)(tl + (c4 + 1) * 68 + k0) = pk2(a.y, b.y);
            *(LAS unsigned*)(tl + (c4 + 2) * 68 + k0) = pk2(a.z, b.z); *(LAS unsigned*)(tl + (c4 + 3) * 68 + k0) = pk2(a.w, b.w); }
    }
    const int nr = lane >> 3, kc = (lane & 7) * 8;
#pragma unroll
    for (int r = 0; r < 8; ++r) { const int n = r * 8 + nr;
        const u32x2 va = *(const LAS u32x2*)(tl + n * 68 + kc), vb = *(const LAS u32x2*)(tl + n * 68 + kc + 4);
        *(u32x4*)(t.dst + (size_t)(t.drow0 + n) * t.lddst + t.k0 + kc) = (u32x4){va[0], va[1], vb[0], vb[1]}; }
}

__device__ __forceinline__ bool xtile_group_b(int ti) {
    const int T_IN = 32 * 88, T_OUT = 32 * 32, T_GU = 32 * 176;
    if (ti < T_IN + T_OUT) return true;
    if (ti < T_IN + T_OUT + T_GU) { const int nt = (ti - T_IN - T_OUT) % 176; const int unit = nt < 88 ? nt >> 1 : (nt - 88) >> 1; return unit < 24; }
    return false;
}
__device__ __forceinline__ void xpose_deferred(Frame& F, bool group_b, int first, int stride, LAS bf16_t* tl) {
    const int T0 = 32 * 88, T1 = 32 * 88 + 32 * 32 + 32 * 176 + 88 * 32;
    for (int ti = T0 + first; ti < T1; ti += stride) if (xtile_group_b(ti) == group_b) { const XTile t = xtile_desc(F, ti); xpose_tile_wave(t, tl, F.lane); }
}

__device__ __forceinline__ void p0_prologue(Frame& F) {
    const int tid = F.tid, G = F.G, bid = blockIdx.x;
    unsigned char* ws = F.ws;
    {
        LAS float* sv = (LAS float*)F.lds;
        LAS float* red = (LAS float*)(F.lds + 24576);
        const float* c = F.in[IN_C]; const float* cctx = F.in[IN_CCTX];
        for (int i = tid; i < 3 * D; i += 512) { const int r = i / D, k = i % D; const float cv = r == 0 ? cctx[k] : c[(r - 1) * D + k]; sv[i] = cv * sigmoidf_(cv); }
        __syncthreads();
        const float* wm = F.in[IN_WMOD]; const float* bm = F.in[IN_BMOD]; float* MOD = (float*)(ws + WS_MOD);
        for (int cb = bid; cb < 256; cb += G) {
            const int n0 = cb * 48;
            if (tid < 504) { const int cg4 = (tid % 12) * 4, kl = tid / 12;
                float a0[4] = {0, 0, 0, 0}, a1[4] = {0, 0, 0, 0}, a2[4] = {0, 0, 0, 0};
#pragma unroll 8
                for (int k = kl; k < D; k += 42) { const float4 w = *(const float4*)(wm + (size_t)k * 12288 + n0 + cg4);
                    const float s0 = sv[k], s1 = sv[D + k], s2 = sv[2 * D + k];
                    a0[0] += s0 * w.x; a0[1] += s0 * w.y; a0[2] += s0 * w.z; a0[3] += s0 * w.w;
                    a1[0] += s1 * w.x; a1[1] += s1 * w.y; a1[2] += s1 * w.z; a1[3] += s1 * w.w;
                    a2[0] += s2 * w.x; a2[1] += s2 * w.y; a2[2] += s2 * w.z; a2[3] += s2 * w.w; }
#pragma unroll
                for (int i = 0; i < 4; ++i) { red[(kl * 3 + 0) * 48 + cg4 + i] = a0[i]; red[(kl * 3 + 1) * 48 + cg4 + i] = a1[i]; red[(kl * 3 + 2) * 48 + cg4 + i] = a2[i]; } }
            __syncthreads();
            if (tid < 144) { const int r = tid / 48, j = tid % 48; float s = 0.f; for (int kl = 0; kl < 42; ++kl) s += red[(kl * 3 + r) * 48 + j]; MOD[r * 12288 + n0 + j] = s + bm[n0 + j]; }
            __syncthreads();
        }
    }
    xpose_all(F);
    {
        const size_t gt = (size_t)bid * 512 + tid, gs = (size_t)G * 512;
        bf16_t* btl = (bf16_t*)(ws + WS_BTLRU);
        const float* wr = F.in[IN_WR]; const float* wi = F.in[IN_WI];
        for (size_t it = gt; it < (size_t)4096 * 32; it += gs) { const int row = (int)(it & 4095), c0 = (int)(it >> 12) * 8;
            const int hd = row >> 9, q = (row >> 7) & 3, j = row & 127, koff = hd < 7 ? 128 * hd : 768, kk0 = c0 - (128 * hd - koff);
            float v[8];
            const float* W = ((q & 1) ? wi : wr) + ((size_t)((q >> 1) * 8 + hd) * 128) * 128 + j;
#pragma unroll
            for (int i = 0; i < 8; ++i) v[i] = (kk0 >= 0 && kk0 < 128) ? W[(size_t)(kk0 + i) * 128] : 0.f;
            *(u32x4*)(btl + (size_t)row * 256 + c0) = (u32x4){pk2(v[0], v[1]), pk2(v[2], v[3]), pk2(v[4], v[5]), pk2(v[6], v[7])}; }
        bf16_t* bto = (bf16_t*)(ws + WS_BTLORA);
        const float* wup = F.in[IN_WUP]; const float* aup = F.in[IN_AUP]; const float* gup = F.in[IN_GUP];
        for (size_t it = gt; it < (size_t)5120 * 32; it += gs) { const int n = (int)(it % 5120), k0 = (int)(it / 5120) * 8;
            float v[8];
            const float* src = nullptr;
            if (n < 2048) { if (k0 < 64) src = wup + ((size_t)(n >> 10) * 64 + k0) * RW + (n & 1023); }
            else if (n < 4096) { if (k0 >= 64 && k0 < 128) src = aup + ((size_t)((n - 2048) >> 10) * 64 + (k0 - 64)) * RW + (n & 1023); }
            else { if (k0 < 160) src = gup + (size_t)k0 * RW + (n - 4096); }
#pragma unroll
            for (int i = 0; i < 8; ++i) v[i] = src ? src[(size_t)i * RW] : 0.f;
            *(u32x4*)(bto + (size_t)n * 256 + k0) = (u32x4){pk2(v[0], v[1]), pk2(v[2], v[3]), pk2(v[4], v[5]), pk2(v[6], v[7])}; }
        float* nl8 = (float*)(ws + WS_NL8); const float* lam = F.in[IN_LAM];
        for (size_t idx = gt; idx < 2048; idx += gs) { const float l = lam[idx]; nl8[idx] = -8.f * log1pf(__expf(-l)); }
    }
}

__device__ __forceinline__ void p1_normmod(Frame& F) {
    const float* MOD = (const float*)(F.ws + WS_MOD); const float* g1 = F.in[IN_NMPRE]; bf16_t* H = (bf16_t*)(F.ws + WS_H);
    for (int row = blockIdx.x * 8 + F.wave; row < NTOK; row += F.G * 8) {
        const float* xr = row < NPTOK ? F.in[IN_XP] + (size_t)row * D : F.in[IN_XS] + (size_t)(row - NPTOK) * D;
        float4 v[8]; float ss = 0.f;
#pragma unroll
        for (int i = 0; i < 8; ++i) { v[i] = *(const float4*)(xr + (i * 64 + F.lane) * 4); ss += v[i].x * v[i].x + v[i].y * v[i].y + v[i].z * v[i].z + v[i].w * v[i].w; }
        ss = wave_sum(ss);
        const float rstd = rsqrtf(ss * (1.f / D) + 1e-6f);
        const float* md = MOD + modidx(row) * 12288;
#pragma unroll
        for (int i = 0; i < 8; ++i) { const int col = (i * 64 + F.lane) * 4;
            const float4 g = *(const float4*)(g1 + col), sc = *(const float4*)(md + D + col), sh = *(const float4*)(md + col);
            const float h0 = v[i].x * rstd * g.x * (1.f + sc.x) + sh.x, h1 = v[i].y * rstd * g.y * (1.f + sc.y) + sh.y;
            const float h2 = v[i].z * rstd * g.z * (1.f + sc.z) + sh.z, h3 = v[i].w * rstd * g.w * (1.f + sc.w) + sh.w;
            *(u32x2*)(H + (size_t)row * D + col) = (u32x2){pk2(h0, h1), pk2(h2, h3)}; }
    }
}

struct NbrOff { int o0, o1, o2, o3; };
__device__ __forceinline__ NbrOff nbr_offsets(int g) {
    NbrOff n;
    if (g < NPTOK) { const int t = g & (PSEQ - 1); n.o0 = t >= 1 ? -1 : 0; n.o1 = t < PSEQ - 1 ? 1 : 0; n.o2 = 0; n.o3 = 0; }
    else { const int t = (g - NPTOK) & (SSEQ - 1), row = t >> 6, col = t & 63; n.o0 = col >= 1 ? -1 : 0; n.o1 = col < 63 ? 1 : 0; n.o2 = row >= 1 ? -64 : 0; n.o3 = row < 63 ? 64 : 0; }
    return n;
}
__device__ __forceinline__ int nbr_kind(bool sample, int j) { return sample ? (j < 840 ? 0 : (j < 1680 ? 1 : (j < 2520 ? 2 : 3))) : (j < 1680 ? 0 : 1); }
__device__ __forceinline__ int nbr_pick(const NbrOff& n, int kind) { return kind == 0 ? n.o0 : (kind == 1 ? n.o1 : (kind == 2 ? n.o2 : n.o3)); }
__device__ __forceinline__ float mixed_val(const bf16_t* PR, int g, int j, int off, float mu) {
    const float p = bf2f(PR[(size_t)g * INWP + j]);
    const float q = off ? bf2f(PR[(size_t)(g + off) * INWP + j]) : 0.f;
    return p + mu * (q - p);
}

__device__ __forceinline__ void p3_elem(Frame& F) {
    const bf16_t* PROJ = (const bf16_t*)(F.ws + WS_PROJ); const bf16_t* PR = PROJ + 2048;
    bf16_t* XC = (bf16_t*)(F.ws + WS_XC); bf16_t* LA = (bf16_t*)(F.ws + WS_LA);
    const float* cw = F.in[IN_CONVW]; const float* cb = F.in[IN_CONVB]; const float* mu = F.in[IN_MU];
    const int lane = F.lane;
    for (int g = blockIdx.x * 8 + F.wave; g < NTOK; g += F.G * 8) {
        const bool sample = g >= NPTOK; const int T = sample ? SSEQ : PSEQ, t = sample ? ((g - NPTOK) & (SSEQ - 1)) : (g & (PSEQ - 1));
#pragma unroll
        for (int half = 0; half < 2; ++half) { const int c0 = half * 512 + lane * 8;
            float o[8];
#pragma unroll
            for (int i = 0; i < 8; ++i) o[i] = cb[c0 + i];
#pragma unroll
            for (int k = 0; k < 4; ++k) { const int tt = t + k - 2;
                if (tt >= 0 && tt < T) { const u32x4 w = *(const u32x4*)(PROJ + (size_t)(g + k - 2) * INWP + c0);
                    const float4 w0 = *(const float4*)(cw + k * LRUW + c0), w1 = *(const float4*)(cw + k * LRUW + c0 + 4);
                    o[0] += bflo(w[0]) * w0.x; o[1] += bfhi(w[0]) * w0.y; o[2] += bflo(w[1]) * w0.z; o[3] += bfhi(w[1]) * w0.w;
                    o[4] += bflo(w[2]) * w1.x; o[5] += bfhi(w[2]) * w1.y; o[6] += bflo(w[3]) * w1.z; o[7] += bfhi(w[3]) * w1.w; } }
            *(u32x4*)(XC + (size_t)g * LRUW + c0) = (u32x4){pk2(o[0], o[1]), pk2(o[2], o[3]), pk2(o[4], o[5]), pk2(o[6], o[7])}; }
        const NbrOff no = nbr_offsets(g);
        if (lane < 48) {
            u32x4 ov = (u32x4){0u, 0u, 0u, 0u};
            if (lane < 36) { const int j = 3072 + lane * 8; const int off = sample ? no.o3 : no.o1;
                const u32x4 pw = *(const u32x4*)(PR + (size_t)g * INWP + j), qw = *(const u32x4*)(PR + (size_t)(g + off) * INWP + j);
                float p[8], q[8], m[8], v[8]; unpack8(pw, p); unpack8(qw, q); ld8(mu + j, m); const float fl = off ? 1.f : 0.f;
#pragma unroll
                for (int i = 0; i < 8; ++i) { const float x = p[i] + m[i] * (q[i] * fl - p[i]); v[i] = lane < 8 ? tanhf(x) : (lane < 16 ? x : sigmoidf_(x)); }
                ov = (u32x4){pk2(v[0], v[1]), pk2(v[2], v[3]), pk2(v[4], v[5]), pk2(v[6], v[7])}; }
            *(u32x4*)(LA + (size_t)g * LAK + lane * 8) = ov; }
    }
}

template <bool SAMPLE>
__device__ __forceinline__ void lru_unit(Frame& F, int uu) {
    constexpr int CH = SAMPLE ? 16 : 64, CHP = CH / 2, NCH = 512 / CHP, NSEG = SAMPLE ? 4 : 1, CL = 16, SEGT = NCH * CL;
    const unsigned* LAB = (const unsigned*)F.out;
    const bf16_t* PROJ = (const bf16_t*)(F.ws + WS_PROJ); bf16_t* MIX = (bf16_t*)(F.ws + WS_H);
    LAS float* cinF = (LAS float*)F.lds;
    LAS float* cinB = (LAS float*)(F.lds + 16384);
    LAS float* aggA = (LAS float*)(F.lds + 32768);
    LAS float* aggB = (LAS float*)(F.lds + 32768 + 4096);
    LAS float* segc = (LAS float*)(F.lds + 32768 + 8192);
    const int tid = F.tid, c = tid / CHP, ch = (tid % CHP) * 2;
    float* nsl = F.out + (size_t)2 * NPTOK * D;
    const int ngrp = LRUW / CH, b = uu / ngrp, cgp = uu % ngrp, chan = cgp * CH + ch;
    const int g0 = SAMPLE ? NPTOK + b * SSEQ : b * PSEQ;
    u32x2 keep[2][SAMPLE ? 1 : CL];
#pragma unroll
    for (int dir = 0; dir < 2; ++dir) {
        LAS float* cin = dir ? cinB : cinF;
        if (c == 0) { segc[ch] = SAMPLE ? F.in[IN_SLRU][(b * 2 + dir) * LRUW + chan] : 0.f; segc[ch + 1] = SAMPLE ? F.in[IN_SLRU][(b * 2 + dir) * LRUW + chan + 1] : 0.f; }
        __syncthreads();
        for (int si = 0; si < NSEG; ++si) { const int s = dir ? NSEG - 1 - si : si;
            const unsigned* p = LAB + ((size_t)(g0 + s * SEGT + c * CL) * 2 + dir) * LRUW + chan;
            u32x2 wv[CL];
#pragma unroll
            for (int i = 0; i < CL; ++i) wv[i] = *(const u32x2*)(p + (size_t)i * 2 * LRUW);
            if (!SAMPLE) {
#pragma unroll
                for (int i = 0; i < CL; ++i) keep[dir][i] = wv[i]; }
            float A0 = 1.f, B0 = 0.f, A1 = 1.f, B1 = 0.f;
            if (dir == 0) {
#pragma unroll
                for (int i = 0; i < CL; ++i) { const float a0 = __expf(bflo(wv[i][0])), a1 = __expf(bflo(wv[i][1])); B0 = a0 * B0 + bfhi(wv[i][0]); A0 *= a0; B1 = a1 * B1 + bfhi(wv[i][1]); A1 *= a1; }
            } else {
#pragma unroll
                for (int i = CL - 1; i >= 0; --i) { const float a0 = __expf(bflo(wv[i][0])), a1 = __expf(bflo(wv[i][1])); B0 = a0 * B0 + bfhi(wv[i][0]); A0 *= a0; B1 = a1 * B1 + bfhi(wv[i][1]); A1 *= a1; }
            }
            aggA[c * CH + ch] = A0; aggB[c * CH + ch] = B0; aggA[c * CH + ch + 1] = A1; aggB[c * CH + ch + 1] = B1;
            __syncthreads();
            if (tid < CH) { float carry = segc[tid];
                for (int k = 0; k < NCH; ++k) { const int cc = dir ? NCH - 1 - k : k; cin[(s * NCH + cc) * CH + tid] = carry; carry = aggA[cc * CH + tid] * carry + aggB[cc * CH + tid]; }
                segc[tid] = carry; }
            __syncthreads();
        }
        if (!SAMPLE && tid < CH) nsl[(size_t)(b * 2 + dir) * LRUW + cgp * CH + tid] = segc[tid];
        __syncthreads();
    }
    for (int s = 0; s < NSEG; ++s) {
        const int gb = g0 + s * SEGT + c * CL;
        const unsigned* pf = LAB + ((size_t)gb * 2 + 0) * LRUW + chan;
        const unsigned* pb = LAB + ((size_t)gb * 2 + 1) * LRUW + chan;
        float hf0[CL], hf1[CL]; float h0 = cinF[(s * NCH + c) * CH + ch], h1 = cinF[(s * NCH + c) * CH + ch + 1];
        u32x2 wv[CL]; unsigned glw[CL];
#pragma unroll
        for (int i = 0; i < CL; ++i) wv[i] = SAMPLE ? *(const u32x2*)(pf + (size_t)i * 2 * LRUW) : keep[0][i];
#pragma unroll
        for (int i = 0; i < CL; ++i) glw[i] = *(const unsigned*)(PROJ + (size_t)(gb + i) * INWP + LRUW + chan);
#pragma unroll
        for (int i = 0; i < CL; ++i) { h0 = __expf(bflo(wv[i][0])) * h0 + bfhi(wv[i][0]); h1 = __expf(bflo(wv[i][1])) * h1 + bfhi(wv[i][1]); hf0[i] = h0; hf1[i] = h1; }
#pragma unroll
        for (int i = 0; i < CL; ++i) wv[i] = SAMPLE ? *(const u32x2*)(pb + (size_t)i * 2 * LRUW) : keep[1][i];
        h0 = cinB[(s * NCH + c) * CH + ch]; h1 = cinB[(s * NCH + c) * CH + ch + 1];
#pragma unroll
        for (int i = CL - 1; i >= 0; --i) { h0 = __expf(bflo(wv[i][0])) * h0 + bfhi(wv[i][0]); h1 = __expf(bflo(wv[i][1])) * h1 + bfhi(wv[i][1]);
            *(unsigned*)(MIX + (size_t)(gb + i) * D + chan) = pk2((hf0[i] + h0) * gelu_tanh(bflo(glw[i])), (hf1[i] + h1) * gelu_tanh(bfhi(glw[i]))); }
    }
    __syncthreads();
}
__device__ __forceinline__ void p5_lru_scan(Frame& F) {
    const int half = F.G / 2;
    if ((int)blockIdx.x < half) { for (int u = blockIdx.x; u < 128; u += half) lru_unit<true>(F, u); }
    else { for (int u = blockIdx.x - half; u < 512; u += F.G - half) lru_unit<false>(F, u); }
}

struct WkvJob { int g0; int gstep; bool sample; int h; int dir; const float* S0; float* Sout; bf16_t* Y; int ypitch; };
constexpr int WNS = 8;
constexpr int WKV_LDS_PER_WAVE = (6 * WNS * 64 + WNS * 64) * 4;
template <int KIND, bool HAS_S0>
__device__ __forceinline__ void wkv_unit(Frame& F, const WkvJob& J) {
    const int lane = F.lane, vi = lane >> 3, ki = lane & 7;
    LAS float* L = (LAS float*)(F.lds + F.wave * WKV_LDS_PER_WAVE);
    LAS float* Ys = L + 6 * WNS * 64;
    const bf16_t* PR = (const bf16_t*)(F.ws + WS_PROJ) + 2048;
    const bf16_t* Eb = (const bf16_t*)F.out; const bf16_t* Ab = Eb + (size_t)NTOK * 2 * RW;
    const int ch8 = J.h * 64 + ki * 8, dir = J.dir;
    const int kd_r = nbr_kind(J.sample, ch8), kd_k = nbr_kind(J.sample, 1024 + ch8), kd_v = nbr_kind(J.sample, 2048 + ch8);
    float mu_r[8], mu_k[8], mu_v[8], k_k[8], k_a[8];
    ld8(F.in[IN_MU] + ch8, mu_r); ld8(F.in[IN_MU] + 1024 + ch8, mu_k); ld8(F.in[IN_MU] + 2048 + ch8, mu_v); ld8(F.in[IN_KK] + ch8, k_k); ld8(F.in[IN_KA] + ch8, k_a);
    f32x2 S[8][4];
    if (HAS_S0) {
#pragma unroll
        for (int i = 0; i < 8; ++i) { float t[8]; ld8(J.S0 + (vi * 8 + i) * 64 + ki * 8, t);
#pragma unroll
            for (int jp = 0; jp < 4; ++jp) S[i][jp] = (f32x2){t[2 * jp], t[2 * jp + 1]}; }
    } else {
#pragma unroll
        for (int i = 0; i < 8; ++i)
#pragma unroll
            for (int jp = 0; jp < 4; ++jp) S[i][jp] = (f32x2){(KIND == 1 && vi == ki && i == 2 * jp) ? 1.f : 0.f, (KIND == 1 && vi == ki && i == 2 * jp + 1) ? 1.f : 0.f};
    }
    u32x4 ro, rn, ko, kn, vo, vn, ee, aa; int vflags = 0;
#define WKV_FETCH(mc) do { const int g = J.g0 + ((mc) * WNS + vi) * J.gstep; const NbrOff no = nbr_offsets(g); \
        const int ofr = nbr_pick(no, kd_r), ofk = nbr_pick(no, kd_k), ofv = nbr_pick(no, kd_v); \
        vflags = (ofr ? 1 : 0) | (ofk ? 2 : 0) | (ofv ? 4 : 0); \
        const bf16_t* pg = PR + (size_t)g * INWP + ch8; \
        ro = *(const u32x4*)pg; rn = *(const u32x4*)(pg + (ptrdiff_t)ofr * INWP); ko = *(const u32x4*)(pg + 1024); kn = *(const u32x4*)(pg + (ptrdiff_t)ofk * INWP + 1024); \
        if (KIND != 1) { vo = *(const u32x4*)(pg + 2048); vn = *(const u32x4*)(pg + (ptrdiff_t)ofv * INWP + 2048); } \
        ee = *(const u32x4*)(Eb + ((size_t)g * 2 + dir) * RW + ch8); aa = *(const u32x4*)(Ab + ((size_t)g * 2 + dir) * RW + ch8); } while (0)
#define WKV_CONVERT() do { float t0[8], t1[8], rr[8], kx[8], kk[8], o[8]; \
        unpack8(ro, t0); unpack8(rn, t1); const float fr_ = (vflags & 1) ? 1.f : 0.f, fk_ = (vflags & 2) ? 1.f : 0.f, fv_ = (vflags & 4) ? 1.f : 0.f; \
        _Pragma("unroll") for (int i = 0; i < 8; ++i) rr[i] = t0[i] + mu_r[i] * (t1[i] * fr_ - t0[i]); \
        lds_st8(L + (4 * WNS + vi) * 64 + ki * 8, rr); \
        unpack8(ko, t0); unpack8(kn, t1); float ssq = 0.f; \
        _Pragma("unroll") for (int i = 0; i < 8; ++i) { kx[i] = t0[i] + mu_k[i] * (t1[i] * fk_ - t0[i]); kk[i] = kx[i] * k_k[i]; ssq += kk[i] * kk[i]; } \
        ssq = red8(ssq); const float rs = rsqrtf(fmaxf(ssq, 1e-24f)); \
        unpack8(aa, t1); unpack8(ee, t0); \
        _Pragma("unroll") for (int i = 0; i < 8; ++i) { kk[i] *= rs; o[i] = -kk[i]; } \
        lds_st8(L + (1 * WNS + vi) * 64 + ki * 8, o); \
        _Pragma("unroll") for (int i = 0; i < 8; ++i) o[i] = kk[i] * t1[i]; \
        lds_st8(L + (2 * WNS + vi) * 64 + ki * 8, o); \
        _Pragma("unroll") for (int i = 0; i < 8; ++i) o[i] = __expf(-t0[i]); \
        lds_st8(L + (0 * WNS + vi) * 64 + ki * 8, o); \
        if (KIND != 1) { \
            _Pragma("unroll") for (int i = 0; i < 8; ++i) o[i] = kx[i] * (1.f + (t1[i] - 1.f) * k_a[i]); \
            lds_st8(L + (3 * WNS + vi) * 64 + ki * 8, o); \
            unpack8(vo, t0); unpack8(vn, t1); \
            _Pragma("unroll") for (int i = 0; i < 8; ++i) o[i] = t0[i] + mu_v[i] * (t1[i] * fv_ - t0[i]); \
            lds_st8(L + (5 * WNS + vi) * 64 + ki * 8, o); } } while (0)
    WKV_FETCH(0);
    WKV_CONVERT();
    for (int mc = 0; mc < 256 / WNS; ++mc) {
        if (mc + 1 < 256 / WNS) WKV_FETCH(mc + 1);
#pragma unroll 2
        for (int s = 0; s < WNS; ++s) {
            f32x2 w[4], kk[4], kka[4], kd[4], r[4], vp[4];
#define WKV_LD8(dst, arr, off) do { const f32x4 _a = *(const LAS f32x4*)(L + ((arr) * WNS + s) * 64 + (off)), _b = *(const LAS f32x4*)(L + ((arr) * WNS + s) * 64 + (off) + 4); \
            dst[0] = (f32x2){_a[0], _a[1]}; dst[1] = (f32x2){_a[2], _a[3]}; dst[2] = (f32x2){_b[0], _b[1]}; dst[3] = (f32x2){_b[2], _b[3]}; } while (0)
            WKV_LD8(w, 0, ki * 8); WKV_LD8(kk, 1, ki * 8); WKV_LD8(kka, 2, ki * 8);
            if (KIND != 1) { WKV_LD8(kd, 3, ki * 8); WKV_LD8(vp, 5, vi * 8); }
            if (KIND == 0) WKV_LD8(r, 4, ki * 8);
            f32x2 acc[8]; float sa[8];
            pk_mul8(acc, S[0][0], S[1][0], S[2][0], S[3][0], S[4][0], S[5][0], S[6][0], S[7][0], kk[0]);
#pragma unroll
            for (int jp = 1; jp < 4; ++jp) pk_mac8(acc, S[0][jp], S[1][jp], S[2][jp], S[3][jp], S[4][jp], S[5][jp], S[6][jp], S[7][jp], kk[jp]);
#pragma unroll
            for (int i = 0; i < 8; ++i) sa[i] = vadd(acc[i][0], acc[i][1]);
            red8x8(sa);
            f32x2 sap[4];
#pragma unroll
            for (int p = 0; p < 4; ++p) sap[p] = (f32x2){sa[2 * p], sa[2 * p + 1]};
#pragma unroll
            for (int jp = 0; jp < 4; ++jp) pk_upd8<KIND != 1>(S[0][jp], S[1][jp], S[2][jp], S[3][jp], S[4][jp], S[5][jp], S[6][jp], S[7][jp], sap, vp, w[jp], kka[jp], kd[jp]);
            if (KIND == 0) {
                float y[8];
                pk_mul8(acc, S[0][0], S[1][0], S[2][0], S[3][0], S[4][0], S[5][0], S[6][0], S[7][0], r[0]);
#pragma unroll
                for (int jp = 1; jp < 4; ++jp) pk_mac8(acc, S[0][jp], S[1][jp], S[2][jp], S[3][jp], S[4][jp], S[5][jp], S[6][jp], S[7][jp], r[jp]);
#pragma unroll
                for (int i = 0; i < 8; ++i) y[i] = vadd(acc[i][0], acc[i][1]);
                red8x8(y);
                if (ki == 0) lds_st8(Ys + s * 64 + vi * 8, y);
            }
        }
        if (KIND == 0) {
            const f32x4 a = *(const LAS f32x4*)(Ys + vi * 64 + ki * 8), b = *(const LAS f32x4*)(Ys + vi * 64 + ki * 8 + 4);
            const int g = J.g0 + (mc * WNS + vi) * J.gstep;
            *(u32x4*)(J.Y + (size_t)g * J.ypitch + ch8) = (u32x4){pk2(a[0], a[1]), pk2(a[2], a[3]), pk2(b[0], b[1]), pk2(b[2], b[3])};
        }
        if (mc + 1 < 256 / WNS) WKV_CONVERT();
    }
    if (J.Sout) {
#pragma unroll
        for (int i = 0; i < 8; ++i) { float* d = J.Sout + (vi * 8 + i) * 64 + ki * 8;
            *(float4*)d = make_float4(S[i][0][0], S[i][0][1], S[i][1][0], S[i][1][1]); *(float4*)(d + 4) = make_float4(S[i][2][0], S[i][2][1], S[i][3][0], S[i][3][1]); }
    }
#undef WKV_FETCH
#undef WKV_CONVERT
#undef WKV_LD8
}

typedef __bf16 bf16x2_t __attribute__((ext_vector_type(2)));
__device__ __forceinline__ unsigned cvt2(f32x2 v) { return __builtin_bit_cast(unsigned, __builtin_convertvector(v, bf16x2_t)); }
#define BLO " op_sel:[0,0,0] op_sel_hi:[0,1,1]"
#define BHI " op_sel:[1,0,0] op_sel_hi:[1,1,1]"
template <bool HASV>
__device__ __forceinline__ void pk_upd8m(f32x2& s0, f32x2& s1, f32x2& s2, f32x2& s3, f32x2& s4, f32x2& s5, f32x2& s6, f32x2& s7, const f32x2 (&sv)[4],
                                         f32x2 w0, f32x2 w1, f32x2 ka0, f32x2 ka1, f32x2 kd0, f32x2 kd1) {
    if (HASV)
        asm("v_pk_mul_f32 %0, %0, %12\n\tv_pk_mul_f32 %1, %1, %13\n\tv_pk_mul_f32 %2, %2, %12\n\tv_pk_mul_f32 %3, %3, %13\n\tv_pk_mul_f32 %4, %4, %12\n\tv_pk_mul_f32 %5, %5, %13\n\tv_pk_mul_f32 %6, %6, %12\n\tv_pk_mul_f32 %7, %7, %13\n\t"
            "v_pk_fma_f32 %0, %8, %14, %0" BLO "\n\tv_pk_fma_f32 %1, %8, %15, %1" BLO "\n\tv_pk_fma_f32 %2, %9, %14, %2" BLO "\n\tv_pk_fma_f32 %3, %9, %15, %3" BLO "\n\t"
            "v_pk_fma_f32 %4, %10, %14, %4" BLO "\n\tv_pk_fma_f32 %5, %10, %15, %5" BLO "\n\tv_pk_fma_f32 %6, %11, %14, %6" BLO "\n\tv_pk_fma_f32 %7, %11, %15, %7" BLO "\n\t"
            "v_pk_fma_f32 %0, %8, %16, %0" BHI "\n\tv_pk_fma_f32 %1, %8, %17, %1" BHI "\n\tv_pk_fma_f32 %2, %9, %16, %2" BHI "\n\tv_pk_fma_f32 %3, %9, %17, %3" BHI "\n\t"
            "v_pk_fma_f32 %4, %10, %16, %4" BHI "\n\tv_pk_fma_f32 %5, %10, %17, %5" BHI "\n\tv_pk_fma_f32 %6, %11, %16, %6" BHI "\n\tv_pk_fma_f32 %7, %11, %17, %7" BHI
            : "+v"(s0), "+v"(s1), "+v"(s2), "+v"(s3), "+v"(s4), "+v"(s5), "+v"(s6), "+v"(s7)
            : "v"(sv[0]), "v"(sv[1]), "v"(sv[2]), "v"(sv[3]), "v"(w0), "v"(w1), "v"(ka0), "v"(ka1), "v"(kd0), "v"(kd1));
    else
        asm("v_pk_mul_f32 %0, %0, %12\n\tv_pk_mul_f32 %1, %1, %13\n\tv_pk_mul_f32 %2, %2, %12\n\tv_pk_mul_f32 %3, %3, %13\n\tv_pk_mul_f32 %4, %4, %12\n\tv_pk_mul_f32 %5, %5, %13\n\tv_pk_mul_f32 %6, %6, %12\n\tv_pk_mul_f32 %7, %7, %13\n\t"
            "v_pk_fma_f32 %0, %8, %14, %0" BLO "\n\tv_pk_fma_f32 %1, %8, %15, %1" BLO "\n\tv_pk_fma_f32 %2, %9, %14, %2" BLO "\n\tv_pk_fma_f32 %3, %9, %15, %3" BLO "\n\t"
            "v_pk_fma_f32 %4, %10, %14, %4" BLO "\n\tv_pk_fma_f32 %5, %10, %15, %5" BLO "\n\tv_pk_fma_f32 %6, %11, %14, %6" BLO "\n\tv_pk_fma_f32 %7, %11, %15, %7" BLO
            : "+v"(s0), "+v"(s1), "+v"(s2), "+v"(s3), "+v"(s4), "+v"(s5), "+v"(s6), "+v"(s7)
            : "v"(sv[0]), "v"(sv[1]), "v"(sv[2]), "v"(sv[3]), "v"(w0), "v"(w1), "v"(ka0), "v"(ka1));
}
#undef BLO
#undef BHI
constexpr int WKM_LDS_PER_WAVE = 12352;
template <int KIND, bool HAS_S0>
__device__ __forceinline__ void wkv_unit_m(Frame& F, const WkvJob& J) {
    const int lane = F.lane, vi = lane >> 3, ki = lane & 7;
    const int nl = lane & 15, q = lane >> 4;
    constexpr bool HASV = (KIND == 0 || KIND == 2), HASY = (KIND == 0 || KIND == 3), IDENT = (KIND == 1 || KIND == 3);
    LAS float* LW = (LAS float*)(F.lds + F.wave * WKM_LDS_PER_WAVE);
    LAS float* LKA = LW + 512; LAS float* LKD = LW + 1024; LAS float* LV = LW + 1536; LAS float* Ys = LW + 2048; LAS float* LC = LW + 2560;
    LAS bf16_t* LNK = (LAS bf16_t*)(LW + 2576); LAS bf16_t* LWR = LNK + 512;
    const bf16_t* PR = (const bf16_t*)(F.ws + WS_PROJ) + 2048;
    const bf16_t* Eb = (const bf16_t*)F.out; const bf16_t* Ab = Eb + (size_t)NTOK * 2 * RW;
    const int ch8 = J.h * 64 + ki * 8, dir = J.dir;
    const int kd_r = nbr_kind(J.sample, ch8), kd_k = nbr_kind(J.sample, 1024 + ch8), kd_v = nbr_kind(J.sample, 2048 + ch8);
    float one; asm volatile("v_mov_b32 %0, 1.0" : "=v"(one));
    f32x2 S[4][2][4];
#pragma unroll
    for (int tn = 0; tn < 4; ++tn)
#pragma unroll
        for (int ks = 0; ks < 2; ++ks) {
            if (HAS_S0) { float t[8]; ld8(J.S0 + (16 * tn + nl) * 64 + 32 * ks + 8 * q, t);
#pragma unroll
                for (int jp = 0; jp < 4; ++jp) S[tn][ks][jp] = (f32x2){t[2 * jp], t[2 * jp + 1]}; }
            else {
#pragma unroll
                for (int jp = 0; jp < 4; ++jp) { const int row = 16 * tn + nl, col = 32 * ks + 8 * q + 2 * jp;
                    S[tn][ks][jp] = (f32x2){(IDENT && row == col) ? 1.f : 0.f, (IDENT && row == col + 1) ? 1.f : 0.f}; } }
        }
    u32x4 ro, rn, ko, kn, vo, vn, ee, aa; int vflags = 0;
#define WKV_FETCH(mc) do { const int g = J.g0 + ((mc) * WNS + vi) * J.gstep; const NbrOff no = nbr_offsets(g); \
        const int ofr = nbr_pick(no, kd_r), ofk = nbr_pick(no, kd_k), ofv = nbr_pick(no, kd_v); \
        vflags = (ofr ? 1 : 0) | (ofk ? 2 : 0) | (ofv ? 4 : 0); \
        const bf16_t* pg = PR + (size_t)g * INWP + ch8; \
        ko = *(const u32x4*)(pg + 1024); kn = *(const u32x4*)(pg + (ptrdiff_t)ofk * INWP + 1024); \
        if (HASY) { ro = *(const u32x4*)pg; rn = *(const u32x4*)(pg + (ptrdiff_t)ofr * INWP); } \
        if (HASV) { vo = *(const u32x4*)(pg + 2048); vn = *(const u32x4*)(pg + (ptrdiff_t)ofv * INWP + 2048); } \
        ee = *(const u32x4*)(Eb + ((size_t)g * 2 + dir) * RW + ch8); aa = *(const u32x4*)(Ab + ((size_t)g * 2 + dir) * RW + ch8); } while (0)
#define WKV_CONVERT() do { float t0[8], t1[8], m[8], rr[8], kx[8], kk[8], wv[8], o[8]; \
        const float fr_ = (vflags & 1) ? 1.f : 0.f, fk_ = (vflags & 2) ? 1.f : 0.f, fv_ = (vflags & 4) ? 1.f : 0.f; \
        unpack8(ko, t0); unpack8(kn, t1); ld8(F.in[IN_MU] + 1024 + ch8, m); float ssq = 0.f; \
        _Pragma("unroll") for (int i = 0; i < 8; ++i) kx[i] = t0[i] + m[i] * (t1[i] * fk_ - t0[i]); \
        ld8(F.in[IN_KK] + ch8, m); \
        _Pragma("unroll") for (int i = 0; i < 8; ++i) { kk[i] = kx[i] * m[i]; ssq += kk[i] * kk[i]; } \
        ssq = red8(ssq); const float rs = rsqrtf(fmaxf(ssq, 1e-24f)); \
        _Pragma("unroll") for (int i = 0; i < 8; ++i) kk[i] *= rs; \
        *(LAS u32x4*)(LNK + vi * 64 + ki * 8) = (u32x4){pk2(-kk[0], -kk[1]), pk2(-kk[2], -kk[3]), pk2(-kk[4], -kk[5]), pk2(-kk[6], -kk[7])}; \
        unpack8(aa, t1); unpack8(ee, t0); \
        _Pragma("unroll") for (int i = 0; i < 8; ++i) { wv[i] = __expf(-t0[i]); kk[i] *= t1[i]; } \
        lds_st8(LW + vi * 64 + ki * 8, wv); lds_st8(LKA + vi * 64 + ki * 8, kk); \
        float km[8]; if (HASV && HASY) { _Pragma("unroll") for (int i = 0; i < 8; ++i) km[i] = kx[i]; } \
        if (HASV) { ld8(F.in[IN_KA] + ch8, m); \
            _Pragma("unroll") for (int i = 0; i < 8; ++i) kx[i] = kx[i] * (1.f + (t1[i] - 1.f) * m[i]); \
            lds_st8(LKD + vi * 64 + ki * 8, kx); \
            unpack8(vo, t0); unpack8(vn, t1); ld8(F.in[IN_MU] + 2048 + ch8, m); \
            _Pragma("unroll") for (int i = 0; i < 8; ++i) o[i] = t0[i] + m[i] * (t1[i] * fv_ - t0[i]); \
            lds_st8(LV + vi * 64 + ki * 8, o); } \
        if (HASY) { unpack8(ro, t0); unpack8(rn, t1); ld8(F.in[IN_MU] + ch8, m); float c1 = 0.f, c2 = 0.f; \
            _Pragma("unroll") for (int i = 0; i < 8; ++i) { rr[i] = t0[i] + m[i] * (t1[i] * fr_ - t0[i]); c1 += kk[i] * rr[i]; if (HASV) c2 += kx[i] * rr[i]; wv[i] *= rr[i]; } \
            if (HASV && dir == 0) { ld8(F.in[IN_RK] + ch8, m); _Pragma("unroll") for (int i = 0; i < 8; ++i) c2 += rr[i] * km[i] * m[i]; } \
            c1 = red8(c1); c2 = red8(c2); if (ki == 0) { LC[vi * 2] = c1; LC[vi * 2 + 1] = c2; } \
            *(LAS u32x4*)(LWR + vi * 64 + ki * 8) = (u32x4){pk2(wv[0], wv[1]), pk2(wv[2], wv[3]), pk2(wv[4], wv[5]), pk2(wv[6], wv[7])}; } } while (0)
    WKV_FETCH(0);
    WKV_CONVERT();
    for (int mc = 0; mc < 256 / WNS; ++mc) {
        if (mc + 1 < 256 / WNS) WKV_FETCH(mc + 1);
#pragma unroll 1
        for (int s = 0; s < WNS; ++s) {
            f32x2 w[2][4], ka[2][4], kd[2][4]; bf16x8 af[2]; float v[4];
#pragma unroll
            for (int ks = 0; ks < 2; ++ks) { const int o = s * 64 + 32 * ks + 8 * q;
                { const f32x4 a = *(const LAS f32x4*)(LW + o), b = *(const LAS f32x4*)(LW + o + 4); w[ks][0] = (f32x2){a[0], a[1]}; w[ks][1] = (f32x2){a[2], a[3]}; w[ks][2] = (f32x2){b[0], b[1]}; w[ks][3] = (f32x2){b[2], b[3]}; }
                { const f32x4 a = *(const LAS f32x4*)(LKA + o), b = *(const LAS f32x4*)(LKA + o + 4); ka[ks][0] = (f32x2){a[0], a[1]}; ka[ks][1] = (f32x2){a[2], a[3]}; ka[ks][2] = (f32x2){b[0], b[1]}; ka[ks][3] = (f32x2){b[2], b[3]}; }
                if (HASV) { const f32x4 a = *(const LAS f32x4*)(LKD + o), b = *(const LAS f32x4*)(LKD + o + 4); kd[ks][0] = (f32x2){a[0], a[1]}; kd[ks][1] = (f32x2){a[2], a[3]}; kd[ks][2] = (f32x2){b[0], b[1]}; kd[ks][3] = (f32x2){b[2], b[3]}; }
                af[ks] = *(const LAS bf16x8*)(((HASY && (nl & 1)) ? LWR : LNK) + o); }
#pragma unroll
            for (int tn = 0; tn < 4; ++tn) v[tn] = HASV ? LV[s * 64 + 16 * tn + nl] : 0.f;
            f32x4 d[4];
#pragma unroll
            for (int tn = 0; tn < 4; ++tn) { d[tn] = (f32x4){0.f, 0.f, 0.f, 0.f};
#pragma unroll
                for (int ks = 0; ks < 2; ++ks) { const u32x4 bw = (u32x4){cvt2(S[tn][ks][0]), cvt2(S[tn][ks][1]), cvt2(S[tn][ks][2]), cvt2(S[tn][ks][3])};
                    d[tn] = __builtin_amdgcn_mfma_f32_16x16x32_bf16(af[ks], __builtin_bit_cast(bf16x8, bw), d[tn], 0, 0, 0); } }
            f32x2 sv[4];
#pragma unroll
            for (int tn = 0; tn < 4; ++tn) sv[tn] = (f32x2){d[tn][0] * one, v[tn]};
#pragma unroll
            for (int jp = 0; jp < 4; ++jp)
                pk_upd8m<HASV>(S[0][0][jp], S[0][1][jp], S[1][0][jp], S[1][1][jp], S[2][0][jp], S[2][1][jp], S[3][0][jp], S[3][1][jp], sv, w[0][jp], w[1][jp], ka[0][jp], ka[1][jp], kd[0][jp], kd[1][jp]);
            if (HASY) { const float c1 = LC[s * 2], c2 = HASV ? LC[s * 2 + 1] : 0.f;
#pragma unroll
                for (int tn = 0; tn < 4; ++tn) { const float y = d[tn][1] + sv[tn][0] * c1 + v[tn] * c2; if (q == 0) Ys[s * 64 + 16 * tn + nl] = y; } }
        }
        if (HASY) {
            const f32x4 a = *(const LAS f32x4*)(Ys + vi * 64 + ki * 8), b = *(const LAS f32x4*)(Ys + vi * 64 + ki * 8 + 4);
            const int g = J.g0 + (mc * WNS + vi) * J.gstep;
            *(u32x4*)(J.Y + (size_t)g * J.ypitch + ch8) = (u32x4){pk2(a[0], a[1]), pk2(a[2], a[3]), pk2(b[0], b[1]), pk2(b[2], b[3])};
        }
        if (mc + 1 < 256 / WNS) WKV_CONVERT();
    }
    if (J.Sout) {
#pragma unroll
        for (int tn = 0; tn < 4; ++tn)
#pragma unroll
            for (int ks = 0; ks < 2; ++ks) { float* dp = J.Sout + (16 * tn + nl) * 64 + 32 * ks + 8 * q;
                *(float4*)dp = make_float4(S[tn][ks][0][0], S[tn][ks][0][1], S[tn][ks][1][0], S[tn][ks][1][1]); *(float4*)(dp + 4) = make_float4(S[tn][ks][2][0], S[tn][ks][2][1], S[tn][ks][3][0], S[tn][ks][3][1]); }
    }
#undef WKV_FETCH
#undef WKV_CONVERT
}
#ifndef WKV_MFMA
#define WKV_MFMA 1
#endif
#if WKV_MFMA
#define WKV_UNIT wkv_unit_m
#else
#define WKV_UNIT wkv_unit
#endif

__device__ __forceinline__ void p7_job_sample(WkvJob& J, float* PQ, int uq, int pq) {
    const int h = uq & 15, dir = (uq >> 4) & 1, chunk = (uq >> 5) & 15, b = uq >> 9;
    const int tt0 = chunk * 256, t0 = dir ? SSEQ - 1 - tt0 : tt0;
    J.sample = true; J.h = h; J.dir = dir; J.g0 = NPTOK + b * SSEQ + t0; J.gstep = dir ? -1 : 1; J.S0 = nullptr; J.Y = nullptr; J.ypitch = 0;
    const int chain = (b * 2 + dir) * 16 + h;
    J.Sout = PQ + ((size_t)(chain * 16 + chunk) * 2 + pq) * 4096;
}
__device__ __forceinline__ void p7_wkv_pass1(Frame& F) {
    float* PQ = (float*)(F.ws + WS_PQ); float* nsw = F.out + (size_t)2 * NPTOK * D + 32 * 2 * LRUW;
    bf16_t* MIX = (bf16_t*)(F.ws + WS_H); bf16_t* YB = (bf16_t*)(F.ws + WS_YB); bf16_t* PRB = (bf16_t*)(F.ws + WS_PRB);
    const int kindQ = (F.wave ^ (F.wave >> 2)) & 1;
    for (int bb = blockIdx.x; bb < 256; bb += F.G) { const int uq = bb * 4 + (F.wave & 3); WkvJob J;
        if (!kindQ) { const int h = uq & 15, dir = (uq >> 4) & 1, b = uq >> 5;
            J.sample = false; J.h = h; J.dir = dir; J.g0 = b * PSEQ + (dir ? PSEQ - 1 : 0); J.gstep = dir ? -1 : 1; J.S0 = nullptr;
            J.Sout = nsw + (size_t)((b * 2 + dir) * 16 + h) * 4096; }
        else p7_job_sample(J, PQ, uq, 1);
        J.Y = J.dir ? YB : MIX + 1024; J.ypitch = J.dir ? RW : D;
        wkv_unit_m<0, false>(F, J); }
    if (F.wave < 4) {
        for (int bb = blockIdx.x; bb < 256; bb += F.G) { WkvJob J; p7_job_sample(J, PQ, bb * 4 + F.wave, 0);
            J.Y = PRB + (ptrdiff_t)J.dir * RW - (ptrdiff_t)NPTOK * 2 * RW; J.ypitch = 2 * RW;
            wkv_unit_m<3, false>(F, J); }
    } else {
        xpose_deferred(F, false, blockIdx.x * 4 + (F.wave - 4), F.G * 4, (LAS bf16_t*)(F.lds + F.wave * WKM_LDS_PER_WAVE));
    }
}
__device__ __forceinline__ void p8_wkv_combine(Frame& F) {
    float* PQ = (float*)(F.ws + WS_PQ);
    LAS float* Sl = (LAS float*)F.lds; LAS float* Pl = (LAS float*)(F.lds + 16384);
    const int tid = F.tid, v = tid >> 3, kq = tid & 7;
    for (int chain = blockIdx.x; chain < 64; chain += F.G) {
        const float* s0 = F.in[IN_SWKV] + (size_t)chain * 4096;
        __syncthreads();
        { const float4 a = *(const float4*)(s0 + tid * 8), b = *(const float4*)(s0 + tid * 8 + 4);
          *(LAS f32x4*)(Sl + tid * 8) = (f32x4){a.x, a.y, a.z, a.w}; *(LAS f32x4*)(Sl + tid * 8 + 4) = (f32x4){b.x, b.y, b.z, b.w}; }
        const float* P0 = PQ + ((size_t)(chain * 16) * 2 + 0) * 4096; const float* Q0 = PQ + ((size_t)(chain * 16) * 2 + 1) * 4096;
        float4 pa = *(const float4*)(P0 + tid * 8), pb = *(const float4*)(P0 + tid * 8 + 4), qa = *(const float4*)(Q0 + v * 64 + kq * 8), qb = *(const float4*)(Q0 + v * 64 + kq * 8 + 4);
        for (int c = 0; c < 15; ++c) {
            float* Qc = PQ + ((size_t)(chain * 16 + c) * 2 + 1) * 4096;
            *(LAS f32x4*)(Pl + tid * 8) = (f32x4){pa.x, pa.y, pa.z, pa.w}; *(LAS f32x4*)(Pl + tid * 8 + 4) = (f32x4){pb.x, pb.y, pb.z, pb.w};
            float acc[8] = {qa.x, qa.y, qa.z, qa.w, qb.x, qb.y, qb.z, qb.w};
            if (c + 1 < 15) { const float* Pn = PQ + ((size_t)(chain * 16 + c + 1) * 2 + 0) * 4096; const float* Qn = Pn + 4096;
                pa = *(const float4*)(Pn + tid * 8); pb = *(const float4*)(Pn + tid * 8 + 4); qa = *(const float4*)(Qn + v * 64 + kq * 8); qb = *(const float4*)(Qn + v * 64 + kq * 8 + 4); }
            __syncthreads();
#pragma unroll 8
            for (int k = 0; k < 64; ++k) { const float s = Sl[v * 64 + k]; const f32x4 p0 = *(const LAS f32x4*)(Pl + k * 64 + kq * 8), p1 = *(const LAS f32x4*)(Pl + k * 64 + kq * 8 + 4);
                acc[0] += s * p0[0]; acc[1] += s * p0[1]; acc[2] += s * p0[2]; acc[3] += s * p0[3]; acc[4] += s * p1[0]; acc[5] += s * p1[1]; acc[6] += s * p1[2]; acc[7] += s * p1[3]; }
            __syncthreads();
            *(LAS f32x4*)(Sl + v * 64 + kq * 8) = (f32x4){acc[0], acc[1], acc[2], acc[3]}; *(LAS f32x4*)(Sl + v * 64 + kq * 8 + 4) = (f32x4){acc[4], acc[5], acc[6], acc[7]};
            *(float4*)(Qc + v * 64 + kq * 8) = make_float4(acc[0], acc[1], acc[2], acc[3]); *(float4*)(Qc + v * 64 + kq * 8 + 4) = make_float4(acc[4], acc[5], acc[6], acc[7]);
        }
    }
}
__device__ __forceinline__ void p9_wkv_pass3(Frame& F) {
    float* PQ = (float*)(F.ws + WS_PQ); bf16_t* MIX = (bf16_t*)(F.ws + WS_H); bf16_t* YB = (bf16_t*)(F.ws + WS_YB); const bf16_t* PRB = (const bf16_t*)(F.ws + WS_PRB);
    const int nl = F.lane & 15, q = F.lane >> 4;
    for (int u = blockIdx.x * 8 + F.wave; u < 1024; u += F.G * 8) {
        const int h = u & 15, dir = (u >> 4) & 1, chunk = (u >> 5) & 15, b = u >> 9;
        const int tt0 = chunk * 256, t0 = dir ? SSEQ - 1 - tt0 : tt0, chain = (b * 2 + dir) * 16 + h, gstep = dir ? -1 : 1, g0 = NPTOK + b * SSEQ + t0;
        const float* Sc = chunk == 0 ? F.in[IN_SWKV] + (size_t)chain * 4096 : PQ + ((size_t)(chain * 16 + chunk - 1) * 2 + 1) * 4096;
        bf16_t* Y = dir ? YB : MIX + 1024; const int ypitch = dir ? RW : D;
        bf16x8 a[4][2];
#pragma unroll
        for (int mt = 0; mt < 4; ++mt)
#pragma unroll
            for (int ks = 0; ks < 2; ++ks) { float t[8]; ld8(Sc + (16 * mt + nl) * 64 + 32 * ks + 8 * q, t);
                const u32x4 w = (u32x4){pk2(t[0], t[1]), pk2(t[2], t[3]), pk2(t[4], t[5]), pk2(t[6], t[7])}; a[mt][ks] = __builtin_bit_cast(bf16x8, w); }
#pragma unroll 2
        for (int nt = 0; nt < 16; ++nt) { const int g = g0 + (16 * nt + nl) * gstep;
            const bf16_t* pr = PRB + ((size_t)(g - NPTOK) * 2 + dir) * RW + h * 64 + 8 * q;
            const bf16x8 b0 = *(const bf16x8*)pr, b1 = *(const bf16x8*)(pr + 32);
            bf16_t* yp = Y + (size_t)g * ypitch + h * 64 + 4 * q;
#pragma unroll
            for (int mt = 0; mt < 4; ++mt) { f32x4 d = (f32x4){0.f, 0.f, 0.f, 0.f};
                d = __builtin_amdgcn_mfma_f32_16x16x32_bf16(a[mt][0], b0, d, 0, 0, 0); d = __builtin_amdgcn_mfma_f32_16x16x32_bf16(a[mt][1], b1, d, 0, 0, 0);
                const u32x2 yq = *(const u32x2*)(yp + 16 * mt);
                *(u32x2*)(yp + 16 * mt) = (u32x2){pk2(bflo(yq[0]) + d[0], bfhi(yq[0]) + d[1]), pk2(bflo(yq[1]) + d[2], bfhi(yq[1]) + d[3])}; } }
    }
}

__device__ __forceinline__ void p10_wkv_finish(Frame& F) {
    bf16_t* MIX = (bf16_t*)(F.ws + WS_H);
    const bf16_t* YB = (const bf16_t*)(F.ws + WS_YB); const bf16_t* Gt = (const bf16_t*)(F.ws + WS_G);
    const float* lnw = F.in[IN_LNW]; const float* lnb = F.in[IN_LNB];
    const int t8 = F.lane >> 3, cg8 = (F.lane & 7) * 8;
    for (int gb = (blockIdx.x * 8 + F.wave) * 8; gb < NTOK; gb += F.G * 64) {
        const int g = gb + t8;
#pragma unroll 4
        for (int h = 0; h < NH; ++h) { const int ch8 = h * 64 + cg8;
            const u32x4 yfw = *(const u32x4*)(MIX + (size_t)g * D + 1024 + ch8), ybw = *(const u32x4*)(YB + (size_t)g * RW + ch8), gw = *(const u32x4*)(Gt + (size_t)g * RW + ch8);
            float a[8], b[8], m[8], y[8];
            unpack8(yfw, a); unpack8(ybw, b); float sm = 0.f;
#pragma unroll
            for (int i = 0; i < 8; ++i) { y[i] = a[i] + b[i]; sm += y[i]; }
            const float mean = red8(sm) * (1.f / 64.f); float sq = 0.f;
#pragma unroll
            for (int i = 0; i < 8; ++i) { y[i] -= mean; sq += y[i] * y[i]; }
            const float rstd = rsqrtf(red8(sq) * (1.f / 64.f) + 64e-5f);
            ld8(lnw + ch8, a); ld8(lnb + ch8, b); unpack8(gw, m);
#pragma unroll
            for (int i = 0; i < 8; ++i) y[i] = (y[i] * rstd * a[i] + b[i]) * m[i];
            *(u32x4*)(MIX + (size_t)g * D + 1024 + ch8) = (u32x4){pk2(y[0], y[1]), pk2(y[2], y[3]), pk2(y[4], y[5]), pk2(y[6], y[7])}; }
    }
    xpose_deferred(F, true, blockIdx.x * 8 + F.wave, F.G * 8, (LAS bf16_t*)(F.lds + F.wave * 8704));
}

__device__ __forceinline__ void p12_rows(Frame& F) {
    const float* MOD = (const float*)(F.ws + WS_MOD); const bf16_t* OUTB = (const bf16_t*)(F.ws + WS_PROJ); bf16_t* H2 = (bf16_t*)(F.ws + WS_H);
    const float* gpost = F.in[IN_NMPOST]; const float* gpre = F.in[IN_NFPRE];
    for (int row = blockIdx.x * 8 + F.wave; row < NTOK; row += F.G * 8) {
        const float* xr = row < NPTOK ? F.in[IN_XP] + (size_t)row * D : F.in[IN_XS] + (size_t)(row - NPTOK) * D;
        const float* md = MOD + modidx(row) * 12288;
        float4 o[8], x[8]; float ss = 0.f;
#pragma unroll
        for (int i = 0; i < 8; ++i) { const int col = (i * 64 + F.lane) * 4; const u32x2 w = *(const u32x2*)(OUTB + (size_t)row * D + col); x[i] = *(const float4*)(xr + col);
            o[i] = make_float4(bflo(w[0]), bfhi(w[0]), bflo(w[1]), bfhi(w[1])); ss += o[i].x * o[i].x + o[i].y * o[i].y + o[i].z * o[i].z + o[i].w * o[i].w; }
        ss = wave_sum(ss);
        const float rstd = rsqrtf(ss * (1.f / D) + 1e-6f);
        float ss2 = 0.f;
#pragma unroll
        for (int i = 0; i < 8; ++i) { const int col = (i * 64 + F.lane) * 4;
            const float4 gp = *(const float4*)(gpost + col), gm = *(const float4*)(md + 2 * D + col);
            float4 r;
            r.x = x[i].x + gm.x * (o[i].x * rstd * gp.x); r.y = x[i].y + gm.y * (o[i].y * rstd * gp.y);
            r.z = x[i].z + gm.z * (o[i].z * rstd * gp.z); r.w = x[i].w + gm.w * (o[i].w * rstd * gp.w);
            *(float4*)(F.out + (size_t)row * D + col) = r; o[i] = r;
            ss2 += r.x * r.x + r.y * r.y + r.z * r.z + r.w * r.w; }
        ss2 = wave_sum(ss2);
        const float rstd2 = rsqrtf(ss2 * (1.f / D) + 1e-6f);
#pragma unroll
        for (int i = 0; i < 8; ++i) { const int col = (i * 64 + F.lane) * 4;
            const float4 g = *(const float4*)(gpre + col), sc = *(const float4*)(md + 4 * D + col), sh = *(const float4*)(md + 3 * D + col);
            const float h0 = o[i].x * rstd2 * g.x * (1.f + sc.x) + sh.x, h1 = o[i].y * rstd2 * g.y * (1.f + sc.y) + sh.y;
            const float h2 = o[i].z * rstd2 * g.z * (1.f + sc.z) + sh.z, h3 = o[i].w * rstd2 * g.w * (1.f + sc.w) + sh.w;
            *(u32x2*)(H2 + (size_t)row * D + col) = (u32x2){pk2(h0, h1), pk2(h2, h3)}; }
    }
}
__device__ __forceinline__ void p15_rows(Frame& F) {
    const float* MOD = (const float*)(F.ws + WS_MOD); const bf16_t* Fb = (const bf16_t*)(F.ws + WS_H); const float* gpost = F.in[IN_NFPOST];
    for (int row = blockIdx.x * 8 + F.wave; row < NTOK; row += F.G * 8) {
        const float* md = MOD + modidx(row) * 12288;
        float4 o[8], x[8]; float ss = 0.f;
#pragma unroll
        for (int i = 0; i < 8; ++i) { const int col = (i * 64 + F.lane) * 4; const u32x2 w = *(const u32x2*)(Fb + (size_t)row * D + col); x[i] = *(const float4*)(F.out + (size_t)row * D + col);
            o[i] = make_float4(bflo(w[0]), bfhi(w[0]), bflo(w[1]), bfhi(w[1])); ss += o[i].x * o[i].x + o[i].y * o[i].y + o[i].z * o[i].z + o[i].w * o[i].w; }
        ss = wave_sum(ss);
        const float rstd = rsqrtf(ss * (1.f / D) + 1e-6f);
#pragma unroll
        for (int i = 0; i < 8; ++i) { const int col = (i * 64 + F.lane) * 4;
            const float4 gp = *(const float4*)(gpost + col), gf = *(const float4*)(md + 5 * D + col);
            float4 r;
            r.x = x[i].x + gf.x * (o[i].x * rstd * gp.x); r.y = x[i].y + gf.y * (o[i].y * rstd * gp.y);
            r.z = x[i].z + gf.z * (o[i].z * rstd * gp.z); r.w = x[i].w + gf.w * (o[i].w * rstd * gp.w);
            *(float4*)(F.out + (size_t)row * D + col) = r; }
    }
}

constexpr int LDS_MISC = 131072, LDS_BYTES = 131072 + 256;
__global__ void __launch_bounds__(512, 2) fwd_kernel(Args args) {
    extern __shared__ __attribute__((aligned(16))) unsigned char lds_raw[];
    Frame F;
    F.lds = (LAS unsigned char*)lds_raw;
    F.tid = threadIdx.x; F.lane = F.tid & 63; F.wave = __builtin_amdgcn_readfirstlane(F.tid >> 6); F.G = gridDim.x;
    F.in = args.in; F.out = args.out; F.ws = args.ws;
    volatile LAS unsigned* MISC = (volatile LAS unsigned*)(F.lds + LDS_MISC);
    const int lo = args.ph_lo, hi = args.ph_hi;
    const bool fused = (hi - lo) > 1;
    if (F.tid < 64) MISC[F.tid] = 0u;
    __syncthreads();
    XcdBarrier bar; bar.bar = (unsigned*)(F.ws + WS_CTL); bar.x = 0; bar.st = MISC;
    if (fused) bar = xcd_barrier_post((unsigned*)(F.ws + WS_CTL), MISC);
#ifndef PH_MASK
#define PH_MASK 0xFFFF
#endif
#define IN(k) (((PH_MASK >> (k)) & 1) && lo <= (k) && (k) < hi)
#define SEAM(k) do { if (IN(k) && IN((k) + 1)) { if (MK_CG_FIRST && (k) == 8) { cg::this_grid().sync(); } else xcd_barrier(bar); } } while (0)
    unsigned char* ws = F.ws;
#ifndef REP_MASK
#define REP_MASK 0
#endif
#define NREP(k) ((((REP_MASK) >> (k)) & 1) ? 2 : 1)
#define FRESH() asm volatile("" : "+v"(F.tid), "+v"(F.lane))
#define RUN(k, ...) do { if (IN(k)) { for (int _rep = 0; _rep < NREP(k); ++_rep) { if (_rep) xcd_barrier(bar); FRESH(); __VA_ARGS__; } } } while (0)
    RUN(0, p0_prologue(F));
    SEAM(0);
    RUN(1, p1_normmod(F));
    SEAM(1);
    RUN(2, { pg8::Gemm g{(const bf16_t*)(ws + WS_H), (const bf16_t*)(ws + WS_WTIN), D, D, D, 0}; pg8::StaticOrder S; S.init(NTOK, INWP, F.G, blockIdx.x);
        pg8::EpiBf16 E{(bf16_t*)(ws + WS_PROJ), INWP}; pg8::gemm_phase(F.lds, g, S, E); });
    SEAM(2);
    RUN(3, p3_elem(F));
    SEAM(3);
    RUN(4, { pg8::Gemm g{(const bf16_t*)(ws + WS_XC), (const bf16_t*)(ws + WS_BTLRU), LRUW, 256, 256, 1}; pg8::StaticOrder S; S.init(NTOK, 4096, F.G, blockIdx.x);
        pg8::EpiLru E{(unsigned*)F.out, (const bf16_t*)(ws + WS_XC), F.in[IN_BR], F.in[IN_BI], (const float*)(ws + WS_NL8)}; pg8::gemm_phase(F.lds, g, S, E); });
    SEAM(4);
    RUN(5, p5_lru_scan(F));
    SEAM(5);
    RUN(6, { pg8::Gemm g{(const bf16_t*)(ws + WS_LA), (const bf16_t*)(ws + WS_BTLORA), LAK, 256, 256, 2}; pg8::StaticOrder S; S.init(NTOK, 5120, F.G, blockIdx.x);
        pg8::EpiLora E{(bf16_t*)F.out, (bf16_t*)F.out + (size_t)NTOK * 2 * RW, (bf16_t*)(ws + WS_G), F.in[IN_W0], F.in[IN_A0]}; pg8::gemm_phase(F.lds, g, S, E); });
    SEAM(6);
    for (int _r78 = 0; _r78 < NREP(7); ++_r78) {
        if (_r78) xcd_barrier(bar);
        if (IN(7)) { FRESH(); p7_wkv_pass1(F); }
        SEAM(7);
        if (IN(8)) { FRESH(); p8_wkv_combine(F); }
    }
    SEAM(8);
    RUN(9, p9_wkv_pass3(F));
    SEAM(9);
    if (IN(10)) { FRESH(); p10_wkv_finish(F); }
    SEAM(10);
    RUN(11, { pg8::Gemm g{(const bf16_t*)(ws + WS_H), (const bf16_t*)(ws + WS_WTOUT), D, D, D, 0}; pg8::StaticOrder S; S.init(NTOK, D, F.G, blockIdx.x);
        pg8::EpiBf16 E{(bf16_t*)(ws + WS_PROJ), D}; pg8::gemm_phase(F.lds, g, S, E); });
    SEAM(11);
    RUN(12, p12_rows(F));
    SEAM(12);
    RUN(13, { pg8::Gemm g{(const bf16_t*)(ws + WS_H), (const bf16_t*)(ws + WS_WTGU), D, D, D, 0}; pg8::StaticOrder S; S.init(NTOK, 2 * FFH, F.G, blockIdx.x);
        pg8::EpiGu E{(bf16_t*)(ws + WS_PROJ)}; pg8::gemm_phase(F.lds, g, S, E); });
    SEAM(13);
    RUN(14, { pg8::Gemm g{(const bf16_t*)(ws + WS_PROJ), (const bf16_t*)(ws + WS_WTDN), FFH, FFH, FFH, 0}; pg8::StaticOrder S; S.init(NTOK, D, F.G, blockIdx.x);
        pg8::EpiBf16 E{(bf16_t*)(ws + WS_H), D}; pg8::gemm_phase(F.lds, g, S, E); });
    SEAM(14);
    if (IN(15)) { FRESH(); p15_rows(F); }
#undef IN
#undef SEAM
}

extern "C" void kernel_launch(void* const* d_in, const int* in_sizes, int n_in, void* d_out, int out_size, void* d_ws, size_t ws_size, hipStream_t stream) {
    static int grid = 0;
    if (grid == 0) {
        if (n_in != 34 || ws_size < WS_END) { fprintf(stderr, "kernel_launch: need 34 inputs and >= %zu bytes of workspace; got %d, %zu\n", (size_t)WS_END, n_in, ws_size); grid = -1; return; }
        int dev = 0, cus = 0, per_cu = 0;
        if (hipGetDevice(&dev) != hipSuccess || hipDeviceGetAttribute(&cus, hipDeviceAttributeMultiprocessorCount, dev) != hipSuccess) { grid = -1; return; }
        if (hipFuncSetAttribute((const void*)fwd_kernel, hipFuncAttributeMaxDynamicSharedMemorySize, LDS_BYTES) != hipSuccess) { fprintf(stderr, "kernel_launch: hipFuncSetAttribute failed\n"); grid = -1; return; }
        if (hipOccupancyMaxActiveBlocksPerMultiprocessor(&per_cu, (const void*)fwd_kernel, 512, LDS_BYTES) != hipSuccess || per_cu < 1) { fprintf(stderr, "kernel_launch: occupancy query says %d\n", per_cu); per_cu = 1; }
        (void)hipGetLastError();
        grid = cus;
    }
    if (grid < 0) return;
    (void)hipMemsetAsync((char*)d_ws + WS_CTL, 0, 64 * 1024, stream);
    Args a{};
    for (int i = 0; i < 34; ++i) a.in[i] = (const float*)d_in[i];
    a.out = (float*)d_out; a.ws = (unsigned char*)d_ws;
#if MK_ONE_LAUNCH
    a.ph_lo = 0; a.ph_hi = NPHASE;
    void* kargs[] = {&a};
    hipError_t e = hipLaunchCooperativeKernel((const void*)fwd_kernel, dim3(grid), dim3(512), kargs, LDS_BYTES, stream);
    if (e != hipSuccess) fprintf(stderr, "cooperative launch failed: %s (grid %d)\n", hipGetErrorString(e), grid);
#else
    for (int p = 0; p < NPHASE; ++p) { a.ph_lo = p; a.ph_hi = p + 1; hipLaunchKernelGGL(fwd_kernel, dim3(grid), dim3(512), LDS_BYTES, stream, a); }
#endif
}
```
